# Optimizing an MI355X kernel written in HIP

```python
import jax, jax.numpy as jnp
from jax import lax
import numpy as np

D_MODEL = 2048
BATCH = 2
SEQ = 8192
DEPTH = 2

CTX_LEN = 256
GRID_W = 64
N_MIXERS = 2
MIXER_MLSTM = 0
MIXER_CHUNK_MLP = 1
EPS = 1e-6

ML_HEADS = 4
ML_DQK = 256
ML_DV = D_MODEL // ML_HEADS
ML_CHUNK = 128
ML_CONV = 3
ML_QK_W = ML_HEADS * ML_DQK
ML_V_W = ML_HEADS * ML_DV
ML_IN_W = 2 * ML_QK_W + 2 * ML_V_W + 4 * ML_HEADS

CM_CHUNK = 128
CM_WIDTH = D_MODEL
CM_GROUPS = 8
CM_GDIM = CM_WIDTH // CM_GROUPS

PEER_HEADS = 8
PEER_NKEYS = 128
PEER_EXPERTS = PEER_NKEYS * PEER_NKEYS
PEER_DKEY = 256
PEER_HALF = PEER_DKEY // 2
PEER_TOPK = 16
PEER_BLOCK = 128

kernel_name = 'hybrid_mlstm_chunkmlp_peer_dit'


def rmsnorm(x, g):
    xf = x.astype(jnp.float32)
    y = xf * lax.rsqrt(jnp.mean(xf * xf, axis=-1, keepdims=True) + EPS)
    return (y * g.astype(jnp.float32)).astype(x.dtype)


def adaln(x, g, shift, scale):
    return rmsnorm(x, g) * (1 + scale[:, None, :]) + shift[:, None, :]


def modulation(cond, w_mod, b_mod):
    m = jax.nn.silu(cond) @ w_mod + b_mod
    return jnp.split(m, 6, axis=-1)


def grid_conv(x, w, b):
    bsz, t, ch = x.shape
    rows = t // GRID_W
    xg = x.reshape(bsz, rows, GRID_W, ch)
    y = lax.conv_general_dilated(xg, w.astype(x.dtype)[:, :, None, :], (1, 1), 'SAME',
                                 dimension_numbers=('NHWC', 'HWIO', 'NHWC'),
                                 feature_group_count=ch)
    return y.reshape(bsz, t, ch) + b


def seq_conv(x, w, b):
    t = x.shape[1]
    pad = ML_CONV // 2
    xp = jnp.pad(x, ((0, 0), (pad, pad), (0, 0)))
    taps = w[pad]
    y = xp[:, 0:t] * taps[0]
    for j in range(1, ML_CONV):
        y = y + xp[:, j:j + t] * taps[j]
    return y + b


def zero_state(bsz):
    return (jnp.zeros((bsz, ML_HEADS, ML_DV, ML_DQK), jnp.float32),
            jnp.zeros((bsz, ML_HEADS, ML_DQK), jnp.float32),
            jnp.zeros((bsz, ML_HEADS), jnp.float32))


def mlstm_scan(q, k, v, log_i, log_f, state, emit):
    bsz, nh, t, _ = q.shape
    nc = t // ML_CHUNK

    def chunks(a):
        a = a.reshape((bsz, nh, nc, ML_CHUNK) + a.shape[3:])
        return jnp.moveaxis(a, 2, 0)

    tril = jnp.tril(jnp.ones((ML_CHUNK, ML_CHUNK), dtype=bool))

    def step(carry, inp):
        c_mat, n_vec, m = carry
        qc, kc, vc, ic, fc = inp
        b = jnp.cumsum(fc, axis=-1)
        b_end = b[..., -1]
        w_log = b_end[..., None] - b + ic
        m_new = jnp.maximum(b_end + m, jnp.max(w_log, axis=-1))
        a_state = jnp.exp(b_end + m - m_new)
        w = jnp.exp(w_log - m_new[..., None])
        c_new = a_state[..., None, None] * c_mat + jnp.einsum('bhs,bhse,bhsd->bhed', w, vc, kc)
        n_new = a_state[..., None] * n_vec + jnp.einsum('bhs,bhsd->bhd', w, kc)
        if not emit:
            return (c_new, n_new, m_new), None
        inter = b + m[..., None]
        d_log = jnp.where(tril, b[..., :, None] - b[..., None, :] + ic[..., None, :], -jnp.inf)
        m_t = jnp.maximum(inter, jnp.max(d_log, axis=-1))
        a_inter = jnp.exp(inter - m_t)
        p = jnp.exp(d_log - m_t[..., None]) * jnp.einsum('bhtd,bhsd->bhts', qc, kc)
        num = (a_inter[..., None] * jnp.einsum('bhed,bhtd->bhte', c_mat, qc)
               + jnp.einsum('bhts,bhse->bhte', p, vc))
        den = a_inter * jnp.einsum('bhd,bhtd->bht', n_vec, qc) + jnp.sum(p, axis=-1)
        h = num / jnp.maximum(jnp.abs(den), jnp.exp(-m_t))[..., None]
        return (c_new, n_new, m_new), h

    state, hs = lax.scan(step, state, (chunks(q), chunks(k), chunks(v), chunks(log_i), chunks(log_f)))
    if not emit:
        return None, state
    h = jnp.moveaxis(hs, 0, 2).reshape(bsz, nh, t, ML_DV)
    return h, state


def mlstm_stream(hn, state_f, state_b, on_grid, emit, w_in, conv_w, conv_b, gate_b, head_g, w_out):
    bsz, t, _ = hn.shape
    proj = hn @ w_in
    qk, v, o, gates = jnp.split(proj, [2 * ML_QK_W, 2 * ML_QK_W + ML_V_W, 2 * ML_QK_W + 2 * ML_V_W], axis=-1)
    qk = jax.nn.silu(grid_conv(qk, conv_w, conv_b) if on_grid else seq_conv(qk, conv_w, conv_b))
    q, k = jnp.split(qk, 2, axis=-1)

    def heads(a, d):
        return a.reshape(bsz, t, ML_HEADS, d).transpose(0, 2, 1, 3).astype(jnp.float32)

    q = heads(q, ML_DQK)
    k = heads(k, ML_DQK) * (ML_DQK ** -0.5)
    v = heads(v, ML_DV)
    g = (gates.astype(jnp.float32) + gate_b.astype(jnp.float32)).reshape(bsz, t, 4, ML_HEADS)
    g = g.transpose(2, 0, 3, 1)
    log_i_f, log_f_f = g[0], jax.nn.log_sigmoid(g[1])
    log_i_b, log_f_b = g[2], jax.nn.log_sigmoid(g[3])
    flip = lambda a: jnp.flip(a, axis=2)
    h_f, st_f = mlstm_scan(q, k, v, log_i_f, log_f_f, state_f, emit)
    h_b, st_b = mlstm_scan(flip(q), flip(k), flip(v), flip(log_i_b), flip(log_f_b), state_b, emit)
    if not emit:
        return None, st_f, st_b
    h = h_f + flip(h_b)
    h = h * lax.rsqrt(jnp.mean(h * h, axis=-1, keepdims=True) + EPS) * head_g.astype(jnp.float32)[None, :, None, :]
    h = h.transpose(0, 2, 1, 3).reshape(bsz, t, ML_V_W).astype(hn.dtype) * jax.nn.sigmoid(o)
    return h @ w_out, st_f, st_b


def chunk_mlp(hn, w_in, g_v, w_s, b_s, w_out):
    bsz, t, _ = hn.shape
    nc = t // CM_CHUNK
    z = jax.nn.gelu(hn @ w_in)
    u, v = jnp.split(z, 2, axis=-1)
    v = rmsnorm(v, g_v).reshape(bsz, nc, CM_CHUNK, CM_GROUPS, CM_GDIM)
    sv = jnp.einsum('gts,bcsgd->bctgd', w_s, v) + b_s.T[None, None, :, :, None]
    return (u * sv.reshape(bsz, t, CM_WIDTH)) @ w_out


def peer(hn, w_q, sub_keys, u_emb, v_emb):
    bsz, t, d = hn.shape
    tok = hn.reshape(-1, PEER_BLOCK, d)

    def block(xb):
        q = (xb @ w_q).reshape(PEER_BLOCK, PEER_HEADS, 2, PEER_HALF)
        s = jnp.einsum('thpd,hpnd->thpn', q, sub_keys).astype(jnp.float32)
        s1, i1 = lax.top_k(s[:, :, 0], PEER_TOPK)
        s2, i2 = lax.top_k(s[:, :, 1], PEER_TOPK)
        cand = (s1[..., :, None] + s2[..., None, :]).reshape(PEER_BLOCK, PEER_HEADS, PEER_TOPK * PEER_TOPK)
        cidx = (i1[..., :, None] * PEER_NKEYS + i2[..., None, :]).reshape(PEER_BLOCK, PEER_HEADS, PEER_TOPK * PEER_TOPK)
        top_s, pos = lax.top_k(cand, PEER_TOPK)
        eidx = jnp.take_along_axis(cidx, pos, axis=-1)
        gate = jax.nn.softmax(top_s, axis=-1)
        ue = u_emb[eidx]
        ve = v_emb[eidx]
        act = jax.nn.gelu(jnp.einsum('thkd,td->thk', ue, xb).astype(jnp.float32)) * gate
        return jnp.einsum('thk,thkd->td', act.astype(xb.dtype), ve)

    return lax.map(block, tok).reshape(bsz, t, d)


def setup_inputs(seed: int = 0) -> dict:
    key = jax.random.key(seed)
    ks = iter(jax.random.split(key, 40))
    n_ml = len(range(MIXER_MLSTM, DEPTH, N_MIXERS))
    n_cm = len(range(MIXER_CHUNK_MLP, DEPTH, N_MIXERS))

    def nrm(shape, scale):
        return jax.random.normal(next(ks), shape, jnp.float32) * scale

    def gain(shape):
        return 1.0 + nrm(shape, 0.02)

    gi_f = nrm((n_ml, ML_HEADS), 0.1)
    gf_f = 3.0 + 3.0 * jax.random.uniform(next(ks), (n_ml, ML_HEADS), jnp.float32)
    gi_b = nrm((n_ml, ML_HEADS), 0.1)
    gf_b = 3.0 + 3.0 * jax.random.uniform(next(ks), (n_ml, ML_HEADS), jnp.float32)
    return {
        'x': nrm((BATCH, SEQ, D_MODEL), 1.0),
        'c': nrm((BATCH, D_MODEL), 1.0),
        'ctx': nrm((BATCH, CTX_LEN, D_MODEL), 1.0),
        'c_ctx': nrm((D_MODEL,), 1.0),
        'w_mod': nrm((DEPTH, D_MODEL, 6 * D_MODEL), 0.5 * D_MODEL ** -0.5),
        'b_mod': nrm((DEPTH, 6 * D_MODEL), 0.02),
        'g_mix': gain((DEPTH, D_MODEL)),
        'g_chan': gain((DEPTH, D_MODEL)),
        'ml_w_in': nrm((n_ml, D_MODEL, ML_IN_W), D_MODEL ** -0.5),
        'ml_conv_w': nrm((n_ml, ML_CONV, ML_CONV, 2 * ML_QK_W), 1.0 / ML_CONV),
        'ml_conv_b': nrm((n_ml, 2 * ML_QK_W), 0.02),
        'ml_gate_b': jnp.concatenate([gi_f, gf_f, gi_b, gf_b], axis=-1),
        'ml_head_g': gain((n_ml, ML_HEADS, ML_DV)),
        'ml_w_out': nrm((n_ml, ML_V_W, D_MODEL), ML_V_W ** -0.5),
        'cm_w_in': nrm((n_cm, D_MODEL, 2 * CM_WIDTH), D_MODEL ** -0.5),
        'cm_g_v': gain((n_cm, CM_WIDTH)),
        'cm_w_s': nrm((n_cm, CM_GROUPS, CM_CHUNK, CM_CHUNK), CM_CHUNK ** -0.5),
        'cm_b_s': gain((n_cm, CM_GROUPS, CM_CHUNK)),
        'cm_w_out': nrm((n_cm, CM_WIDTH, D_MODEL), CM_WIDTH ** -0.5),
        'peer_w_q': nrm((DEPTH, D_MODEL, PEER_HEADS * PEER_DKEY), D_MODEL ** -0.5),
        'peer_keys': nrm((DEPTH, PEER_HEADS, 2, PEER_NKEYS, PEER_HALF), PEER_HALF ** -0.5),
        'peer_u': nrm((DEPTH, PEER_EXPERTS, D_MODEL), D_MODEL ** -0.5),
        'peer_v': nrm((DEPTH, PEER_EXPERTS, D_MODEL), 1.0),
        'g_final': gain((D_MODEL,)),
    }


def reference(x, c, ctx, c_ctx, w_mod, b_mod, g_mix, g_chan,
              ml_w_in, ml_conv_w, ml_conv_b, ml_gate_b, ml_head_g, ml_w_out,
              cm_w_in, cm_g_v, cm_w_s, cm_b_s, cm_w_out,
              peer_w_q, peer_keys, peer_u, peer_v, g_final):
    bsz = x.shape[0]
    h_lat = x
    h_ctx = ctx
    for i in range(DEPTH):
        kind = i % N_MIXERS
        j = i // N_MIXERS
        ctx_later = any(l % N_MIXERS == MIXER_MLSTM for l in range(i + 1, DEPTH))
        ctx_now = ctx_later or kind == MIXER_MLSTM
        sh1, sc1, gt1, sh2, sc2, gt2 = modulation(c, w_mod[i], b_mod[i])
        hn = adaln(h_lat, g_mix[i], sh1, sc1)
        if ctx_now:
            csh1, csc1, cgt1, csh2, csc2, cgt2 = modulation(c_ctx[None, :], w_mod[i], b_mod[i])
            hc = adaln(h_ctx, g_mix[i], csh1, csc1)
        if kind == MIXER_MLSTM:
            ml = (ml_w_in[j], ml_conv_w[j], ml_conv_b[j], ml_gate_b[j], ml_head_g[j], ml_w_out[j])
            z0 = zero_state(bsz)
            yc, st_f, st_b = mlstm_stream(hc, z0, z0, False, ctx_later, *ml)
            y, _, _ = mlstm_stream(hn, st_f, st_b, True, True, *ml)
        else:
            cm = (cm_w_in[j], cm_g_v[j], cm_w_s[j], cm_b_s[j], cm_w_out[j])
            y = chunk_mlp(hn, *cm)
            yc = chunk_mlp(hc, *cm) if ctx_later else None
        pe = (peer_w_q[i], peer_keys[i], peer_u[i], peer_v[i])
        h_lat = h_lat + gt1[:, None, :] * y
        h_lat = h_lat + gt2[:, None, :] * peer(adaln(h_lat, g_chan[i], sh2, sc2), *pe)
        if ctx_later:
            h_ctx = h_ctx + cgt1[:, None, :] * yc
            h_ctx = h_ctx + cgt2[:, None, :] * peer(adaln(h_ctx, g_chan[i], csh2, csc2), *pe)
    return rmsnorm(h_lat, g_final)
```

```cpp
#include <hip/hip_runtime.h>
#include <cstdio>
#include <cstdint>
namespace pg8 {
#define PG8_LAS __attribute__((address_space(3)))
typedef unsigned short bf16_t;
typedef short bf16x8 __attribute__((ext_vector_type(8)));
typedef float f32x4 __attribute__((ext_vector_type(4)));
typedef unsigned u32x4 __attribute__((ext_vector_type(4)));
constexpr int BM = 256, BK = 64, HALF = 128, HTB = HALF * BK * 2  , STAGE_BYTES = 8 * HTB, NXCD = 8, WGM = 8;

__host__ __device__ __forceinline__ int lds_byte(int r, int c) { const int st = (r >> 4) * 2 + (c >> 5), rr = r & 15, cc = c & 31, ob = rr * 64 + cc * 2; return st * 1024 + (ob ^ (((ob >> 9) & 1) << 5)); }
__host__ __device__ __forceinline__ void stage_rc(int b, int& R, int& C) { const int st = b / 1024, sb = b % 1024, swz = sb ^ (((sb >> 9) & 1) << 5); R = (st >> 1) * 16 + swz / 64; C = (st & 1) * 32 + (swz % 64) / 2; }
__host__ __device__ __forceinline__ int perm32(int rho) { const int n = rho >> 4, i = rho & 15; return 8 * (i >> 2) + 4 * n + (i & 3); }

struct Unit { int pm, pn; };
struct Gemm { const bf16_t* A; const bf16_t* Bt; int M, N, K; };

struct StaticOrder {
    int nM, nN, nwg, G, c, wgm;
    __host__ __device__ void init(int M, int N, int G_, int c_) { nM = M / BM; nN = N / BM; nwg = nM * nN; G = G_; c = c_; wgm = (nN == 16) ? 2 : 4; }
    __host__ __device__ bool next(int i, Unit& u) const {
        const long L = (long)i * G + c; if (L >= nwg) return false;
        int wgid = (int)L; { const int q = nwg / NXCD, r = nwg % NXCD, xcd = wgid % NXCD, off = wgid / NXCD; wgid = (xcd < r ? xcd * (q + 1) : r * (q + 1) + (xcd - r) * q) + off; }
        const int nig = wgm * nN, gid = wgid / nig, fm = gid * wgm, gsz = (nM - fm) < wgm ? (nM - fm) : wgm;
        u.pm = fm + ((wgid % nig) % gsz); u.pn = (wgid % nig) / gsz; return true;
    }
    __device__ __forceinline__ void a_ready(const Unit&) const {}
    __device__ __forceinline__ void done(const Unit&) const {}
};
__device__ __forceinline__ unsigned cvt_pk_bf16(float lo, float hi) { unsigned r; asm volatile("v_cvt_pk_bf16_f32 %0, %1, %2" : "=v"(r) : "v"(lo), "v"(hi)); return r; }
typedef float f32x2 __attribute__((ext_vector_type(2)));
template <class Epi, class Sched, bool ALIGN_EPI = false, bool SP2 = false, bool FP8 = false>
__device__ __forceinline__ void gemm_phase(PG8_LAS unsigned char* lds, const Gemm g, const Sched& S, const Epi& E) {
    const int tid = threadIdx.x, wid = __builtin_amdgcn_readfirstlane(tid >> 6), lane = tid & 63, wr = wid >> 2, wc = wid & 3, fr = lane & 15, fq = lane >> 4;
    const int K = g.K, nt = K / BK;
    unsigned voffA[2], voffB[2];
#pragma unroll
    for (int i = 0; i < 2; ++i) { int R, C; stage_rc(tid * 16 + i * 8192, R, C); const int Rb = Epi::PERM ? ((R & ~31) + perm32(R & 31)) : R;
        voffA[i] = (unsigned)(R * K + C) * 2u; voffB[i] = (unsigned)(Rb * K + C) * 2u; }
    const size_t kstep = (size_t)(BK * 2);
    const size_t hstep = (size_t)HALF * K * 2;
    const size_t tstep = 2 * hstep;
    const unsigned ldsw = (unsigned)wid * 1024u;
    const int aoff = lds_byte(wr * 64 + fr, fq * 8), boff = lds_byte(wc * 32 + fr, fq * 8);
#define PG8_SA(b, h) (((b) * 2 + (h)) * HTB)
#define PG8_SB(b, h) ((4 + (b) * 2 + (h)) * HTB)
#define PG8_STAGE(bufoff, gbase, voff) do { _Pragma("unroll") for (int _i = 0; _i < 2; ++_i) \
        __builtin_amdgcn_global_load_lds((const unsigned*)((const char*)(gbase) + (voff)[_i]), (PG8_LAS unsigned*)(lds + (bufoff) + ldsw + _i * 8192), 16, 0, 0); } while (0)
#define PG8_LDA(dst, b, h) do { _Pragma("unroll") for (int m = 0; m < 4; ++m) { const pg8_v4i l0_ = *(const PG8_LAS pg8_v4i*)(lds + PG8_SA(b, h) + aoff + m * 2048), l1_ = *(const PG8_LAS pg8_v4i*)(lds + PG8_SA(b, h) + aoff + m * 2048 + 1024); dst[m] = __builtin_shufflevector(l0_, l1_, 0, 1, 2, 3, 4, 5, 6, 7); } } while (0)
#define PG8_LDB(dst, b, h) do { _Pragma("unroll") for (int n = 0; n < 2; ++n) { const pg8_v4i l0_ = *(const PG8_LAS pg8_v4i*)(lds + PG8_SB(b, h) + boff + n * 2048), l1_ = *(const PG8_LAS pg8_v4i*)(lds + PG8_SB(b, h) + boff + n * 2048 + 1024); dst[n] = __builtin_shufflevector(l0_, l1_, 0, 1, 2, 3, 4, 5, 6, 7); } } while (0)
#define PG8_MMA(ai, bj, At, Bt) do { __builtin_amdgcn_s_setprio(1); _Pragma("unroll") for (int m = 0; m < 4; ++m) _Pragma("unroll") for (int n = 0; n < 2; ++n) { \
        if constexpr (FP8) { asm volatile("v_mfma_f32_16x16x128_f8f6f4 %0, %1, %2, %0" : "+v"(acc[ai][bj][m][n]) : "v"(Bt[n]), "v"(At[m])); }     \
        else { acc[ai][bj][m][n] = __builtin_amdgcn_mfma_f32_16x16x32_bf16(__builtin_bit_cast(bf16x8, __builtin_shufflevector(Bt[n], Bt[n], 0, 1, 2, 3)), __builtin_bit_cast(bf16x8, __builtin_shufflevector(At[m], At[m], 0, 1, 2, 3)), acc[ai][bj][m][n], 0, 0, 0); \
               acc[ai][bj][m][n] = __builtin_amdgcn_mfma_f32_16x16x32_bf16(__builtin_bit_cast(bf16x8, __builtin_shufflevector(Bt[n], Bt[n], 4, 5, 6, 7)), __builtin_bit_cast(bf16x8, __builtin_shufflevector(At[m], At[m], 4, 5, 6, 7)), acc[ai][bj][m][n], 0, 0, 0); } } \
        __builtin_amdgcn_s_setprio(0); } while (0)
#define PG8_WAIT_V(n) asm volatile("s_waitcnt vmcnt(" #n ")" ::: "memory")
#define PG8_WAIT_L(n) asm volatile("s_waitcnt lgkmcnt(" #n ")" ::: "memory")
#define PG8_BAR __builtin_amdgcn_s_barrier()
#define PG8_SCHED __builtin_amdgcn_sched_barrier(0)
    Unit cur, nxt; int ui = 0;
    if (!S.next(0, cur)) return;
    f32x4 acc[2][2][4][2];
#pragma unroll
    for (int a = 0; a < 2; ++a)
#pragma unroll
        for (int b = 0; b < 2; ++b)
#pragma unroll
            for (int m = 0; m < 4; ++m)
#pragma unroll
                for (int n = 0; n < 2; ++n) acc[a][b][m][n] = (f32x4){0.f, 0.f, 0.f, 0.f};
    typedef int pg8_v4i __attribute__((ext_vector_type(4))); typedef int pg8_v8i __attribute__((ext_vector_type(8)));
    pg8_v8i At[4], B0[2], B1[2];
    const char* cA = (const char*)g.A + (size_t)cur.pm * tstep; const char* cB = (const char*)g.Bt + (size_t)cur.pn * tstep;
    S.a_ready(cur);
    if constexpr (SP2) {
        PG8_STAGE(PG8_SB(0, 0), cB, voffB); PG8_STAGE(PG8_SB(0, 1), cB + hstep, voffB); PG8_STAGE(PG8_SA(0, 0), cA, voffA); PG8_STAGE(PG8_SA(0, 1), cA + hstep, voffA);
        if (wr == 1) PG8_BAR;
        PG8_WAIT_V(2); PG8_BAR;
        PG8_STAGE(PG8_SB(1, 0), cB + kstep, voffB); PG8_STAGE(PG8_SA(1, 0), cA + kstep, voffA); PG8_STAGE(PG8_SB(1, 1), cB + hstep + kstep, voffB);
        PG8_WAIT_V(6); PG8_BAR;
    } else {
        PG8_STAGE(PG8_SB(0, 0), cB, voffB); PG8_STAGE(PG8_SA(0, 0), cA, voffA); PG8_STAGE(PG8_SB(0, 1), cB + hstep, voffB); PG8_STAGE(PG8_SA(0, 1), cA + hstep, voffA);
        if (wr == 1) PG8_BAR;
        PG8_WAIT_V(4); PG8_BAR;
        PG8_STAGE(PG8_SB(1, 0), cB + kstep, voffB); PG8_STAGE(PG8_SA(1, 0), cA + kstep, voffA); PG8_STAGE(PG8_SB(1, 1), cB + hstep + kstep, voffB);
        PG8_WAIT_V(6); PG8_BAR;
    }
    for (;;) {
        const bool has_next = S.next(ui + 1, nxt);
        const char* nA = has_next ? (const char*)g.A + (size_t)nxt.pm * tstep : cA; const char* nB = has_next ? (const char*)g.Bt + (size_t)nxt.pn * tstep : cB;
        for (int t = 0; t < nt; t += 2) {
            const bool last = (t == nt - 2);
            const char* a1 = cA + (size_t)(t + 1) * kstep;
            const char* a2 = last ? nA : cA + (size_t)(t + 2) * kstep; const char* b2 = last ? nB : cB + (size_t)(t + 2) * kstep;
            const char* a3 = a2 + kstep; const char* b3 = b2 + kstep;
            if (last && has_next) S.a_ready(nxt);
            if constexpr (SP2) {
            PG8_LDB(B0, 0, 0); PG8_LDB(B1, 0, 1); PG8_SCHED; PG8_LDA(At, 0, 0); PG8_STAGE(PG8_SA(1, 1), a1 + hstep, voffA);
            PG8_WAIT_V(8); PG8_WAIT_L(0); PG8_BAR; PG8_MMA(0, 0, At, B0); PG8_MMA(0, 1, At, B1); PG8_BAR; PG8_SCHED;
            PG8_LDA(At, 0, 1); PG8_STAGE(PG8_SB(0, 0), b2, voffB); PG8_STAGE(PG8_SB(0, 1), b2 + hstep, voffB); PG8_STAGE(PG8_SA(0, 0), a2, voffA);
            PG8_WAIT_V(8); PG8_WAIT_L(0); PG8_BAR; PG8_MMA(1, 0, At, B0); PG8_MMA(1, 1, At, B1); PG8_BAR; PG8_SCHED;
            PG8_LDB(B0, 1, 0); PG8_LDB(B1, 1, 1); PG8_SCHED; PG8_LDA(At, 1, 0); PG8_STAGE(PG8_SA(0, 1), a2 + hstep, voffA);
            PG8_WAIT_V(8); PG8_WAIT_L(0); PG8_BAR; PG8_MMA(0, 0, At, B0); PG8_MMA(0, 1, At, B1); PG8_BAR; PG8_SCHED;
            PG8_LDA(At, 1, 1); PG8_STAGE(PG8_SB(1, 0), b3, voffB); PG8_STAGE(PG8_SB(1, 1), b3 + hstep, voffB); PG8_STAGE(PG8_SA(1, 0), a3, voffA);
            PG8_WAIT_V(8); PG8_WAIT_L(0); PG8_BAR; PG8_MMA(1, 0, At, B0); PG8_MMA(1, 1, At, B1); PG8_BAR; PG8_SCHED;
            } else {
            PG8_LDB(B0, 0, 0); PG8_SCHED; PG8_LDA(At, 0, 0); PG8_STAGE(PG8_SA(1, 1), a1 + hstep, voffA);
            PG8_WAIT_L(8); PG8_BAR; PG8_WAIT_L(0); PG8_MMA(0, 0, At, B0); PG8_BAR; PG8_SCHED;
            PG8_LDB(B1, 0, 1); PG8_STAGE(PG8_SB(0, 0), b2, voffB);
            PG8_BAR; PG8_WAIT_L(0); PG8_MMA(0, 1, At, B1); PG8_BAR;
            PG8_LDA(At, 0, 1); PG8_STAGE(PG8_SA(0, 0), a2, voffA);
            PG8_BAR; PG8_WAIT_L(0); PG8_MMA(1, 0, At, B0); PG8_BAR; PG8_SCHED;
            PG8_STAGE(PG8_SB(0, 1), b2 + hstep, voffB);
            PG8_WAIT_V(6); PG8_BAR; PG8_MMA(1, 1, At, B1); PG8_BAR;
            PG8_LDB(B0, 1, 0); PG8_SCHED; PG8_LDA(At, 1, 0); PG8_STAGE(PG8_SA(0, 1), a2 + hstep, voffA);
            PG8_WAIT_L(8); PG8_BAR; PG8_WAIT_L(0); PG8_MMA(0, 0, At, B0); PG8_BAR; PG8_SCHED;
            PG8_LDB(B1, 1, 1); PG8_STAGE(PG8_SB(1, 0), b3, voffB);
            PG8_BAR; PG8_WAIT_L(0); PG8_MMA(0, 1, At, B1); PG8_BAR;
            PG8_LDA(At, 1, 1); PG8_STAGE(PG8_SA(1, 0), a3, voffA);
            PG8_BAR; PG8_WAIT_L(0); PG8_MMA(1, 0, At, B0); PG8_BAR; PG8_SCHED;
            PG8_STAGE(PG8_SB(1, 1), b3 + hstep, voffB);
            PG8_WAIT_V(6); PG8_BAR; PG8_MMA(1, 1, At, B1); PG8_BAR;
            }
        }
        if constexpr (FP8) asm volatile("s_nop 7\n\ts_nop 7" ::: "memory");
        if constexpr (ALIGN_EPI) { if (wr == 0) PG8_BAR; }
        if constexpr (!Epi::AFTER_DRAIN) { E(acc, cur, wr, wc, fr, fq); S.done(cur); }
        if (!has_next) break;
#pragma unroll
        for (int a = 0; a < 2; ++a)
#pragma unroll
            for (int b = 0; b < 2; ++b)
#pragma unroll
                for (int m = 0; m < 4; ++m)
#pragma unroll
                    for (int n = 0; n < 2; ++n) acc[a][b][m][n] = (f32x4){0.f, 0.f, 0.f, 0.f};
        cur = nxt; cA = nA; cB = nB; ++ui;
        if constexpr (ALIGN_EPI) { if (wr == 1) PG8_BAR; }
    }
    PG8_WAIT_V(0);
    if constexpr (!ALIGN_EPI) { if (wr == 0) PG8_BAR; }
    PG8_BAR;
    if constexpr (Epi::AFTER_DRAIN) { E.fused(acc, cur, wr, wc, fr, fq, lds, wid, lane); S.done(cur); }
#undef PG8_SA
#undef PG8_SB
#undef PG8_STAGE
#undef PG8_LDA
#undef PG8_LDB
#undef PG8_MMA
#undef PG8_WAIT_V
#undef PG8_WAIT_L
#undef PG8_BAR
#undef PG8_SCHED
}
}

#define GAS __attribute__((address_space(1)))
#define LAS __attribute__((address_space(3)))
typedef unsigned short bf16;
typedef unsigned v4u __attribute__((ext_vector_type(4)));
typedef unsigned v2u __attribute__((ext_vector_type(2)));
typedef float f32x4 __attribute__((ext_vector_type(4)));
typedef short bf16x8 __attribute__((ext_vector_type(8)));

constexpr int NWAVES = 8, NTHR = 512;
constexpr int D = 2048, SEQ = 8192, M = 16384, CTXL = 256, MC = 512, MT = M + MC;
constexpr int NMOD = 12288;
constexpr int NH = 4, DQK = 256, DV = 512, CHK = 128, NCH = 64, NCHT = 66;
constexpr int NEXP = 16384;
constexpr float EPS = 1e-6f;
constexpr float W8_SCALE = 64.0f, W8_INV = 1.0f / 64.0f;

constexpr size_t MiB = (size_t)1 << 20;
constexpr size_t WS_CTL = 0, CTL_ZERO_BYTES = 1 * MiB;
constexpr size_t WS_MODV = 1 * MiB;
constexpr size_t WS_WG = 1 * MiB + 512 * 1024;
constexpr size_t WS_VSS = 1 * MiB + 768 * 1024;
constexpr size_t WS_BCUM = 2 * MiB;
constexpr size_t WS_WST = 2 * MiB + 512 * 1024;
constexpr size_t WS_MPREV = 3 * MiB + 256 * 1024;
constexpr size_t WS_ASTATE = WS_MPREV + 8192;
constexpr size_t WS_AINT = 4 * MiB;
constexpr size_t WS_EXPNM = 4 * MiB + 512 * 1024;
constexpr size_t WS_GATES = 5 * MiB;
constexpr size_t WS_KEYS = 7 * MiB;
constexpr size_t WS_WIN0 = 8 * MiB, WS_WOUT0 = 32 * MiB, WS_WQ0 = 40 * MiB, WS_WIN1 = 48 * MiB, WS_WOUT1 = 64 * MiB, WS_WQ1 = 72 * MiB;
constexpr size_t WS_UT0 = 80 * MiB, WS_VT0 = 96 * MiB, WS_UT1 = 112 * MiB, WS_VT1 = 128 * MiB;
constexpr size_t WS_TSC = 208 * MiB;
constexpr size_t WS_XQ = 212 * MiB;
constexpr size_t WS_SX = 244 * MiB;
constexpr size_t WS_HLAT = 336 * MiB;
constexpr size_t WS_HN = 464 * MiB;
constexpr size_t WS_QKRAW = 532 * MiB;
constexpr size_t WS_V = 600 * MiB;
constexpr size_t WS_OG = 668 * MiB;
constexpr size_t WS_QC = 732 * MiB;
constexpr size_t WS_EIDX = 732 * MiB, WS_EGATE = 740 * MiB, WS_ACT = 748 * MiB;
constexpr size_t WS_XCH = 756 * MiB;
constexpr size_t WS_KC = 764 * MiB;
constexpr size_t WS_WKT = 798 * MiB;
constexpr size_t WS_VTR = 864 * MiB;
constexpr size_t WS_PM = 930 * MiB;
constexpr size_t WS_VSSP = 962 * MiB;
constexpr size_t WS_QC8 = 964 * MiB;
constexpr size_t WS_END = 980 * MiB;
constexpr int CW_BAR = 4096;
constexpr int CW_XCH = 32768;

constexpr int LDS_BYTES = 147456;
constexpr int LDS_MISC = 145408;

#define LDS_WAIT() asm volatile("s_waitcnt lgkmcnt(0)" ::: "memory")
#define VM_WAIT() asm volatile("s_waitcnt vmcnt(0)" ::: "memory")

typedef __bf16 bf16x2_t __attribute__((ext_vector_type(2)));
typedef float f32x2_t __attribute__((ext_vector_type(2)));
__device__ __forceinline__ unsigned pk2c(float lo, float hi) { const bf16x2_t v = __builtin_convertvector((f32x2_t){lo, hi}, bf16x2_t); return __builtin_bit_cast(unsigned, v); }
__device__ __forceinline__ unsigned pk2(float lo, float hi) { unsigned r; asm volatile("v_cvt_pk_bf16_f32 %0, %1, %2" : "=v"(r) : "v"(lo), "v"(hi)); return r; }
__device__ __forceinline__ unsigned pk4_fp8(float a, float b, float c2, float d) { int w = __builtin_amdgcn_cvt_pk_fp8_f32(a, b, 0, false); w = __builtin_amdgcn_cvt_pk_fp8_f32(c2, d, w, true); return (unsigned)w; }
__device__ __forceinline__ unsigned e2m1_code(float x) { const float ax = fabsf(x);
    const unsigned m = (ax >= 0.25f) + (ax >= 0.75f) + (ax >= 1.25f) + (ax >= 1.75f) + (ax >= 2.5f) + (ax >= 3.5f) + (ax >= 5.0f); return m | (x < 0.f ? 8u : 0u); }
__device__ __forceinline__ float e2m1_val(unsigned cd) { const unsigned m = cd & 7u; const float a = m < 4u ? 0.5f * (float)m : (m == 4u ? 2.0f : m == 5u ? 3.0f : m == 6u ? 4.0f : 6.0f); return (cd & 8u) ? -a : a; }
__device__ __forceinline__ unsigned fp4x4(float a, float b, float c, float d) { unsigned w = __builtin_amdgcn_cvt_scalef32_pk_fp4_f32(0u, a, b, 1.0f, 0); return __builtin_amdgcn_cvt_scalef32_pk_fp4_f32(w, c, d, 1.0f, 1) & 0xffffu; }
__device__ __forceinline__ float bflo(unsigned u) { return __uint_as_float(u << 16); }
__device__ __forceinline__ float bfhi(unsigned u) { return __uint_as_float(u & 0xffff0000u); }
__device__ __forceinline__ float bf2f(bf16 b) { return __uint_as_float(((unsigned)b) << 16); }
__device__ __forceinline__ float fexp(float x) { return __builtin_amdgcn_exp2f(x * 1.4426950408889634f); }
__device__ __forceinline__ float sigmoidf_(float x) { return __builtin_amdgcn_rcpf(1.0f + fexp(-x)); }
__device__ __forceinline__ float siluf_(float x) { return x * sigmoidf_(x); }
__device__ __forceinline__ float gelu_tanh(float x) { const float u = 0.7978845608028654f * (x + 0.044715f * x * x * x); return x * __builtin_amdgcn_rcpf(1.0f + fexp(-2.0f * u)); }
__device__ __forceinline__ float log_sigmoid(float x) { return fminf(x, 0.f) - log1pf(expf(-fabsf(x))); }
#define WR_DPP(x, c) __int_as_float(__builtin_amdgcn_update_dpp(0, __float_as_int(x), (c), 0xf, 0xf, false))
#define WR_LANE(x, l) __int_as_float(__builtin_amdgcn_readlane(__float_as_int(x), (l)))
__device__ __forceinline__ float wmaxf_all(float v) {
    v = fmaxf(v, WR_DPP(v, 0x128)); v = fmaxf(v, WR_DPP(v, 0x124)); v = fmaxf(v, WR_DPP(v, 0x122)); v = fmaxf(v, WR_DPP(v, 0x121));
    return fmaxf(fmaxf(WR_LANE(v, 0), WR_LANE(v, 16)), fmaxf(WR_LANE(v, 32), WR_LANE(v, 48)));
}
__device__ __forceinline__ int row16_sum_i32(int v) {
    v += __builtin_amdgcn_update_dpp(0, v, 0x128, 0xf, 0xf, false);
    v += __builtin_amdgcn_update_dpp(0, v, 0x124, 0xf, 0xf, false);
    v += __builtin_amdgcn_update_dpp(0, v, 0x122, 0xf, 0xf, false);
    v += __builtin_amdgcn_update_dpp(0, v, 0x121, 0xf, 0xf, false);
    return v;
}
__device__ __forceinline__ unsigned q4(float a, float b, float c, float d, float inv, int bias) {
    int qa = (int)rintf(a * inv), qb = (int)rintf(b * inv), qc = (int)rintf(c * inv), qd = (int)rintf(d * inv);
    qa = min(127, max(-127, qa)) + bias; qb = min(127, max(-127, qb)) + bias; qc = min(127, max(-127, qc)) + bias; qd = min(127, max(-127, qd)) + bias;
    return (unsigned)(qa & 255) | ((unsigned)(qb & 255) << 8) | ((unsigned)(qc & 255) << 16) | ((unsigned)(qd & 255) << 24);
}
__device__ __forceinline__ float wsum(float v) {
    v += WR_DPP(v, 0x128); v += WR_DPP(v, 0x124); v += WR_DPP(v, 0x122); v += WR_DPP(v, 0x121);
    return (WR_LANE(v, 0) + WR_LANE(v, 16)) + (WR_LANE(v, 32) + WR_LANE(v, 48));
}

#define XB_TMO      128
#define XB_XCNT(j)  (256  + 64 * (j))
#define XB_XSUB(j)  (1280 + 64 * (j))
#define XB_XGEN(j)  (2304 + 64 * (j))
#define XB_TOP      3328
#define XB_TOPGEN   3392
#define XCD_BAR_WORDS 3456
#define XB_SPIN_CAP (1u << 22)

__device__ __forceinline__ unsigned xb_ld(unsigned* p)              { return __hip_atomic_load(p, __ATOMIC_RELAXED, __HIP_MEMORY_SCOPE_AGENT); }
__device__ __forceinline__ unsigned xb_add(unsigned* p, unsigned v) { return __hip_atomic_fetch_add(p, v, __ATOMIC_RELAXED, __HIP_MEMORY_SCOPE_AGENT); }
__device__ __forceinline__ unsigned xb_xcc_id() { return (unsigned)__builtin_amdgcn_s_getreg((3 << 11) | 20) & 0xFu; }
#define XB_SPIN(cond, bar) do { unsigned _sp = 0; while (cond) { __builtin_amdgcn_s_sleep(1); \
    if ((++_sp & 255u) == 0u) { if (xb_ld(&(bar)[XB_TMO])) break; if (_sp > XB_SPIN_CAP) { atomicAdd(&(bar)[XB_TMO], 1u); break; } } } } while (0)

struct XcdBarrier { unsigned* bar; unsigned x; volatile LAS unsigned* st; };

__device__ __forceinline__ XcdBarrier xcd_barrier_post(unsigned* bar, volatile LAS unsigned* st) {
    XcdBarrier b; b.bar = bar; b.x = xb_xcc_id(); b.st = st;
    if (threadIdx.x == 0) (void)xb_add(&bar[XB_XCNT(b.x)], 1u);
    return b;
}
__device__ __forceinline__ void xcd_barrier_complete(unsigned* bar, unsigned x, unsigned& nloc, unsigned& nx) {
    const unsigned G = gridDim.x * gridDim.y * gridDim.z;
    unsigned sum, cnt, mine, sp = 0u;
    for (;;) {
        sum = 0u; cnt = 0u; mine = 0u;
#pragma unroll
        for (unsigned j = 0; j < 16; ++j) { const unsigned c = xb_ld(&bar[XB_XCNT(j)]); sum += c; cnt += (c > 0u) ? 1u : 0u; mine = (j == x) ? c : mine; }
        if (sum == G) break;
        __builtin_amdgcn_s_sleep(1);
        if ((++sp & 255u) == 0u) { if (xb_ld(&bar[XB_TMO])) break; if (sp > XB_SPIN_CAP) { atomicAdd(&bar[XB_TMO], 1u); break; } }
    }
    nloc = mine > 0u ? mine : 1u; nx = cnt > 0u ? cnt : 1u;
}
__device__ __forceinline__ void xcd_barrier(const XcdBarrier& b) {
    asm volatile("s_waitcnt vmcnt(0)" ::: "memory");
    __syncthreads();
    if (threadIdx.x == 0) {
        unsigned* bar = b.bar;
        __builtin_amdgcn_s_waitcnt(0);
        unsigned nloc = b.st[0], nx = b.st[1];
        if (nloc == 0u) { xcd_barrier_complete(bar, b.x, nloc, nx); b.st[0] = nloc; b.st[1] = nx; }
        const unsigned old = xb_add(&bar[XB_XSUB(b.x)], 1u);
        const unsigned gen = old / nloc;
        if (old + 1u == (gen + 1u) * nloc) {
            __builtin_amdgcn_fence(__ATOMIC_RELEASE, "agent");
            asm volatile("s_waitcnt vmcnt(0)" ::: "memory");
            const unsigned og = xb_add(&bar[XB_TOP], 1u);
            const unsigned tg = og / nx;
            if (og + 1u == (tg + 1u) * nx) xb_add(&bar[XB_TOPGEN], 1u);
            else XB_SPIN(xb_ld(&bar[XB_TOPGEN]) == tg, bar);
            __builtin_amdgcn_fence(__ATOMIC_ACQUIRE, "agent");
            xb_add(&bar[XB_XGEN(b.x)], 1u);
            asm volatile("s_waitcnt vmcnt(0)" ::: "memory");
        } else {
            XB_SPIN(xb_ld(&bar[XB_XGEN(b.x)]) == gen, bar);
            __builtin_amdgcn_fence(__ATOMIC_ACQUIRE, "agent");
            asm volatile("s_waitcnt vmcnt(0)" ::: "memory");
        }
    }
    __syncthreads();
}

struct Params { const float* in[24]; float* out; unsigned char* ws; int ph_lo, ph_hi; };
struct Frame { LAS unsigned char* lds; unsigned char* ws; int tid, lane, wave, G, bid; };

enum { I_X = 0, I_C, I_CTX, I_CCTX, I_WMOD, I_BMOD, I_GMIX, I_GCHAN, I_MLWIN, I_MLCW, I_MLCB, I_MLGB, I_MLHG, I_MLWOUT, I_CMWIN, I_CMGV, I_CMWS, I_CMBS, I_CMWOUT, I_PWQ, I_PKEYS, I_PU, I_PV, I_GFINAL };

struct EpiML {
    static constexpr bool PERM = true, AFTER_DRAIN = false;
    bf16* qk; bf16* vtr; bf16* og; int ctx; float asc;
    __device__ __forceinline__ void operator()(const pg8::f32x4 (&acc)[2][2][4][2], const pg8::Unit& u, int wr, int wc, int fr, int fq) const {
        asm volatile("" : "+v"(fr), "+v"(fq));
        const int row0 = u.pm * 256 + wr * 64 + fr; const int pn = u.pn; bf16* base = qk; int colt; bool sg = false, isv = false;
        if (!ctx) { if (pn < 8) { base = qk; colt = pn * 256; } else if (pn < 16) { isv = true; colt = (pn - 8) * 256; } else { base = og; colt = (pn - 16) * 256; sg = true; } }
        else { if (pn < 4) { base = qk; colt = 1024 + pn * 256; } else { isv = true; colt = (pn - 4) * 256; } }
        const int col0 = colt + wc * 32 + 8 * fq;
#pragma unroll
        for (int ai = 0; ai < 2; ++ai)
#pragma unroll
            for (int m = 0; m < 4; ++m) { const int r = row0 + ai * 128 + m * 16; bf16* rowp = base + (size_t)r * D + col0;
                const int b = ctx ? (r >> 8) : (r >> 13), k = ctx ? ((r >> 7) & 1) : 2 + ((r >> 7) & 63), s = r & 127;
                bf16* vp = vtr + (((size_t)b * NCHT + k) * D + col0) * CHK + s;
#pragma unroll
                for (int bj = 0; bj < 2; ++bj) { pg8::f32x4 v0 = acc[ai][bj][m][0] * asc, v1 = acc[ai][bj][m][1] * asc;
                    if (sg) {
#pragma unroll
                        for (int j = 0; j < 4; ++j) { v0[j] = sigmoidf_(v0[j]); v1[j] = sigmoidf_(v1[j]); } }
                    v4u w; w.x = pk2(v0[0], v0[1]); w.y = pk2(v0[2], v0[3]); w.z = pk2(v1[0], v1[1]); w.w = pk2(v1[2], v1[3]);
                    if (!isv) *(v4u*)(rowp + bj * 128) = w;
                    else { bf16* q = vp + (size_t)(bj * 128) * CHK;
                        q[0 * CHK] = (bf16)(w.x & 0xffffu); q[1 * CHK] = (bf16)(w.x >> 16); q[2 * CHK] = (bf16)(w.y & 0xffffu); q[3 * CHK] = (bf16)(w.y >> 16);
                        q[4 * CHK] = (bf16)(w.z & 0xffffu); q[5 * CHK] = (bf16)(w.z >> 16); q[6 * CHK] = (bf16)(w.w & 0xffffu); q[7 * CHK] = (bf16)(w.w >> 16); } } }
    }
};
struct EpiPlain {
    static constexpr bool PERM = true, AFTER_DRAIN = false;
    bf16* O; float asc;
    __device__ __forceinline__ void operator()(const pg8::f32x4 (&acc)[2][2][4][2], const pg8::Unit& u, int wr, int wc, int fr, int fq) const {
        asm volatile("" : "+v"(fr), "+v"(fq));
        const int row0 = u.pm * 256 + wr * 64 + fr; const int col0 = u.pn * 256 + wc * 32 + 8 * fq;
#pragma unroll
        for (int ai = 0; ai < 2; ++ai)
#pragma unroll
            for (int m = 0; m < 4; ++m) { bf16* rowp = O + (size_t)(row0 + ai * 128 + m * 16) * D + col0;
#pragma unroll
                for (int bj = 0; bj < 2; ++bj) { const pg8::f32x4 v0 = acc[ai][bj][m][0] * asc, v1 = acc[ai][bj][m][1] * asc;
                    v4u w; w.x = pk2(v0[0], v0[1]); w.y = pk2(v0[2], v0[3]); w.z = pk2(v1[0], v1[1]); w.w = pk2(v1[2], v1[3]);
                    *(v4u*)(rowp + bj * 128) = w; } }
    }
};
struct EpiCM {
    static constexpr bool PERM = true, AFTER_DRAIN = false;
    bf16* U; bf16* V; float* vssp; float asc;
    __device__ __forceinline__ void operator()(const pg8::f32x4 (&acc)[2][2][4][2], const pg8::Unit& u, int wr, int wc, int fr, int fq) const {
        asm volatile("" : "+v"(fr), "+v"(fq));
        const int row0 = u.pm * 256 + wr * 64 + fr; const bool isv = u.pn >= 8; bf16* base = isv ? V : U;
        const int col0 = (isv ? u.pn - 8 : u.pn) * 256 + wc * 32 + 8 * fq;
#pragma unroll
        for (int ai = 0; ai < 2; ++ai)
#pragma unroll
            for (int m = 0; m < 4; ++m) { const int row = row0 + ai * 128 + m * 16; bf16* rowp = base + (size_t)row * D + col0; float ss = 0.f;
#pragma unroll
                for (int bj = 0; bj < 2; ++bj) { pg8::f32x4 v0 = acc[ai][bj][m][0] * asc, v1 = acc[ai][bj][m][1] * asc;
#pragma unroll
                    for (int j = 0; j < 4; ++j) { v0[j] = gelu_tanh(v0[j]); v1[j] = gelu_tanh(v1[j]); ss += v0[j] * v0[j] + v1[j] * v1[j]; }
                    v4u w; w.x = pk2(v0[0], v0[1]); w.y = pk2(v0[2], v0[3]); w.z = pk2(v1[0], v1[1]); w.w = pk2(v1[2], v1[3]);
                    *(v4u*)(rowp + bj * 128) = w; }
                if (isv) {
                    { const unsigned b = __float_as_uint(ss); const auto r = __builtin_amdgcn_permlane16_swap(b, b, false, false); ss = __uint_as_float(r[0]) + __uint_as_float(r[1]); }
                    { const unsigned b = __float_as_uint(ss); const auto r = __builtin_amdgcn_permlane32_swap(b, b, false, false); ss = __uint_as_float(r[0]) + __uint_as_float(r[1]); }
                    if (fq == 0) vssp[(size_t)row * 32 + (u.pn - 8) * 4 + wc] = ss; } }
    }
};
template <bool BASE_BF16> struct EpiResid {
    static constexpr bool PERM = true, AFTER_DRAIN = false;
    const void* base; bf16* out; const float* gate; float asc;
    __device__ __forceinline__ void operator()(const pg8::f32x4 (&acc)[2][2][4][2], const pg8::Unit& u, int wr, int wc, int fr, int fq) const {
        asm volatile("" : "+v"(fr), "+v"(fq));
        const int row0 = u.pm * 256 + wr * 64 + fr, col0 = u.pn * 256 + wc * 32 + 8 * fq;
        const float* gt = gate + (size_t)((u.pm * 256) >> 13) * NMOD + col0;
        pg8::f32x4 gv[2][2];
#pragma unroll
        for (int bj = 0; bj < 2; ++bj)
#pragma unroll
            for (int n = 0; n < 2; ++n) gv[bj][n] = *(const pg8::f32x4*)(gt + bj * 128 + 4 * n) * asc;
#pragma unroll
        for (int ai = 0; ai < 2; ++ai)
#pragma unroll
            for (int m = 0; m < 4; ++m) { const size_t off = (size_t)(row0 + ai * 128 + m * 16) * D + col0;
#pragma unroll
                for (int bj = 0; bj < 2; ++bj) { pg8::f32x4 b0, b1;
                    if (BASE_BF16) { const v4u x = *(const v4u*)((const bf16*)base + off + bj * 128); b0 = (pg8::f32x4){bflo(x.x), bfhi(x.x), bflo(x.y), bfhi(x.y)}; b1 = (pg8::f32x4){bflo(x.z), bfhi(x.z), bflo(x.w), bfhi(x.w)}; }
                    else { b0 = __builtin_nontemporal_load((const pg8::f32x4*)((const float*)base + off + bj * 128)); b1 = __builtin_nontemporal_load((const pg8::f32x4*)((const float*)base + off + bj * 128 + 4)); }
                    const pg8::f32x4 r0 = b0 + gv[bj][0] * acc[ai][bj][m][0], r1 = b1 + gv[bj][1] * acc[ai][bj][m][1];
                    v4u w; w.x = pk2c(r0[0], r0[1]); w.y = pk2c(r0[2], r0[3]); w.z = pk2c(r1[0], r1[1]); w.w = pk2c(r1[2], r1[3]);
                    *(v4u*)(out + off + bj * 128) = w; } }
    }
};

__device__ __forceinline__ void tr_load(const float* W, int ldw, int nblk, int item, int lane, f32x4 (&r)[8]) {
    const int kb = item / nblk, nb = item % nblk, k0 = 64 * kb, n0 = 32 * nb, g = lane >> 3, c4 = lane & 7;
#pragma unroll
    for (int i = 0; i < 8; ++i) r[i] = __builtin_nontemporal_load((const f32x4*)(W + (size_t)(k0 + 8 * g + i) * ldw + n0 + 4 * c4));
}
__device__ __forceinline__ void tr_store_bf16(bf16* WT, int K, int nblk, int item, int lane, const f32x4 (&r)[8]) {
    const int kb = item / nblk, nb = item % nblk, k0 = 64 * kb, n0 = 32 * nb, g = lane >> 3, c4 = lane & 7;
#pragma unroll
    for (int c = 0; c < 4; ++c) { v4u o; o.x = pk2(r[0][c], r[1][c]); o.y = pk2(r[2][c], r[3][c]); o.z = pk2(r[4][c], r[5][c]); o.w = pk2(r[6][c], r[7][c]);
        *(v4u*)(WT + (size_t)(n0 + 4 * c4 + c) * K + k0 + 8 * g) = o; }
}
__device__ __forceinline__ void tr_store_fp8(unsigned char* WT, int K, int nblk, int item, int lane, const f32x4 (&r)[8], float scale) {
    const int kb = item / nblk, nb = item % nblk, k0 = 64 * kb, n0 = 32 * nb, g = lane >> 3, c4 = lane & 7;
#pragma unroll
    for (int c = 0; c < 4; ++c) { v2u o; o.x = pk4_fp8(r[0][c] * scale, r[1][c] * scale, r[2][c] * scale, r[3][c] * scale); o.y = pk4_fp8(r[4][c] * scale, r[5][c] * scale, r[6][c] * scale, r[7][c] * scale);
        *(v2u*)(WT + (size_t)(n0 + 4 * c4 + c) * K + k0 + 8 * g) = o; }
}
__device__ __forceinline__ void p0_prologue(const Frame& F, const Params& P) {
    unsigned char* ws = F.ws;
    const int gt = F.bid * NTHR + F.tid, NGT = F.G * NTHR;
    {
        LAS float* sil = (LAS float*)F.lds;
        LAS float* red = (LAS float*)(F.lds + 24576);
        for (int i = F.tid; i < 3 * D; i += NTHR) { const int r = i / D, k = i % D; const float cv = r < 2 ? P.in[I_C][r * D + k] : P.in[I_CCTX][k]; sil[i] = siluf_(cv); }
        __syncthreads();
        const int cg = F.tid & 15, rl = F.tid >> 4;
        for (int u = F.bid; u < 384; u += F.G) {
            const int layer = u / 192, col0 = (u % 192) * 64;
            const float* W = P.in[I_WMOD] + (size_t)layer * D * NMOD + col0 + cg * 4;
            float a[3][4];
#pragma unroll
            for (int r = 0; r < 3; ++r)
#pragma unroll
                for (int j = 0; j < 4; ++j) a[r][j] = 0.f;
#pragma unroll 8
            for (int k = rl; k < D; k += 32) {
                const f32x4 w = __builtin_nontemporal_load((const f32x4*)(W + (size_t)k * NMOD));
                const float s0 = sil[k], s1 = sil[D + k], s2 = sil[2 * D + k];
#pragma unroll
                for (int j = 0; j < 4; ++j) { a[0][j] += s0 * w[j]; a[1][j] += s1 * w[j]; a[2][j] += s2 * w[j]; }
            }
#pragma unroll
            for (int r = 0; r < 3; ++r)
#pragma unroll
                for (int j = 0; j < 4; ++j) red[(rl * 16 + cg) * 12 + r * 4 + j] = a[r][j];
            __syncthreads();
            if (F.tid < 192) { const int cj = F.tid & 63, r = F.tid >> 6; float s = 0.f;
                for (int q = 0; q < 32; ++q) s += red[(q * 16 + (cj >> 2)) * 12 + r * 4 + (cj & 3)];
                ((float*)(ws + WS_MODV))[((size_t)layer * 3 + r) * NMOD + col0 + cj] = s + P.in[I_BMOD][layer * NMOD + col0 + cj]; }
            __syncthreads();
        }
    }
    for (int i = gt; i < M; i += NGT) ((float*)(ws + WS_VSS))[i] = 0.f;
    for (int i = gt; i < 16 * D; i += NGT) { const int j = i / D, k = i % D; ((float*)(ws + WS_WG))[i] = P.in[I_MLWIN][(size_t)k * 6160 + 6144 + j]; }
    for (int i = gt; i < 2 * 8 * 2 * 128 * 128 / 2; i += NGT) { const float a = P.in[I_PKEYS][2 * i], b = P.in[I_PKEYS][2 * i + 1]; ((unsigned*)(ws + WS_KEYS))[i] = pk2(a, b); }
    {
        const int gw = F.bid * NWAVES + F.wave, NGW = F.G * NWAVES;
        constexpr int I0 = 32 * 192, I1 = 32 * 64, I2 = 32 * 128;
        constexpr int NIT = I0 + I1 + I1 + I2 + I1 + I1;
        for (int it = gw; it < NIT; it += NGW) {
            f32x4 r[8]; int q = it;
            if (q < I0) { tr_load(P.in[I_MLWIN], 6160, 192, q, F.lane, r); tr_store_fp8(ws + WS_WIN0, D, 192, q, F.lane, r, W8_SCALE); continue; } q -= I0;
            if (q < I1) { tr_load(P.in[I_MLWOUT], D, 64, q, F.lane, r); tr_store_fp8(ws + WS_WOUT0, D, 64, q, F.lane, r, W8_SCALE); continue; } q -= I1;
            if (q < I1) { tr_load(P.in[I_PWQ], D, 64, q, F.lane, r); tr_store_bf16((bf16*)(ws + WS_WQ0), D, 64, q, F.lane, r); continue; } q -= I1;
            if (q < I2) { tr_load(P.in[I_CMWIN], 4096, 128, q, F.lane, r); tr_store_fp8(ws + WS_WIN1, D, 128, q, F.lane, r, W8_SCALE); continue; } q -= I2;
            if (q < I1) { tr_load(P.in[I_CMWOUT], D, 64, q, F.lane, r); tr_store_fp8(ws + WS_WOUT1, D, 64, q, F.lane, r, W8_SCALE); continue; } q -= I1;
            tr_load(P.in[I_PWQ] + (size_t)D * D, D, 64, q, F.lane, r); tr_store_fp8(ws + WS_WQ1, D, 64, q, F.lane, r, W8_SCALE);
        }
    }
}

template <bool GATES, bool QUANT = false, bool SRC_BF16 = false, bool OUT_FP8 = false>
__device__ __forceinline__ void adaln_phase(const Frame& F, const void* srcAv, const float* srcB, int nctx, const float* gvec, const float* modv, int shoff, int scoff, bf16* dst,
                                            const float* wg, const float* gate_b, float* gates) {
    LAS float* wgl = (LAS float*)F.lds;
    if (GATES) { for (int i = F.tid; i < 16 * D / 4; i += NTHR) ((LAS f32x4*)wgl)[i] = ((const f32x4*)wg)[i]; __syncthreads(); }
    const int gw = F.bid * NWAVES + F.wave, NGW = F.G * NWAVES, lane = F.lane;
    const float* srcA = (const float*)srcAv; const bf16* srcAb = (const bf16*)srcAv;
    f32x4 nf[8]; v2u nb[8];
    if (gw < M + nctx) {
        const float* xr0 = gw < M ? srcA + (size_t)gw * D : srcB + (size_t)(gw - M) * D;
#pragma unroll
        for (int j = 0; j < 8; ++j) { if (SRC_BF16) nb[j] = ((const v2u*)(srcAb + (size_t)gw * D))[lane + 64 * j]; else nf[j] = ((const f32x4*)xr0)[lane + 64 * j]; } }
    for (int row = gw; row < M + nctx; row += NGW) {
        const float* mv = modv + (size_t)(row < M ? (row >> 13) : 2) * NMOD;
        f32x4 v[8]; float s = 0.f;
#pragma unroll
        for (int j = 0; j < 8; ++j) { if (SRC_BF16) v[j] = (f32x4){bflo(nb[j].x), bfhi(nb[j].x), bflo(nb[j].y), bfhi(nb[j].y)}; else v[j] = nf[j];
            s += (v[j][0] * v[j][0] + v[j][1] * v[j][1]) + (v[j][2] * v[j][2] + v[j][3] * v[j][3]); }
        { const int rn = (row + NGW < M + nctx) ? row + NGW : row;
          const float* xrn = rn < M ? srcA + (size_t)rn * D : srcB + (size_t)(rn - M) * D;
#pragma unroll
          for (int j = 0; j < 8; ++j) { if (SRC_BF16) nb[j] = ((const v2u*)(srcAb + (size_t)rn * D))[lane + 64 * j]; else nf[j] = ((const f32x4*)xrn)[lane + 64 * j]; } }
        const float rstd = 1.0f / sqrtf(wsum(s) * (1.0f / D) + EPS);
        v2u* o8 = (v2u*)(dst + (size_t)row * D);
#pragma unroll
        for (int j = 0; j < 8; ++j) { const int c4 = lane + 64 * j;
            const f32x4 g4 = ((const f32x4*)gvec)[c4], sc = ((const f32x4*)(mv + scoff))[c4], sh = ((const f32x4*)(mv + shoff))[c4];
            v[j] = v[j] * rstd * g4 * (sc + 1.0f) + sh;
            if (OUT_FP8) ((unsigned*)((unsigned char*)dst + (size_t)row * D))[c4] = pk4_fp8(v[j][0], v[j][1], v[j][2], v[j][3]);
            else { v2u w; w.x = pk2(v[j][0], v[j][1]); w.y = pk2(v[j][2], v[j][3]); o8[c4] = w; } }
        if (QUANT) {
            float mx = 0.f;
#pragma unroll
            for (int j = 0; j < 8; ++j) mx = fmaxf(mx, fmaxf(fmaxf(fabsf(v[j][0]), fabsf(v[j][1])), fmaxf(fabsf(v[j][2]), fabsf(v[j][3]))));
            mx = wmaxf_all(mx);
            const float sc = mx > 0.f ? mx * (1.0f / 119.0f) : 1.0f, inv = 1.0f / sc;
            unsigned short* xh = (unsigned short*)(F.ws + WS_XQ + (size_t)row * D); unsigned short* xl = xh + 512; int xs = 0;
#pragma unroll
            for (int j = 0; j < 8; ++j) { unsigned wh = 0u, wl = 0u;
#pragma unroll
                for (int i = 0; i < 4; ++i) { int q = (int)rintf(v[j][i] * inv); q = min(119, max(-119, q)); xs += q; const int ql = ((q + 8) & 15) - 8, qh = (q - ql) >> 4; wl |= (unsigned)(ql & 15) << (4 * i); wh |= (unsigned)(qh & 15) << (4 * i); }
                xh[lane + 64 * j] = (unsigned short)wh; xl[lane + 64 * j] = (unsigned short)wl; }
            xs = row16_sum_i32(xs); xs = (__builtin_amdgcn_readlane(xs, 0) + __builtin_amdgcn_readlane(xs, 16)) + (__builtin_amdgcn_readlane(xs, 32) + __builtin_amdgcn_readlane(xs, 48));
            if (lane == 0) { ((float*)(F.ws + WS_SX))[2 * row] = sc; ((float*)(F.ws + WS_SX))[2 * row + 1] = (float)xs; }
        }
        if (GATES) {
            float a[16];
#pragma unroll
            for (int q = 0; q < 16; ++q) { float t = 0.f;
#pragma unroll
                for (int j = 0; j < 8; ++j) { const f32x4 w4 = ((const LAS f32x4*)(wgl + q * D))[lane + 64 * j]; t += (v[j][0] * w4[0] + v[j][1] * w4[1]) + (v[j][2] * w4[2] + v[j][3] * w4[3]); }
                a[q] = t; __builtin_amdgcn_sched_barrier(0); }
            const bool h5 = (lane & 32) != 0, h4 = (lane & 16) != 0, h3 = (lane & 8) != 0, h2 = (lane & 4) != 0;
            float b8[8], b4[4], b2[2], b1;
#pragma unroll
            for (int i = 0; i < 8; ++i) { const float keep = h5 ? a[8 + i] : a[i], give = h5 ? a[i] : a[8 + i]; b8[i] = keep + __shfl_xor(give, 32); }
#pragma unroll
            for (int i = 0; i < 4; ++i) { const float keep = h4 ? b8[4 + i] : b8[i], give = h4 ? b8[i] : b8[4 + i]; b4[i] = keep + __shfl_xor(give, 16); }
#pragma unroll
            for (int i = 0; i < 2; ++i) { const float keep = h3 ? b4[2 + i] : b4[i], give = h3 ? b4[i] : b4[2 + i]; b2[i] = keep + __shfl_xor(give, 8); }
            { const float keep = h2 ? b2[1] : b2[0], give = h2 ? b2[0] : b2[1]; b1 = keep + __shfl_xor(give, 4); }
            b1 += __shfl_xor(b1, 2); b1 += __shfl_xor(b1, 1);
            if ((lane & 3) == 0) { const int q = (h5 ? 8 : 0) + (h4 ? 4 : 0) + (h3 ? 2 : 0) + (h2 ? 1 : 0);
                float gq = b1 + gate_b[q]; if ((q >> 2) & 1) gq = log_sigmoid(gq); gates[(size_t)row * 16 + q] = gq; }
        }
    }
}

__device__ __forceinline__ void p1_adaln_gates(const Frame& F, const float* srcA, const float* srcB, int nctx, const float* gvec, const float* modv, int shoff, int scoff, unsigned char* dst,
                                               const float* wg, const float* gate_b, float* gates) {
    constexpr int LDW = 2056;
    LAS bf16* wgb = (LAS bf16*)F.lds;
    LAS bf16* tile = (LAS bf16*)(F.lds + 16 * LDW * 2);
    LAS float* part = (LAS float*)(F.lds + 2 * 16 * LDW * 2);
    const int lane = F.lane, w = F.wave, fr = lane & 15, fq = lane >> 4, tid = F.tid;
    for (int i = tid; i < 16 * D / 4; i += NTHR) { const f32x4 x = ((const f32x4*)wg)[i]; const int q = (4 * i) / D, k = (4 * i) % D;
        v2u o; o.x = pk2(x[0], x[1]); o.y = pk2(x[2], x[3]); *(LAS v2u*)(wgb + q * LDW + k) = o; }
    __syncthreads();
    const int NR = M + nctx, NG = (NR + 15) / 16;
    for (int gi = F.bid; gi < NG; gi += F.G) {
        const int r0 = gi * 16;
#pragma unroll
        for (int rr = 0; rr < 2; ++rr) {
            const int rl = 2 * w + rr, row = r0 + rl;
            if (row < NR) {
                const float* xr = row < M ? srcA + (size_t)row * D : srcB + (size_t)(row - M) * D;
                const float* mv = modv + (size_t)(row < M ? (row >> 13) : 2) * NMOD;
                f32x4 v[8]; float s = 0.f;
#pragma unroll
                for (int j = 0; j < 8; ++j) { v[j] = __builtin_nontemporal_load((const f32x4*)xr + lane + 64 * j); s += (v[j][0] * v[j][0] + v[j][1] * v[j][1]) + (v[j][2] * v[j][2] + v[j][3] * v[j][3]); }
                const float rstd = 1.0f / sqrtf(wsum(s) * (1.0f / D) + EPS);
#pragma unroll
                for (int j = 0; j < 8; ++j) { const int c4 = lane + 64 * j;
                    const f32x4 g4 = ((const f32x4*)gvec)[c4], sc = ((const f32x4*)(mv + scoff))[c4], sh = ((const f32x4*)(mv + shoff))[c4];
                    v[j] = v[j] * rstd * g4 * (sc + 1.0f) + sh;
                    ((unsigned*)(dst + (size_t)row * D))[c4] = pk4_fp8(v[j][0], v[j][1], v[j][2], v[j][3]);
                    v2u o; o.x = pk2(v[j][0], v[j][1]); o.y = pk2(v[j][2], v[j][3]); *(LAS v2u*)(tile + rl * LDW + 4 * c4) = o; }
            } else {
#pragma unroll
                for (int j = 0; j < 8; ++j) *(LAS v2u*)(tile + rl * LDW + 4 * (lane + 64 * j)) = (v2u){0u, 0u};
            }
        }
        __syncthreads();
        { f32x4 acc = (f32x4){0.f, 0.f, 0.f, 0.f};
#pragma unroll
          for (int ks = 0; ks < 8; ++ks) { const int k0 = 256 * w + 32 * ks + 8 * fq;
              const bf16x8 af = *(const LAS bf16x8*)(wgb + fr * LDW + k0), bfr = *(const LAS bf16x8*)(tile + fr * LDW + k0);
              acc = __builtin_amdgcn_mfma_f32_16x16x32_bf16(af, bfr, acc, 0, 0, 0); }
#pragma unroll
          for (int r = 0; r < 4; ++r) part[w * 256 + (4 * fq + r) * 16 + fr] = acc[r]; }
        __syncthreads();
        if (tid < 256) { const int q = tid >> 4, cI = tid & 15, row = r0 + cI; float s = 0.f;
#pragma unroll
            for (int ww = 0; ww < 8; ++ww) s += part[ww * 256 + tid];
            if (row < NR) { float gq = s + gate_b[q]; if ((q >> 2) & 1) gq = log_sigmoid(gq); gates[(size_t)row * 16 + q] = gq; } }
    }
}

__device__ __forceinline__ void wscan_add2(float& a, float& b, int lane) {
    float t = a + b;
#pragma unroll
    for (int o = 1; o < 64; o <<= 1) { const float u = __shfl_up(t, o); if (lane >= o) t += u; }
    const float excl = t - (a + b); a = excl + a; b = a + b;
}
__device__ __forceinline__ void wscan_max2(float& a, float& b, int lane) {
    float t = fmaxf(a, b);
#pragma unroll
    for (int o = 1; o < 64; o <<= 1) { const float u = __shfl_up(t, o); if (lane >= o) t = fmaxf(t, u); }
    float excl = __shfl_up(t, 1); if (lane == 0) excl = -INFINITY;
    a = fmaxf(excl, a); b = fmaxf(a, b);
}
__device__ __forceinline__ float wmaxall(float v) {
#pragma unroll
    for (int o = 1; o < 64; o <<= 1) v = fmaxf(v, __shfl_xor(v, o));
    return v;
}

__device__ __forceinline__ void p3_conv(const Frame& F, const Params& P) {
    unsigned char* ws = F.ws;
    const bf16* QKRAW = (const bf16*)(ws + WS_QKRAW); const bf16* VV = (const bf16*)(ws + WS_V);
    bf16* QC = (bf16*)(ws + WS_QC); bf16* KC = (bf16*)(ws + WS_KC); bf16* VTR = (bf16*)(ws + WS_VTR);
    const float* GATES = (const float*)(ws + WS_GATES);
    const float* cw = P.in[I_MLCW]; const float* cbias = P.in[I_MLCB];
    LAS float* wl = (LAS float*)F.lds;
    LAS bf16* tile = (LAS bf16*)(F.lds + 4096);
    constexpr int U_GS = 16, U_LC = 4096, U_LV = 0, U_CC = 64, U_CV = 0, U_ALL = U_GS + U_LC + U_LV + U_CC + U_CV;
    for (int uu = F.bid; uu < U_GS + U_CC; uu += F.G) {
        const int u = uu < U_GS ? uu : uu + U_LC + U_LV;
        int r = u;
        if (r < U_GS) {
            const int dir = r >> 3, b = (r >> 2) & 1, h = r & 3;
            LAS float* beta = (LAS float*)(F.lds + 8192);
            LAS float* bend = (LAS float*)(F.lds + 8192 + 66 * 512);
            LAS float* wmx = bend + 66; LAS float* mnw = wmx + 66;
            float* BCUM = (float*)(ws + WS_BCUM) + (size_t)r * SEQ; float* WST = (float*)(ws + WS_WST) + (size_t)r * (NCHT * CHK);
            float* MPREV = (float*)(ws + WS_MPREV) + r * NCHT; float* ASTATE = (float*)(ws + WS_ASTATE) + r * NCHT;
            for (int k = F.wave; k < NCHT; k += NWAVES) {
                const int row0 = k < 2 ? M + b * CTXL + k * CHK : b * SEQ + (k - 2) * CHK;
                const int j0 = 2 * F.lane, j1 = j0 + 1, s0 = dir ? 127 - j0 : j0, s1 = dir ? 127 - j1 : j1;
                const float f0 = GATES[(size_t)(row0 + s0) * 16 + (2 * dir + 1) * 4 + h], f1 = GATES[(size_t)(row0 + s1) * 16 + (2 * dir + 1) * 4 + h];
                const float i0 = GATES[(size_t)(row0 + s0) * 16 + (2 * dir) * 4 + h], i1 = GATES[(size_t)(row0 + s1) * 16 + (2 * dir) * 4 + h];
                float b0 = f0, b1 = f1; wscan_add2(b0, b1, F.lane);
                const float be = __shfl(b1, 63);
                const float t0 = i0 - b0, t1 = i1 - b1;
                beta[k * 128 + s0] = t0; beta[k * 128 + s1] = t1;
                const float wm = wmaxall(fmaxf(t0, t1)) + be;
                if (F.lane == 0) { bend[k] = be; wmx[k] = wm; }
                if (k >= 2) { BCUM[(k - 2) * CHK + s0] = b0; BCUM[(k - 2) * CHK + s1] = b1; }
            }
            __syncthreads();
            if (F.tid == 0) { float m = 0.f;
                for (int idx = 0; idx < NCHT; ++idx) { const int k = dir ? (idx < 2 ? 1 - idx : 67 - idx) : idx;
                    const float mn = fmaxf(bend[k] + m, wmx[k]); MPREV[k] = m; ASTATE[k] = expf(bend[k] + m - mn); mnw[k] = mn; m = mn; } }
            __syncthreads();
            for (int i = F.tid; i < NCHT * CHK; i += NTHR) { const int k = i >> 7; WST[i] = expf(bend[k] + beta[i] - mnw[k]); }
            __syncthreads();
            continue;
        }
        r -= U_GS;
        if (r < U_LC || (r >= U_LC + U_LV && r < U_LC + U_LV + U_CC)) {
            const bool isctx = r >= U_LC; if (isctx) r -= U_LC + U_LV;
            int b, c, cb;
            if (!isctx) { cb = r & 31; c = (r >> 5) & 63; b = r >> 11; } else { cb = 16 + (r & 15); c = (r >> 4) & 1; b = r >> 5; }
            const int chb = cb * 64;
            for (int i = F.tid; i < 9 * 64 + 64; i += NTHR) wl[i] = i < 576 ? cw[(i >> 6) * D + chb + (i & 63)] : cbias[chb + (i - 576)];
            __syncthreads();
#pragma unroll 1
            for (int it = 0; it < 2; ++it) {
                const int item = F.tid + NTHR * it, tl = item >> 3, cg = item & 7, ch0 = chb + cg * 8;
                float a[8];
#pragma unroll
                for (int q = 0; q < 8; ++q) a[q] = wl[576 + cg * 8 + q];
                if (!isctx) {
                    const int t = c * CHK + tl, gr = t >> 6, gc = t & 63;
#pragma unroll
                    for (int di = 0; di < 3; ++di)
#pragma unroll
                        for (int dj = 0; dj < 3; ++dj) { const int rr = gr + di - 1, c2 = gc + dj - 1;
                            if (rr >= 0 && rr < 128 && c2 >= 0 && c2 < 64) {
                                const v4u x = *(const v4u*)(QKRAW + ((size_t)b * SEQ + rr * 64 + c2) * D + ch0);
                                const LAS float* w = wl + (di * 3 + dj) * 64 + cg * 8;
                                a[0] += bflo(x.x) * w[0]; a[1] += bfhi(x.x) * w[1]; a[2] += bflo(x.y) * w[2]; a[3] += bfhi(x.y) * w[3];
                                a[4] += bflo(x.z) * w[4]; a[5] += bfhi(x.z) * w[5]; a[6] += bflo(x.w) * w[6]; a[7] += bfhi(x.w) * w[7]; } }
                } else {
                    const int s = c * CHK + tl;
#pragma unroll
                    for (int dj = 0; dj < 3; ++dj) { const int s2 = s + dj - 1;
                        if (s2 >= 0 && s2 < CTXL) {
                            const v4u x = *(const v4u*)(QKRAW + ((size_t)M + b * CTXL + s2) * D + ch0);
                            const LAS float* w = wl + (3 + dj) * 64 + cg * 8;
                            a[0] += bflo(x.x) * w[0]; a[1] += bfhi(x.x) * w[1]; a[2] += bflo(x.y) * w[2]; a[3] += bfhi(x.y) * w[3];
                            a[4] += bflo(x.z) * w[4]; a[5] += bfhi(x.z) * w[5]; a[6] += bflo(x.w) * w[6]; a[7] += bfhi(x.w) * w[7]; } }
                }
                const float sc = ch0 >= 1024 ? 0.0625f : 1.0f;
#pragma unroll
                for (int q = 0; q < 8; ++q) a[q] = siluf_(a[q]) * sc;
                v4u o; o.x = pk2(a[0], a[1]); o.y = pk2(a[2], a[3]); o.z = pk2(a[4], a[5]); o.w = pk2(a[6], a[7]);
                const size_t row = isctx ? (size_t)M + b * CTXL + c * CHK + tl : (size_t)b * SEQ + c * CHK + tl;
                if (ch0 < 1024) { *(v4u*)(QC + row * 1024 + ch0) = o; v2u o8; o8.x = pk4_fp8(a[0], a[1], a[2], a[3]); o8.y = pk4_fp8(a[4], a[5], a[6], a[7]); *(v2u*)(ws + WS_QC8 + row * 1024 + ch0) = o8; }
                else *(v4u*)(KC + row * 1024 + (ch0 - 1024)) = o;
            }
            __syncthreads();
            continue;
        }
        {
            int b, k, cb;
            if (r < U_LC + U_LV) { r -= U_LC; cb = r & 31; k = 2 + ((r >> 5) & 63); b = r >> 11; } else { r -= U_LC + U_LV + U_CC; cb = r & 31; k = (r >> 5) & 1; b = r >> 6; }
            const size_t row0 = k < 2 ? (size_t)M + b * CTXL + k * CHK : (size_t)b * SEQ + (k - 2) * CHK;
#pragma unroll
            for (int it = 0; it < 2; ++it) { const int item = F.tid + NTHR * it, s = item >> 3, cg = item & 7;
                const v4u x = *(const v4u*)(VV + (row0 + s) * D + cb * 64 + cg * 8);
                LAS unsigned* tp = (LAS unsigned*)(tile + s * 66 + cg * 8); tp[0] = x.x; tp[1] = x.y; tp[2] = x.z; tp[3] = x.w; }
            __syncthreads();
#pragma unroll
            for (int it = 0; it < 2; ++it) { const int item = F.tid + NTHR * it, sg = item & 15, e = item >> 4;
                unsigned short q[8];
#pragma unroll
                for (int i = 0; i < 8; ++i) q[i] = tile[(sg * 8 + i) * 66 + e];
                v4u o; o.x = q[0] | ((unsigned)q[1] << 16); o.y = q[2] | ((unsigned)q[3] << 16); o.z = q[4] | ((unsigned)q[5] << 16); o.w = q[6] | ((unsigned)q[7] << 16);
                *(v4u*)(VTR + (((size_t)b * NCHT + k) * D + cb * 64 + e) * CHK + sg * 8) = o; }
            __syncthreads();
        }
    }
    {
        LAS unsigned char* tl2 = F.lds + 4096;
        const bool skip16 = F.G > 32; const int nb = skip16 ? F.G - 16 : F.G, b0 = skip16 ? F.bid - 16 : F.bid;
        if (b0 >= 0) {
            v4u pre[4]; float wreg[2];
#define P3_FETCH(R) do { const int r_ = (R), b_ = r_ >> 11, c_ = (r_ >> 5) & 63, chb_ = (r_ & 31) * 64; \
                _Pragma("unroll") for (int it = 0; it < 4; ++it) { const int item = F.tid + NTHR * it, tok = item >> 3, cg = item & 7, grow = 2 * c_ - 1 + (tok >> 6); \
                    pre[it] = (v4u){0u, 0u, 0u, 0u}; if (grow >= 0 && grow < 128) pre[it] = *(const v4u*)(QKRAW + ((size_t)b_ * SEQ + grow * 64 + (tok & 63)) * D + chb_ + cg * 8); } \
                wreg[0] = cw[(F.tid >> 6) * D + chb_ + (F.tid & 63)]; \
                wreg[1] = 0.f; if (F.tid < 128) { const int i = 512 + F.tid; wreg[1] = i < 576 ? cw[(i >> 6) * D + chb_ + (i & 63)] : cbias[chb_ + (i - 576)]; } } while (0)
            int r = b0;
            if (r < U_LC) P3_FETCH(r);
#pragma unroll 1
            for (; r < U_LC; r += nb) {
                const int b = r >> 11, c = (r >> 5) & 63, chb = (r & 31) * 64;
#pragma unroll
                for (int it = 0; it < 4; ++it) { const int item = F.tid + NTHR * it; *(LAS v4u*)(tl2 + (item >> 3) * 144 + (item & 7) * 16) = pre[it]; }
                wl[F.tid] = wreg[0]; if (F.tid < 128) wl[512 + F.tid] = wreg[1];
                __syncthreads();
                if (r + nb < U_LC) P3_FETCH(r + nb);
#pragma unroll 1
                for (int it = 0; it < 2; ++it) {
                    const int item = F.tid + NTHR * it, tl = item >> 3, cg = item & 7, ch0 = chb + cg * 8, gc = tl & 63;
                    float a[8];
#pragma unroll
                    for (int q = 0; q < 8; ++q) a[q] = wl[576 + cg * 8 + q];
#pragma unroll
                    for (int di = 0; di < 3; ++di)
#pragma unroll
                        for (int dj = 0; dj < 3; ++dj) { const int c2 = gc + dj - 1;
                            if (c2 >= 0 && c2 < 64) {
                                const v4u x = *(const LAS v4u*)(tl2 + (64 + tl + (di - 1) * 64 + dj - 1) * 144 + cg * 16);
                                const LAS float* w = wl + (di * 3 + dj) * 64 + cg * 8;
                                a[0] += bflo(x.x) * w[0]; a[1] += bfhi(x.x) * w[1]; a[2] += bflo(x.y) * w[2]; a[3] += bfhi(x.y) * w[3];
                                a[4] += bflo(x.z) * w[4]; a[5] += bfhi(x.z) * w[5]; a[6] += bflo(x.w) * w[6]; a[7] += bfhi(x.w) * w[7]; } }
                    const float sc = ch0 >= 1024 ? 0.0625f : 1.0f;
#pragma unroll
                    for (int q = 0; q < 8; ++q) a[q] = siluf_(a[q]) * sc;
                    v4u o; o.x = pk2(a[0], a[1]); o.y = pk2(a[2], a[3]); o.z = pk2(a[4], a[5]); o.w = pk2(a[6], a[7]);
                    const size_t row = (size_t)b * SEQ + c * CHK + tl;
                    if (ch0 < 1024) { *(v4u*)(QC + row * 1024 + ch0) = o; v2u o8; o8.x = pk4_fp8(a[0], a[1], a[2], a[3]); o8.y = pk4_fp8(a[4], a[5], a[6], a[7]); *(v2u*)(ws + WS_QC8 + row * 1024 + ch0) = o8; }
                    else *(v4u*)(KC + row * 1024 + (ch0 - 1024)) = o;
                }
                __syncthreads();
            }
#undef P3_FETCH
        }
    }
}

__device__ __forceinline__ f32x4 mfma16(bf16x8 a, bf16x8 b, f32x4 c) { return __builtin_amdgcn_mfma_f32_16x16x32_bf16(a, b, c, 0, 0, 0); }

__device__ __forceinline__ void p4_intra(const Frame& F) {
    unsigned char* ws = F.ws;
    const bf16* QC = (const bf16*)(ws + WS_QC); const bf16* KC = (const bf16*)(ws + WS_KC);
    const float* GATES = (const float*)(ws + WS_GATES);
    bf16* PM = (bf16*)(ws + WS_PM);
    float* AINT = (float*)(ws + WS_AINT); float* EXPNM = (float*)(ws + WS_EXPNM);
    LAS bf16* Qs = (LAS bf16*)F.lds;
    LAS bf16* Ks = (LAS bf16*)(F.lds + 67584);
    LAS float* vec = (LAS float*)(F.lds + 135168);
    const int lane = F.lane, w = F.wave, fr = lane & 15, fq = lane >> 4;
    v4u pk_[8], pq_[8]; float pv_[3];
#define P4_DECODE(U, dir, b, h, k, lat) const bool lat = (U) < 1024; int dir, b, h, k; \
        if (lat) { dir = (U) & 1; k = 2 + (((U) >> 1) & 63); h = ((U) >> 7) & 3; b = (U) >> 9; } else { const int r_ = (U) - 1024; dir = r_ & 1; k = (r_ >> 1) & 1; h = (r_ >> 2) & 3; b = r_ >> 4; }
#define P4_FETCH(U) do { P4_DECODE(U, dir_, b_, h_, k_, lat_) const int seq_ = dir_ * 8 + b_ * 4 + h_; \
        const size_t row0_ = k_ < 2 ? (size_t)M + b_ * CTXL + k_ * CHK : (size_t)b_ * SEQ + (k_ - 2) * CHK; \
        _Pragma("unroll") for (int it = 0; it < 8; ++it) { const int item = F.tid + NTHR * it, row = item >> 5, ch = item & 31; \
            pk_[it] = *(const v4u*)(KC + (row0_ + row) * 1024 + h_ * 256 + ch * 8); \
            if (lat_) pq_[it] = *(const v4u*)(QC + (row0_ + row) * 1024 + h_ * 256 + ch * 8); } \
        if (F.tid < 128) { const int s = F.tid; \
            pv_[2] = ((const float*)(ws + WS_WST))[(size_t)seq_ * (NCHT * CHK) + k_ * CHK + s]; \
            if (lat_) { pv_[0] = ((const float*)(ws + WS_BCUM))[(size_t)seq_ * SEQ + (k_ - 2) * CHK + s]; pv_[1] = GATES[(row0_ + s) * 16 + 2 * dir_ * 4 + h_]; } } } while (0)
    if (F.bid < 1024 + 32) P4_FETCH(F.bid);
    for (int u = F.bid; u < 1024 + 32; u += F.G) {
        P4_DECODE(u, dir, b, h, k, lat)
        const int seq = dir * 8 + b * 4 + h;
#pragma unroll
        for (int it = 0; it < 8; ++it) { const int item = F.tid + NTHR * it, row = item >> 5, ch = item & 31;
            *(LAS v4u*)(Ks + row * 264 + ch * 8) = pk_[it];
            if (lat) *(LAS v4u*)(Qs + row * 264 + ch * 8) = pq_[it]; }
        if (F.tid < 128) { const int s = F.tid;
            vec[256 + s] = pv_[2];
            if (lat) { vec[s] = pv_[0]; vec[128 + s] = pv_[1] - pv_[0]; } }
        __syncthreads();
        if (u + F.G < 1024 + 32) P4_FETCH(u + F.G);
        if (lat) {
            if (w == 0) {
                const int j0 = 2 * lane, j1 = j0 + 1, s0 = dir ? 127 - j0 : j0, s1 = dir ? 127 - j1 : j1;
                float p0 = vec[128 + s0], p1 = vec[128 + s1]; wscan_max2(p0, p1, lane);
                const float mprev = ((const float*)(ws + WS_MPREV))[seq * NCHT + k];
                const float m0 = fmaxf(mprev, p0), m1 = fmaxf(mprev, p1);
                vec[384 + s0] = -m0; vec[384 + s1] = -m1;
                AINT[(size_t)u * CHK + s0] = expf(mprev - m0); AINT[(size_t)u * CHK + s1] = expf(mprev - m1);
                EXPNM[(size_t)u * CHK + s0] = expf(-(vec[s0] + m0)); EXPNM[(size_t)u * CHK + s1] = expf(-(vec[s1] + m1));
            }
            __syncthreads();
            f32x4 acc[8];
#pragma unroll
            for (int st = 0; st < 8; ++st) acc[st] = (f32x4){0.f, 0.f, 0.f, 0.f};
#pragma unroll
#define P4_LIVE(ST) (dir ? ((ST) >= w) : ((ST) <= w))
            for (int ks = 0; ks < 8; ++ks) {
                const bf16x8 qf = *(const LAS bf16x8*)(Qs + (16 * w + fr) * 264 + ks * 32 + 8 * fq);
#pragma unroll
                for (int st = 0; st < 8; ++st) if (P4_LIVE(st)) { const bf16x8 kf = *(const LAS bf16x8*)(Ks + (16 * st + fr) * 264 + ks * 32 + 8 * fq); acc[st] = mfma16(kf, qf, acc[st]); }
            }
            const int t = 16 * w + fr; const float al = vec[384 + t];
#pragma unroll
            for (int st = 0; st < 8; ++st) { const int sb = 16 * st + 4 * fq;
                if (P4_LIVE(st)) { float p[4];
#pragma unroll
                    for (int r = 0; r < 4; ++r) { const int s = sb + r; const bool ok = dir ? (s >= t) : (s <= t);
                        p[r] = ok ? expf(fminf(al + vec[128 + s], 0.f)) * acc[st][r] : 0.f; }
                    v2u o; o.x = pk2c(p[0], p[1]); o.y = pk2c(p[2], p[3]);
                    *(v2u*)(PM + ((size_t)u * CHK + t) * CHK + sb) = o; }
                else if ((st >> 1) == (w >> 1)) *(v2u*)(PM + ((size_t)u * CHK + t) * CHK + sb) = (v2u){0u, 0u};
            }
#undef P4_LIVE
        }
        {
            unsigned char* dstc = ws + WS_WKT + ((size_t)seq * NCHT + k) * (256 * 128);
#pragma unroll
            for (int it = 0; it < 4; ++it) { const int item = F.tid + NTHR * it, d = item >> 3, sg = item & 7; float q[16];
#pragma unroll
                for (int i = 0; i < 16; ++i) { const int s = sg * 16 + i; q[i] = bf2f(Ks[s * 264 + d]) * vec[256 + s] * 64.0f; }
                v4u o; o.x = pk4_fp8(q[0], q[1], q[2], q[3]); o.y = pk4_fp8(q[4], q[5], q[6], q[7]); o.z = pk4_fp8(q[8], q[9], q[10], q[11]); o.w = pk4_fp8(q[12], q[13], q[14], q[15]);
                *(v4u*)(dstc + (size_t)item * 16) = o; }
        }
        __syncthreads();
    }
}

#undef P4_FETCH
#undef P4_DECODE
__device__ __forceinline__ void p5_scan(const Frame& F) {
    unsigned char* ws = F.ws;
    const bf16* PM = (const bf16*)(ws + WS_PM); const unsigned char* WKT = ws + WS_WKT; const bf16* VTR = (const bf16*)(ws + WS_VTR);
    const float* AINT = (const float*)(ws + WS_AINT); const float* EXPNM = (const float*)(ws + WS_EXPNM); const float* ASTATE = (const float*)(ws + WS_ASTATE);
    LAS bf16* VTs = (LAS bf16*)F.lds;
    LAS unsigned char* V8 = F.lds + 17408;
    LAS unsigned char* C8 = F.lds + 26624;
    const int lane = F.lane, w = F.wave, fr = lane & 15, fq = lane >> 4, tid = F.tid;
    const int vb = (F.G == 256) ? ((F.bid & 7) * 32 + (F.bid >> 3)) : F.bid;
    typedef int i32x4 __attribute__((ext_vector_type(4))); typedef int i32x8 __attribute__((ext_vector_type(8)));
    bf16x8 ones; { const short o1 = (short)0x3F80;
#pragma unroll
        for (int i = 0; i < 8; ++i) ones[i] = o1; }
    i32x8 ones8; { const int o1 = 0x38383838;
#pragma unroll
        for (int i = 0; i < 8; ++i) ones8[i] = o1; }
#define MFMA8(A, B, C) __builtin_amdgcn_mfma_scale_f32_16x16x128_f8f6f4((A), (B), (C), 0, 0, 0, 0, 0, 0)
#define LD8(PTR) __builtin_shufflevector(*(const LAS i32x4*)(PTR), *(const LAS i32x4*)((PTR) + 64), 0, 1, 2, 3, 4, 5, 6, 7)
#define CAT8(X, Y) __builtin_shufflevector(__builtin_bit_cast(i32x4, (X)), __builtin_bit_cast(i32x4, (Y)), 0, 1, 2, 3, 4, 5, 6, 7)
    for (int unit = vb; unit < 256; unit += F.G) {
        const int seq = unit >> 4, j = unit & 15, dir = seq >> 3, b = (seq >> 2) & 1, h = seq & 3;
        bf16* HOUT = (bf16*)(ws + (dir ? WS_V : WS_QKRAW));
        f32x4 CT[2][3];
#pragma unroll
        for (int a = 0; a < 2; ++a)
#pragma unroll
            for (int e = 0; e < 3; ++e) CT[a][e] = (f32x4){0.f, 0.f, 0.f, 0.f};
        for (int i = tid; i < 2 * 48 * 272 / 4; i += NTHR) ((LAS unsigned*)C8)[i] = 0u;
        v4u qa[4], pa[4], wa[4], va, qb[4], pb[4], wb[4], vb_; float ga[3], gb[3];
        const unsigned voV = (unsigned)(((tid >> 4) * CHK + (tid & 15) * 8) * 2);
        const unsigned voQ = (unsigned)((16 * w + fr) * 1024 + 16 * fq), voP = (unsigned)(((16 * w + fr) * CHK + 8 * fq) * 2), voW = (unsigned)((32 * w + fr) * 128 + 16 * fq);
#define P5_KOF(I) (dir ? ((I) < 2 ? 1 - (I) : 67 - (I)) : (I))
#define P5_NEED(IT) (dir ? ((IT) >= (w >> 1)) : ((IT) <= (w >> 1)))
#define P5_FETCH(KK, preQ, preV, preP, preW, preG) do { const int kq_ = (KK), kk_ = kq_ < 0 ? 2 : kq_; \
            preG[2] = ASTATE[seq * NCHT + kk_]; \
            const unsigned char* bV_ = (const unsigned char*)(VTR + (((size_t)b * NCHT + kk_) * D + h * 512 + j * 32) * CHK); \
            preV = *(const v4u*)(bV_ + voV); \
            const unsigned char* bW_ = WKT + ((size_t)seq * NCHT + kk_) * (256 * 128); \
            _Pragma("unroll") for (int it = 0; it < 4; ++it) preW[it] = *(const v4u*)(bW_ + (it >> 1) * 2048 + (it & 1) * 64 + voW);     \
            { const int c_ = kk_ >= 2 ? kk_ - 2 : 0; const int u4_ = dir | (c_ << 1) | (h << 7) | (b << 9); const size_t rown_ = (size_t)b * SEQ + c_ * CHK; \
                const unsigned char* bQ_ = ws + WS_QC8 + rown_ * 1024 + h * 256; const unsigned char* bP_ = (const unsigned char*)(PM + (size_t)u4_ * CHK * CHK); \
                preG[0] = AINT[(size_t)u4_ * CHK + 16 * w + fr]; preG[1] = EXPNM[(size_t)u4_ * CHK + 16 * w + fr]; \
                _Pragma("unroll") for (int it = 0; it < 4; ++it) preQ[it] = *(const v4u*)(bQ_ + it * 64 + voQ);        \
                _Pragma("unroll") for (int it = 0; it < 4; ++it) preP[it] = *(const v4u*)(bP_ + (P5_NEED(it) ? it : (w >> 1)) * 64 + voP); } } while (0)
        P5_FETCH(P5_KOF(0), qa, va, pa, wa, ga); asm volatile("" ::: "memory");
        int tpa = 0, tpb = 0, sink = 0;
        __syncthreads();
        auto step = [&](const int idx, v4u (&preQ)[4], v4u& preV, v4u (&preP)[4], v4u (&preW)[4], float (&preG)[3], v4u (&nxtQ)[4], v4u& nxtV, v4u (&nxtP)[4], v4u (&nxtW)[4], float (&nxtG)[3], int& tp) __attribute__((always_inline)) {
            const int k = P5_KOF(idx), par = idx & 1;
            const bool lat = k >= 2;
            const int kn = (idx + 1 < NCHT) ? P5_KOF(idx + 1) : -1;
            const float a_state = preG[2], aint = preG[0] * (1.0f / 64.0f), expnm = preG[1];
            LAS bf16* VTc = VTs + par * (32 * 136); LAS unsigned char* V8c = V8 + par * (32 * 144); LAS unsigned char* C8c = C8 + par * (48 * 272); LAS unsigned char* C8n = C8 + (par ^ 1) * (48 * 272);
            { *(LAS v4u*)(VTc + (tid >> 4) * 136 + (tid & 15) * 8) = preV;
              v2u v8; v8.x = pk4_fp8(bflo(preV.x), bfhi(preV.x), bflo(preV.y), bfhi(preV.y)); v8.y = pk4_fp8(bflo(preV.z), bfhi(preV.z), bflo(preV.w), bfhi(preV.w));
              *(LAS v2u*)(V8c + (tid >> 4) * 144 + (tid & 15) * 8) = v8; }
            __syncthreads();
            P5_FETCH(kn, nxtQ, nxtV, nxtP, nxtW, nxtG);
            { const int kt0 = (idx + 3 < NCHT) ? P5_KOF(idx + 3) : 2, ct_ = kt0 >= 2 ? kt0 - 2 : 0; const int u4t = dir | (ct_ << 1) | (h << 7) | (b << 9);
              const int L = w * 64 + lane; const unsigned char* ta;
              if (L < 96) { const int sl = (j * 48 + L) % 768, ln = sl & 255;
                  ta = sl < 256 ? ws + WS_QC8 + ((size_t)b * SEQ + ct_ * CHK + (ln >> 1)) * 1024 + h * 256 + (ln & 1) * 128
                     : sl < 512 ? (const unsigned char*)(PM + (size_t)u4t * CHK * CHK) + ln * 128 : WKT + ((size_t)seq * NCHT + kt0) * (256 * 128) + ln * 128; }
              else ta = (const unsigned char*)(VTR + (((size_t)b * NCHT + kt0) * D + h * 512 + j * 32) * CHK) + (L & 63) * 128;
              sink += tp; tp = *(const int*)ta; }
            if (lat) {
                const int c = k - 2; const int u4 = dir | (c << 1) | (h << 7) | (b << 9);
                const size_t row0 = (size_t)b * SEQ + c * CHK;
                const int t = 16 * w + fr;
                f32x4 H[3];
#pragma unroll
                for (int e = 0; e < 3; ++e) H[e] = (f32x4){0.f, 0.f, 0.f, 0.f};
#pragma unroll
                for (int ks = 0; ks < 2; ++ks) { const i32x8 qf = CAT8(preQ[2 * ks], preQ[2 * ks + 1]);
#pragma unroll
                    for (int et = 0; et < 3; ++et) { const i32x8 cf = LD8(C8c + (16 * et + fr) * 272 + 128 * ks + 16 * fq); H[et] = MFMA8(cf, qf, H[et]); } }
#pragma unroll
                for (int et = 0; et < 3; ++et) H[et] = H[et] * aint;
#pragma unroll
                for (int ks = 0; ks < 4; ++ks) if (P5_NEED(ks)) { const bf16x8 pf = __builtin_bit_cast(bf16x8, preP[ks]);
                    const bf16x8 v0 = *(const LAS bf16x8*)(VTc + fr * 136 + ks * 32 + 8 * fq), v1 = *(const LAS bf16x8*)(VTc + (16 + fr) * 136 + ks * 32 + 8 * fq);
                    H[0] = mfma16(v0, pf, H[0]); H[1] = mfma16(v1, pf, H[1]); H[2] = mfma16(ones, pf, H[2]); }
                {
                    const float den = H[2][0];
                    const float inv = 1.0f / fmaxf(fabsf(den), expnm);
                    bf16* orow = HOUT + (row0 + t) * D + h * 512 + j * 32 + 4 * fq;
#pragma unroll
                    for (int et = 0; et < 2; ++et) { v2u o; o.x = pk2c(H[et][0] * inv, H[et][1] * inv); o.y = pk2c(H[et][2] * inv, H[et][3] * inv); *(v2u*)(orow + 16 * et) = o; }
                }
            }
            { const i32x8 vf0 = LD8(V8c + fr * 144 + 16 * fq), vf1 = LD8(V8c + (16 + fr) * 144 + 16 * fq);
#pragma unroll
              for (int dt = 0; dt < 2; ++dt) { const i32x8 wf = CAT8(preW[2 * dt], preW[2 * dt + 1]);
#pragma unroll
                  for (int et = 0; et < 3; ++et) CT[dt][et] = CT[dt][et] * a_state;
                  CT[dt][0] = MFMA8(wf, vf0, CT[dt][0]); CT[dt][1] = MFMA8(wf, vf1, CT[dt][1]); CT[dt][2] = MFMA8(wf, ones8, CT[dt][2]); } }
#pragma unroll
            for (int dt = 0; dt < 2; ++dt)
#pragma unroll
                for (int et = 0; et < 3; ++et) *(LAS unsigned*)(C8n + (16 * et + fr) * 272 + 32 * w + 16 * dt + 4 * fq) = pk4_fp8(CT[dt][et][0], CT[dt][et][1], CT[dt][et][2], CT[dt][et][3]);
        };
#pragma unroll 1
        for (int idx = 0; idx < NCHT; idx += 2) {
            step(idx, qa, va, pa, wa, ga, qb, vb_, pb, wb, gb, tpa);
            step(idx + 1, qb, vb_, pb, wb, gb, qa, va, pa, wa, ga, tpb);
        }
        sink += tpa + tpb; asm volatile("" :: "v"(sink));
        __syncthreads();
    }
#undef P5_FETCH
#undef P5_KOF
#undef P5_NEED
#undef CAT8
#undef MFMA8
#undef LD8
}

__device__ __forceinline__ void p6_combine(const Frame& F, const float* head_g) {
    unsigned char* ws = F.ws;
    const bf16* HF = (const bf16*)(ws + WS_QKRAW); const bf16* HB = (const bf16*)(ws + WS_V); const bf16* OG = (const bf16*)(ws + WS_OG); bf16* HN = (bf16*)(ws + WS_HN);
    const int gw = F.bid * NWAVES + F.wave, NGW = F.G * NWAVES, lane = F.lane;
    v4u na[4], nbb[4], no[4];
    if (gw < M) {
#pragma unroll
        for (int hh = 0; hh < 4; ++hh) { const size_t off = (size_t)gw * D + hh * 512 + lane * 8; na[hh] = *(const v4u*)(HF + off); nbb[hh] = *(const v4u*)(HB + off); no[hh] = *(const v4u*)(OG + off); } }
    for (int row = gw; row < M; row += NGW) {
        v4u ca[4], cb[4], co[4];
#pragma unroll
        for (int hh = 0; hh < 4; ++hh) { ca[hh] = na[hh]; cb[hh] = nbb[hh]; co[hh] = no[hh]; }
        { const int rn = (row + NGW < M) ? row + NGW : row;
#pragma unroll
          for (int hh = 0; hh < 4; ++hh) { const size_t off = (size_t)rn * D + hh * 512 + lane * 8; na[hh] = *(const v4u*)(HF + off); nbb[hh] = *(const v4u*)(HB + off); no[hh] = *(const v4u*)(OG + off); } }
#pragma unroll
        for (int hh = 0; hh < 4; ++hh) { const size_t off = (size_t)row * D + hh * 512 + lane * 8;
            const v4u a = ca[hh], b = cb[hh], o = co[hh];
            float x[8] = { bflo(a.x) + bflo(b.x), bfhi(a.x) + bfhi(b.x), bflo(a.y) + bflo(b.y), bfhi(a.y) + bfhi(b.y), bflo(a.z) + bflo(b.z), bfhi(a.z) + bfhi(b.z), bflo(a.w) + bflo(b.w), bfhi(a.w) + bfhi(b.w) };
            float ss = 0.f;
#pragma unroll
            for (int i = 0; i < 8; ++i) ss += x[i] * x[i];
            const float rstd = 1.0f / sqrtf(wsum(ss) * (1.0f / 512.0f) + EPS);
            const f32x4 g0 = *(const f32x4*)(head_g + hh * 512 + lane * 8), g1 = *(const f32x4*)(head_g + hh * 512 + lane * 8 + 4);
            const float og[8] = { bflo(o.x), bfhi(o.x), bflo(o.y), bfhi(o.y), bflo(o.z), bfhi(o.z), bflo(o.w), bfhi(o.w) };
            float y[8];
#pragma unroll
            for (int i = 0; i < 8; ++i) { const float hn = x[i] * rstd * (i < 4 ? g0[i] : g1[i - 4]); y[i] = hn * og[i]; }
            v2u w; w.x = pk4_fp8(y[0], y[1], y[2], y[3]); w.y = pk4_fp8(y[4], y[5], y[6], y[7]);
            *(v2u*)((unsigned char*)HN + off) = w; }
    }
}

#define DPP_ROR(x, n) __builtin_amdgcn_update_dpp(0, (x), 0x120 + (n), 0xf, 0xf, false)
#define DPP_SHR0(x, n) __builtin_amdgcn_update_dpp(0, (x), 0x110 + (n), 0xf, 0xf, true)
__device__ __forceinline__ float row_min(float v) {
    v = fminf(v, __int_as_float(DPP_ROR(__float_as_int(v), 8))); v = fminf(v, __int_as_float(DPP_ROR(__float_as_int(v), 4)));
    v = fminf(v, __int_as_float(DPP_ROR(__float_as_int(v), 2))); v = fminf(v, __int_as_float(DPP_ROR(__float_as_int(v), 1))); return v; }
__device__ __forceinline__ float row_max(float v) {
    v = fmaxf(v, __int_as_float(DPP_ROR(__float_as_int(v), 8))); v = fmaxf(v, __int_as_float(DPP_ROR(__float_as_int(v), 4)));
    v = fmaxf(v, __int_as_float(DPP_ROR(__float_as_int(v), 2))); v = fmaxf(v, __int_as_float(DPP_ROR(__float_as_int(v), 1))); return v; }
__device__ __forceinline__ float row_sumf(float v) {
    v += __int_as_float(DPP_ROR(__float_as_int(v), 8)); v += __int_as_float(DPP_ROR(__float_as_int(v), 4));
    v += __int_as_float(DPP_ROR(__float_as_int(v), 2)); v += __int_as_float(DPP_ROR(__float_as_int(v), 1)); return v; }
__device__ __forceinline__ int row_sumi(int v) { return row16_sum_i32(v); }
__device__ __forceinline__ int row_incl_scan(int v, int) {
    v += DPP_SHR0(v, 1); v += DPP_SHR0(v, 2); v += DPP_SHR0(v, 4); v += DPP_SHR0(v, 8); return v; }
template <int NV> __device__ __forceinline__ float row_bisect16(const float (&v)[NV]) {
    float mn = v[0], mx = v[0];
#pragma unroll
    for (int j = 1; j < NV; ++j) { mn = fminf(mn, v[j]); mx = fmaxf(mx, v[j]); }
    float lo = row_min(mn), hi = row_max(mx); int cl = NV * 16;
    for (int it = 0; it < 64; ++it) {
        const float mid = 0.5f * (lo + hi);
        const bool active = (cl != 16) && (mid > lo) && (mid < hi);
        if (!__any(active)) break;
        int c = 0;
#pragma unroll
        for (int j = 0; j < NV; ++j) c += (v[j] >= mid) ? 1 : 0;
        c = row_sumi(c);
        if (active) { if (c >= 16) { lo = mid; cl = c; } else hi = mid; }
    }
    return lo;
}

template <int NV> __device__ __forceinline__ unsigned row_select16(const float (&v)[NV]) {
    typedef short s16x2 __attribute__((ext_vector_type(2))); typedef unsigned short u16x2 __attribute__((ext_vector_type(2)));
    float mn = v[0], mx = v[0];
#pragma unroll
    for (int j = 1; j < NV; ++j) { mn = fminf(mn, v[j]); mx = fmaxf(mx, v[j]); }
    mn = row_min(mn); mx = row_max(mx);
    const float sc = 32767.0f / fmaxf(mx - mn, 1e-30f);
    unsigned kp[NV / 2];
#pragma unroll
    for (int j = 0; j < NV / 2; ++j) { const unsigned k0 = min(32767u, (unsigned)((v[2 * j] - mn) * sc)), k1 = min(32767u, (unsigned)((v[2 * j + 1] - mn) * sc)); kp[j] = k0 | (k1 << 16); }
    unsigned T = 0u;
#pragma unroll 1
    for (int b = 14; b >= 0; --b) {
        const unsigned cand = T | (1u << b); const s16x2 c2 = __builtin_bit_cast(s16x2, cand * 0x00010001u);
        u16x2 acc = (u16x2){0, 0};
#pragma unroll
        for (int j = 0; j < NV / 2; ++j) { const s16x2 d = __builtin_bit_cast(s16x2, kp[j]) - c2; acc += __builtin_bit_cast(u16x2, d) >> (unsigned short)15; }
        const unsigned a = __builtin_bit_cast(unsigned, acc);
        const int lt = row_sumi((int)((a & 0xffffu) + (a >> 16)));
        if (NV * 16 - lt >= 16) T = cand;
    }
    unsigned selm = 0u;
#pragma unroll
    for (int j = 0; j < NV; ++j) { const unsigned k = (j & 1) ? (kp[j >> 1] >> 16) : (kp[j >> 1] & 0xffffu); selm |= (k >= T ? 1u : 0u) << j; }
    return selm;
}

template <int NV> __device__ __forceinline__ void row_select16_x2(const float (&va)[NV], const float (&vb)[NV], unsigned& selma, unsigned& selmb) {
    typedef short s16x2 __attribute__((ext_vector_type(2))); typedef unsigned short u16x2 __attribute__((ext_vector_type(2)));
    float mna = va[0], mxa = va[0], mnb = vb[0], mxb = vb[0];
#pragma unroll
    for (int j = 1; j < NV; ++j) { mna = fminf(mna, va[j]); mxa = fmaxf(mxa, va[j]); mnb = fminf(mnb, vb[j]); mxb = fmaxf(mxb, vb[j]); }
    mna = row_min(mna); mxa = row_max(mxa); mnb = row_min(mnb); mxb = row_max(mxb);
    const float sca = 32767.0f / fmaxf(mxa - mna, 1e-30f), scb = 32767.0f / fmaxf(mxb - mnb, 1e-30f);
    unsigned kpa[NV / 2], kpb[NV / 2];
#pragma unroll
    for (int j = 0; j < NV / 2; ++j) { const unsigned a0 = min(32767u, (unsigned)((va[2 * j] - mna) * sca)), a1 = min(32767u, (unsigned)((va[2 * j + 1] - mna) * sca)); kpa[j] = a0 | (a1 << 16);
        const unsigned b0 = min(32767u, (unsigned)((vb[2 * j] - mnb) * scb)), b1 = min(32767u, (unsigned)((vb[2 * j + 1] - mnb) * scb)); kpb[j] = b0 | (b1 << 16); }
    unsigned Ta = 0u, Tb = 0u;
#pragma unroll 1
    for (int b = 14; b >= 0; --b) {
        const unsigned ca = Ta | (1u << b), cb = Tb | (1u << b);
        const s16x2 c2a = __builtin_bit_cast(s16x2, ca * 0x00010001u), c2b = __builtin_bit_cast(s16x2, cb * 0x00010001u);
        u16x2 acca = (u16x2){0, 0}, accb = (u16x2){0, 0};
#pragma unroll
        for (int j = 0; j < NV / 2; ++j) { const s16x2 da = __builtin_bit_cast(s16x2, kpa[j]) - c2a, db = __builtin_bit_cast(s16x2, kpb[j]) - c2b;
            acca += __builtin_bit_cast(u16x2, da) >> (unsigned short)15; accb += __builtin_bit_cast(u16x2, db) >> (unsigned short)15; }
        const unsigned a = __builtin_bit_cast(unsigned, acca), bq = __builtin_bit_cast(unsigned, accb);
        const int lt = row_sumi((int)(((a & 0xffffu) + (a >> 16)) | (((bq & 0xffffu) + (bq >> 16)) << 16)));
        if (NV * 16 - (lt & 0xffff) >= 16) Ta = ca;
        if (NV * 16 - (lt >> 16) >= 16) Tb = cb;
    }
    selma = 0u; selmb = 0u;
#pragma unroll
    for (int j = 0; j < NV; ++j) { const unsigned ka = (j & 1) ? (kpa[j >> 1] >> 16) : (kpa[j >> 1] & 0xffffu), kb = (j & 1) ? (kpb[j >> 1] >> 16) : (kpb[j >> 1] & 0xffffu);
        selma |= (ka >= Ta ? 1u : 0u) << j; selmb |= (kb >= Tb ? 1u : 0u) << j; }
}

__device__ __forceinline__ void p10_topk(const Frame& F, int layer, const Params& P) {
    const float* pu = P.in[I_PU]; const float* pv = P.in[I_PV];
    unsigned char* ws = F.ws;
    const bf16* QP = (const bf16*)(ws + WS_OG); const bf16* KEYS = (const bf16*)(ws + WS_KEYS) + (size_t)layer * (8 * 2 * 128 * 128);
    int* EIDX = (int*)(ws + WS_EIDX); float* EGATE = (float*)(ws + WS_EGATE);
    LAS bf16* keysL = (LAS bf16*)F.lds;
    LAS bf16* At = (LAS bf16*)(F.lds + 69632);
    LAS float* sc = (LAS float*)(F.lds + 86528);
    LAS float* sel_s = (LAS float*)(F.lds + 120320);
    LAS int* sel_i = (LAS int*)(F.lds + 128512);
    LAS float* fin_s = (LAS float*)(F.lds + 136704);
    LAS int* fin_i = (LAS int*)(F.lds + 140800);
    const int lane = F.lane, w = F.wave, fr = lane & 15, fq = lane >> 4, tid = F.tid;
    for (int blk = F.bid; blk < M / 64; blk += F.G) {
        v4u kreg[8], areg[2];
#pragma unroll
        for (int it = 0; it < 8; ++it) { const int item = tid + NTHR * it, row = item >> 4, ch = item & 15; kreg[it] = *(const v4u*)(KEYS + (size_t)row * 128 + ch * 8); }
#pragma unroll
        for (int it = 0; it < 2; ++it) { const int item = tid + NTHR * it, row = item >> 5, ch = item & 31; areg[it] = *(const v4u*)(QP + (size_t)(blk * 64 + row) * D + ch * 8); }
#pragma unroll 1
        for (int h = 0; h < 8; ++h) {
#pragma unroll 1
            for (int tile = 0; tile < 2; ++tile) {
                const int t0 = blk * 64 + tile * 32;
                const int tqr = (blk * 16 + h * 2 + tile) * 8 + w, tqt = tqr >> 14, tqe = tqr & (NEXP - 1);
                f32x4 tqv[4][2];
                { const float* src = (tqt ? pv : pu) + ((size_t)layer * NEXP + tqe) * D;
#pragma unroll
                  for (int j = 0; j < 4; ++j)
#pragma unroll
                      for (int q = 0; q < 2; ++q) tqv[j][q] = __builtin_nontemporal_load((const f32x4*)src + 2 * lane + 128 * j + q); }
                __syncthreads();
                if (tile == 0) {
#pragma unroll
                    for (int it = 0; it < 8; ++it) { const int item = tid + NTHR * it, row = item >> 4, ch = item & 15; *(LAS v4u*)(keysL + row * 136 + ch * 8) = kreg[it]; } }
#pragma unroll
                for (int it = 0; it < 2; ++it) { const int item = tid + NTHR * it, row = item >> 5, ch = item & 31; *(LAS v4u*)(At + row * 264 + ch * 8) = areg[it]; }
                __syncthreads();
                { const int hn = tile ? h + 1 : h, tn = tile ? 0 : 1;
                  if (hn < 8) {
#pragma unroll
                      for (int it = 0; it < 2; ++it) { const int item = tid + NTHR * it, row = item >> 5, ch = item & 31; areg[it] = *(const v4u*)(QP + (size_t)(blk * 64 + tn * 32 + row) * D + hn * 256 + ch * 8); }
                      if (tile) {
#pragma unroll
                          for (int it = 0; it < 8; ++it) { const int item = tid + NTHR * it, row = item >> 4, ch = item & 15; kreg[it] = *(const v4u*)(KEYS + ((size_t)hn * 256 + row) * 128 + ch * 8); } } } }
#pragma unroll
                for (int p = 0; p < 2; ++p)
#pragma unroll
                    for (int tt = 0; tt < 2; ++tt) { f32x4 acc = (f32x4){0.f, 0.f, 0.f, 0.f};
#pragma unroll
                        for (int ks = 0; ks < 4; ++ks) { const bf16x8 af = *(const LAS bf16x8*)(At + (16 * tt + fr) * 264 + p * 128 + ks * 32 + 8 * fq);
                            const bf16x8 kf = *(const LAS bf16x8*)(keysL + (p * 128 + 16 * w + fr) * 136 + ks * 32 + 8 * fq); acc = mfma16(kf, af, acc); }
                        *(LAS f32x4*)(sc + ((16 * tt + fr) * 2 + p) * 132 + 16 * w + 4 * fq) = acc; }
                __syncthreads();
                {
                    const int tla = 4 * w + (fq >> 1), tlb = tla + 2, p = fq & 1;
                    float va[8], vb[8];
                    { const f32x4 a = *(const LAS f32x4*)(sc + (tla * 2 + p) * 132 + fr * 8), b = *(const LAS f32x4*)(sc + (tla * 2 + p) * 132 + fr * 8 + 4);
                      va[0] = a[0]; va[1] = a[1]; va[2] = a[2]; va[3] = a[3]; va[4] = b[0]; va[5] = b[1]; va[6] = b[2]; va[7] = b[3]; }
                    { const f32x4 a = *(const LAS f32x4*)(sc + (tlb * 2 + p) * 132 + fr * 8), b = *(const LAS f32x4*)(sc + (tlb * 2 + p) * 132 + fr * 8 + 4);
                      vb[0] = a[0]; vb[1] = a[1]; vb[2] = a[2]; vb[3] = a[3]; vb[4] = b[0]; vb[5] = b[1]; vb[6] = b[2]; vb[7] = b[3]; }
                    unsigned selma, selmb; row_select16_x2<8>(va, vb, selma, selmb);
                    { const int ns = __popc(selma); int pos = row_incl_scan(ns, fr) - ns; const int o = ((tile * 32 + tla) * 2 + p) * 16;
#pragma unroll
                      for (int j = 0; j < 8; ++j) if ((selma >> j) & 1u) { if (pos < 16) { sel_s[o + pos] = va[j]; sel_i[o + pos] = fr * 8 + j; } ++pos; } }
                    { const int ns = __popc(selmb); int pos = row_incl_scan(ns, fr) - ns; const int o = ((tile * 32 + tlb) * 2 + p) * 16;
#pragma unroll
                      for (int j = 0; j < 8; ++j) if ((selmb >> j) & 1u) { if (pos < 16) { sel_s[o + pos] = vb[j]; sel_i[o + pos] = fr * 8 + j; } ++pos; } }
                }
                LDS_WAIT(); asm volatile("" ::: "memory");
                { unsigned* dst = (unsigned*)(ws + (layer ? (tqt ? WS_VT1 : WS_UT1) : (tqt ? WS_VT0 : WS_UT0)) + (size_t)tqe * 1024);
                  float ss = 0.f;
#pragma unroll
                  for (int j = 0; j < 4; ++j)
#pragma unroll
                      for (int q = 0; q < 2; ++q) ss += (tqv[j][q][0] * tqv[j][q][0] + tqv[j][q][1] * tqv[j][q][1]) + (tqv[j][q][2] * tqv[j][q][2] + tqv[j][q][3] * tqv[j][q][3]);
                  ss = wsum(ss);
                  const float rms = sqrtf(ss * (1.0f / D));
                  const float step = ss > 0.f ? (tqt ? 0.47f * rms : 0.3352f * rms) : 1.0f, inv = 1.0f / step;
#pragma unroll
                  for (int j = 0; j < 4; ++j) { unsigned wq = 0u;
                      if (tqt) wq = fp4x4(tqv[j][0][0] * inv, tqv[j][0][1] * inv, tqv[j][0][2] * inv, tqv[j][0][3] * inv) | (fp4x4(tqv[j][1][0] * inv, tqv[j][1][1] * inv, tqv[j][1][2] * inv, tqv[j][1][3] * inv) << 16);
                      else {
#pragma unroll
                          for (int i = 0; i < 4; ++i) {
                              const unsigned lo = (unsigned)__builtin_amdgcn_fmed3f(fmaf(tqv[j][0][i], inv, 8.0f), 0.0f, 15.5f), hi = (unsigned)__builtin_amdgcn_fmed3f(fmaf(tqv[j][1][i], inv, 8.0f), 0.0f, 15.5f);
                              wq |= ((lo ^ 8u) << (4 * i)) | ((hi ^ 8u) << (16 + 4 * i)); } }
                      dst[lane + 64 * j] = wq; }
                  if (lane == 0) ((float*)(ws + WS_TSC))[((size_t)layer * NEXP + tqe) * 2 + tqt] = step; }
                if (tile == 1) {
                    const int tl = 4 * w + fq, oa = (tl * 2) * 16, ob = ((32 + tl) * 2) * 16;
                    const float s1a = sel_s[oa + fr], s1b = sel_s[ob + fr];
                    float ca[16], cb[16];
#pragma unroll
                    for (int q = 0; q < 4; ++q) { const f32x4 s2 = *(const LAS f32x4*)(sel_s + oa + 16 + 4 * q); ca[4 * q] = s1a + s2[0]; ca[4 * q + 1] = s1a + s2[1]; ca[4 * q + 2] = s1a + s2[2]; ca[4 * q + 3] = s1a + s2[3]; }
#pragma unroll
                    for (int q = 0; q < 4; ++q) { const f32x4 s2 = *(const LAS f32x4*)(sel_s + ob + 16 + 4 * q); cb[4 * q] = s1b + s2[0]; cb[4 * q + 1] = s1b + s2[1]; cb[4 * q + 2] = s1b + s2[2]; cb[4 * q + 3] = s1b + s2[3]; }
                    unsigned selma, selmb; row_select16_x2<16>(ca, cb, selma, selmb);
                    { const int ns = __popc(selma); int pos = row_incl_scan(ns, fr) - ns; const int i1 = sel_i[oa + fr];
#pragma unroll
                      for (int j = 0; j < 16; ++j) if ((selma >> j) & 1u) { if (pos < 16) { fin_s[tl * 16 + pos] = ca[j]; fin_i[tl * 16 + pos] = i1 * 128 + sel_i[oa + 16 + j]; } ++pos; } }
                    { const int ns = __popc(selmb); int pos = row_incl_scan(ns, fr) - ns; const int i1 = sel_i[ob + fr];
#pragma unroll
                      for (int j = 0; j < 16; ++j) if ((selmb >> j) & 1u) { if (pos < 16) { fin_s[(32 + tl) * 16 + pos] = cb[j]; fin_i[(32 + tl) * 16 + pos] = i1 * 128 + sel_i[ob + 16 + j]; } ++pos; } }
                    LDS_WAIT(); asm volatile("" ::: "memory");
#pragma unroll
                    for (int tt = 0; tt < 2; ++tt) {
                        const float ts = fin_s[(32 * tt + tl) * 16 + fr]; const int ei = fin_i[(32 * tt + tl) * 16 + fr];
                        const float mx = row_max(ts); const float ex = expf(ts - mx); const float sm = row_sumf(ex);
                        const size_t o = (size_t)(blk * 64 + 32 * tt + tl) * 128 + h * 16 + fr;
                        EIDX[o] = ei; EGATE[o] = ex / sm;
                    }
                    LDS_WAIT(); asm volatile("" ::: "memory");
                }
            }
        }
    }
}

__device__ __forceinline__ void p11u_pass(const Frame& F, int layer) {
    unsigned char* ws = F.ws;
    const unsigned char* UT = ws + (layer ? WS_UT1 : WS_UT0);
    typedef float f32x2v __attribute__((ext_vector_type(2)));
    const f32x2v* TSC = (const f32x2v*)(ws + WS_TSC) + (size_t)layer * NEXP;
    const unsigned char* XQ = ws + WS_XQ; const f32x2v* SX = (const f32x2v*)(ws + WS_SX);
    const int* EIDX = (const int*)(ws + WS_EIDX); const float* EGATE = (const float*)(ws + WS_EGATE); float* ACT = (float*)(ws + WS_ACT);
    const int lane = F.lane, g16 = lane >> 4, l16 = lane & 15;
    LAS unsigned char* xs = F.lds + F.wave * 12288;
    LAS int* list = (LAS int*)(F.lds + F.wave * 12288 + 8192);
    LAS float* glist = (LAS float*)(F.lds + F.wave * 12288 + 10240);
    const unsigned long long lt = (1ull << lane) - 1ull;
    for (int vb = F.bid; vb < 256; vb += F.G) {
        const int bk = vb & 7, tg = (vb >> 3) * 8 + F.wave;
#pragma unroll 1
        for (int sb = 0; sb < 16; ++sb) {
            const int tok0 = tg * 64 + sb * 4;
            int n = 0;
#pragma unroll
            for (int tl = 0; tl < 4; ++tl) {
                const int e0 = EIDX[(size_t)(tok0 + tl) * 128 + lane], e1 = EIDX[(size_t)(tok0 + tl) * 128 + 64 + lane];
                const float g0 = EGATE[(size_t)(tok0 + tl) * 128 + lane], g1 = EGATE[(size_t)(tok0 + tl) * 128 + 64 + lane];
                const v4u xa = *(const v4u*)(XQ + (size_t)(tok0 + tl) * D + 16 * lane), xb = *(const v4u*)(XQ + (size_t)(tok0 + tl) * D + 1024 + 16 * lane);
                *(LAS v4u*)(xs + tl * 2048 + 16 * lane) = xa; *(LAS v4u*)(xs + tl * 2048 + 1024 + 16 * lane) = xb;
                const bool s0 = (e0 >> 11) == bk, s1 = (e1 >> 11) == bk;
                const unsigned long long m0 = __ballot(s0), m1 = __ballot(s1);
                const int c0 = __popcll(m0);
                if (s0) { const int p = n + __popcll(m0 & lt); list[p] = (e0 << 10) | (tl << 7) | lane; glist[p] = g0; }
                if (s1) { const int p = n + c0 + __popcll(m1 & lt); list[p] = (e1 << 10) | (tl << 7) | (64 + lane); glist[p] = g1; }
                n += c0 + __popcll(m1);
            }
            LDS_WAIT(); asm volatile("" ::: "memory");
            v4u u[2][4]; f32x2v sc2[2], sx2[2]; float gk[2]; int tokk[2], kidx[2], tls[2]; bool valid[2];
#define U_FETCH(P0, U, SC2, SX2, GK, TOKK, KIDX, TLS, VALID) do { _Pragma("unroll") for (int h = 0; h < 2; ++h) { const int p = (P0) + 4 * h + g16; VALID[h] = p < n; const int pp = VALID[h] ? p : 0; const int ent = VALID[h] ? list[pp] : 0; GK[h] = glist[pp]; \
                    const int e = ent >> 10; TLS[h] = (ent >> 7) & 3; const int tok = tok0 + TLS[h]; KIDX[h] = ent & 127; TOKK[h] = tok; \
                    const unsigned char* rowp = UT + (size_t)e * 1024 + l16 * 16; \
                    _Pragma("unroll") for (int i = 0; i < 4; ++i) U[h][i] = *(const v4u*)(rowp + 256 * i); \
                    SC2[h] = TSC[e]; SX2[h] = SX[tok]; } } while (0)
#define U_COMP(U, SC2, SX2, GK, TOKK, KIDX, TLS, VALID) do { _Pragma("unroll") for (int h = 0; h < 2; ++h) { int acch = 0, accl = 0; const LAS unsigned char* xp = xs + TLS[h] * 2048 + l16 * 16;     \
                    _Pragma("unroll") for (int i = 0; i < 4; ++i) { const v4u xa = *(const LAS v4u*)(xp + 256 * i), xb = *(const LAS v4u*)(xp + 1024 + 256 * i); \
                        acch = __builtin_amdgcn_sdot8((int)U[h][i].x, (int)xa.x, acch, false); accl = __builtin_amdgcn_sdot8((int)U[h][i].x, (int)xb.x, accl, false); \
                        acch = __builtin_amdgcn_sdot8((int)U[h][i].y, (int)xa.y, acch, false); accl = __builtin_amdgcn_sdot8((int)U[h][i].y, (int)xb.y, accl, false); \
                        acch = __builtin_amdgcn_sdot8((int)U[h][i].z, (int)xa.z, acch, false); accl = __builtin_amdgcn_sdot8((int)U[h][i].z, (int)xb.z, accl, false); \
                        acch = __builtin_amdgcn_sdot8((int)U[h][i].w, (int)xa.w, acch, false); accl = __builtin_amdgcn_sdot8((int)U[h][i].w, (int)xb.w, accl, false); } \
                    const int acc = row16_sum_i32(16 * acch + accl); \
                    const float d = ((float)(2 * acc) + SX2[h].y) * (0.5f * SC2[h].x * SX2[h].x);       \
                    const float act = gelu_tanh(d) * GK[h] * SC2[h].y; \
                    if (VALID[h] && l16 == 0) ACT[(size_t)TOKK[h] * 128 + KIDX[h]] = act; } } while (0)
            v4u un[2][4]; f32x2v sc2n[2], sx2n[2]; float gkn[2]; int tokkn[2], kidxn[2], tlsn[2]; bool validn[2];
            U_FETCH(0, u, sc2, sx2, gk, tokk, kidx, tls, valid);
#pragma unroll 1
            for (int p0 = 0; p0 < n; p0 += 16) {
                U_FETCH(p0 + 8, un, sc2n, sx2n, gkn, tokkn, kidxn, tlsn, validn);
                U_COMP(u, sc2, sx2, gk, tokk, kidx, tls, valid);
                U_FETCH(p0 + 16, u, sc2, sx2, gk, tokk, kidx, tls, valid);
                if (p0 + 8 < n) U_COMP(un, sc2n, sx2n, gkn, tokkn, kidxn, tlsn, validn);
            }
#undef U_COMP
#undef U_FETCH
            LDS_WAIT(); asm volatile("" ::: "memory");
        }
    }
}
template <int TAIL> __device__ __forceinline__ void p11v_pass(const Frame& F, int layer, const float* tgv, const float* tmod, unsigned char* thn, float* tout) {
    unsigned char* ws = F.ws;
    const unsigned char* VT = ws + (layer ? WS_VT1 : WS_VT0);
    bf16* HLAT = (bf16*)(ws + WS_HLAT);
    const int* EIDX = (const int*)(ws + WS_EIDX); const float* ACT = (const float*)(ws + WS_ACT);
    const float* MODV = (const float*)(ws + WS_MODV) + (size_t)layer * 3 * NMOD;
    const int lane = F.lane, l8 = lane & 7, g8 = lane >> 3, fr = lane & 15, fq = lane >> 4;
    typedef int i32x2 __attribute__((ext_vector_type(2))); typedef int i32x4 __attribute__((ext_vector_type(4))); typedef int i32x8 __attribute__((ext_vector_type(8)));
    typedef float f32x2v __attribute__((ext_vector_type(2)));
    LAS unsigned char* T = F.lds + F.wave * 17536;
    LAS unsigned char* apl = T + 16384;
    LAS float* outs = (LAS float*)(T + 16512);
    LAS unsigned char* twr = T + (16 * g8) * 128;
    const LAS unsigned char* trd = T + (32 * fq + fr) * 128;
    for (int vb = F.bid; vb < 256; vb += F.G) {
        const int s = vb & 7, tg = (vb >> 3) * 8 + F.wave;
        const unsigned char* vbase = VT + s * 128 + 16 * l8;
        i32x4 evn[4]; f32x2v a2; v4u w[16]; float part_mine = 0.f;
        { const int tok = tg * 64;
          i32x4 ev0[4];
#pragma unroll
          for (int j = 0; j < 4; ++j) ev0[j] = *(const i32x4*)(EIDX + (size_t)tok * 128 + 16 * g8 + 4 * j);
#pragma unroll
          for (int q = 0; q < 16; ++q) w[q] = *(const v4u*)(vbase + (size_t)ev0[q >> 2][q & 3] * 1024);
          a2 = *(const f32x2v*)(ACT + (size_t)tok * 128 + 2 * lane);
#pragma unroll
          for (int j = 0; j < 4; ++j) evn[j] = *(const i32x4*)(EIDX + (size_t)(tok + 1) * 128 + 16 * g8 + 4 * j); }
#pragma unroll 1
        for (int ti = 0; ti < 64; ++ti) {
            const int tok = tg * 64 + ti, tokn = tg * 64 + (ti < 63 ? ti + 1 : 63), tokn2 = tg * 64 + (ti < 62 ? ti + 2 : 63);
#pragma unroll
            for (int q = 0; q < 16; ++q) { const v4u x = (q & 1) ? (v4u){w[q].z, w[q].w, w[q].x, w[q].y} : w[q]; *(LAS v4u*)(twr + q * 128 + ((l8 ^ (q >> 1)) * 16)) = x; }
            float amax = fmaxf(fabsf(a2.x), fabsf(a2.y)); amax = wmaxf_all(amax);
            const float uh = amax > 0.f ? amax * (1.0f / 6.0f) : 1.0f, iuh = 1.0f / uh;
            { const unsigned ch = __builtin_amdgcn_cvt_scalef32_pk_fp4_f32(0u, a2.x * iuh, a2.y * iuh, 1.0f, 0) & 0xffu;
              const f32x2v dq = __builtin_amdgcn_cvt_scalef32_pk_f32_fp4(ch, 1.0f, 0);
              const unsigned cl = __builtin_amdgcn_cvt_scalef32_pk_fp4_f32(0u, (a2.x * iuh - dq[0]) * 6.0f, (a2.y * iuh - dq[1]) * 6.0f, 1.0f, 0) & 0xffu;
              apl[lane] = (unsigned char)ch; apl[64 + lane] = (unsigned char)cl; }
#pragma unroll
            for (int q = 0; q < 16; ++q) w[q] = *(const v4u*)(vbase + (size_t)evn[q >> 2][q & 3] * 1024);
            a2 = *(const f32x2v*)(ACT + (size_t)tokn * 128 + 2 * lane);
#pragma unroll
            for (int j = 0; j < 4; ++j) evn[j] = *(const i32x4*)(EIDX + (size_t)tokn2 * 128 + 16 * g8 + 4 * j);
            const int col = s * 256 + 4 * lane; const size_t off = (size_t)tok * D + col;
            const f32x4 gq = *(const f32x4*)(MODV + (size_t)(tok >> 13) * NMOD + 10240 + col); const v2u hx = *(const v2u*)(HLAT + off);
            LDS_WAIT(); asm volatile("" ::: "memory");
            i32x4 bq = (i32x4){0, 0, 0, 0};
            if (fr < 2) bq = *(const LAS i32x4*)(apl + fr * 64 + 16 * fq);
            const i32x8 b8 = (i32x8){bq[0], bq[1], bq[2], bq[3], 0, 0, 0, 0};
#pragma unroll
            for (int ct = 0; ct < 16; ++ct) {
                const LAS unsigned char* p = trd + ((ct ^ fr) * 8);
                const i32x2 r0 = __builtin_amdgcn_ds_read_tr4_b64_v2i32((LAS i32x2*)p), r1 = __builtin_amdgcn_ds_read_tr4_b64_v2i32((LAS i32x2*)(p + 2048));
                const i32x8 a8 = (i32x8){r0[0], r0[1], r1[0], r1[1], 0, 0, 0, 0};
                const f32x4 d = __builtin_amdgcn_mfma_scale_f32_16x16x128_f8f6f4(a8, b8, (f32x4){0.f, 0.f, 0.f, 0.f}, 4, 4, 0, 0, 0, 0);
                f32x4 dl;
#pragma unroll
                for (int r = 0; r < 4; ++r) dl[r] = __int_as_float(__builtin_amdgcn_update_dpp(0, __float_as_int(d[r]), 0x101, 0xf, 0xf, true));
                if (fr == 0) *(LAS f32x4*)(outs + ct * 16 + 4 * fq) = uh * (d + dl * (1.0f / 6.0f));
            }
            LDS_WAIT(); asm volatile("" ::: "memory");
            const f32x4 o = *(const LAS f32x4*)(outs + 4 * lane);
            f32x4 h0 = (f32x4){bflo(hx.x), bfhi(hx.x), bflo(hx.y), bfhi(hx.y)};
#pragma unroll
            for (int i = 0; i < 4; ++i) h0[i] += gq[i] * o[i];
            { v2u ho; ho.x = pk2c(h0[0], h0[1]); ho.y = pk2c(h0[2], h0[3]); *(v2u*)(HLAT + off) = ho;
              if (TAIL) { const float b0 = bflo(ho.x), b1 = bfhi(ho.x), b2 = bflo(ho.y), b3 = bfhi(ho.y); const float ss = wsum((b0 * b0 + b1 * b1) + (b2 * b2 + b3 * b3)); if (lane == ti) part_mine = ss; } }
            LDS_WAIT(); asm volatile("" ::: "memory");
        }
        if (TAIL) {
            float* xsl = (float*)(ws + WS_XCH) + ((size_t)(layer * 256 + tg) * 8) * 64;
            unsigned* xcnt = (unsigned*)(ws + WS_CTL) + CW_XCH + layer * 256 + tg;
            __hip_atomic_store(xsl + s * 64 + lane, part_mine, __ATOMIC_RELAXED, __HIP_MEMORY_SCOPE_AGENT);
            asm volatile("s_waitcnt vmcnt(0)" ::: "memory");
            if (lane == 0) (void)xb_add(xcnt, 1u);
            { unsigned sp = 0u; while (xb_ld(xcnt) < 8u) { __builtin_amdgcn_s_sleep(2); if (++sp > XB_SPIN_CAP) break; } }
            float tot = 0.f;
#pragma unroll
            for (int q = 0; q < 8; ++q) tot += __hip_atomic_load(xsl + q * 64 + lane, __ATOMIC_RELAXED, __HIP_MEMORY_SCOPE_AGENT);
            const float rstd_l = 1.0f / sqrtf(tot * (1.0f / D) + EPS);
            const int col = s * 256 + 4 * lane, bt = (tg * 64) >> 13;
            const f32x4 g4 = *(const f32x4*)(tgv + col);
            f32x4 am = g4, bm = (f32x4){0.f, 0.f, 0.f, 0.f};
            if (TAIL == 1) { const float* mv = tmod + (size_t)bt * NMOD; const f32x4 sc = *(const f32x4*)(mv + 2048 + col), sh = *(const f32x4*)(mv + col); am = g4 * (sc + 1.0f); bm = sh; }
#pragma unroll 1
            for (int t0 = 0; t0 < 64; t0 += 32) {
                v2u hx[32];
#pragma unroll
                for (int i = 0; i < 32; ++i) hx[i] = *(const v2u*)(HLAT + (size_t)(tg * 64 + t0 + i) * D + col);
#pragma unroll
                for (int i = 0; i < 32; ++i) { const size_t off = (size_t)(tg * 64 + t0 + i) * D + col;
                    const float rstd = __int_as_float(__builtin_amdgcn_readlane(__float_as_int(rstd_l), t0 + i));
                    const f32x4 y = (f32x4){bflo(hx[i].x), bfhi(hx[i].x), bflo(hx[i].y), bfhi(hx[i].y)} * rstd * am + bm;
                    if (TAIL == 1) *(unsigned*)(thn + off) = pk4_fp8(y[0], y[1], y[2], y[3]);
                    else __builtin_nontemporal_store(y, (f32x4*)(tout + off)); }
            }
        }
    }
}

__device__ __forceinline__ void p14_spatial(const Frame& F, const Params& P) {
    unsigned char* ws = F.ws;
    const bf16* U = (const bf16*)(ws + WS_QKRAW); const bf16* VV = (const bf16*)(ws + WS_V); bf16* HN = (bf16*)(ws + WS_HN);
    const float* VSSP = (const float*)(ws + WS_VSSP);
    const float* w_s = P.in[I_CMWS]; const float* b_s = P.in[I_CMBS]; const float* g_v = P.in[I_CMGV];
    LAS bf16* Wp = (LAS bf16*)F.lds;
    LAS bf16* Vr = (LAS bf16*)(F.lds + 34816);
    LAS float* rs = (LAS float*)(F.lds + 103424);
    const int lane = F.lane, w = F.wave, fr = lane & 15, fq = lane >> 4, tid = F.tid;
    for (int u = F.bid; u < 1024; u += F.G) {
        const int g = u & 7, c = (u >> 3) & 63, b = u >> 9; const size_t row0 = (size_t)b * SEQ + c * CHK;
        __syncthreads();
        if (tid < 128) { float s = 0.f; for (int i = 0; i < 32; ++i) s += VSSP[(row0 + tid) * 32 + i]; rs[tid] = 1.0f / sqrtf(s * (1.0f / D) + EPS); }
#pragma unroll
        for (int it = 0; it < 8; ++it) { const int item = tid + NTHR * it, s = item >> 5, ch = item & 31;
            const v4u x = *(const v4u*)(VV + (row0 + s) * D + g * 256 + ch * 8);
            LAS v2u* d2 = (LAS v2u*)(Vr + s * 268 + ch * 8); d2[0] = (v2u){x.x, x.y}; d2[1] = (v2u){x.z, x.w}; }
        __syncthreads();
#pragma unroll
        for (int it = 0; it < 4; ++it) { const int item = tid + NTHR * it, t = item >> 4, s0 = (item & 15) * 8;
            const f32x4 a = *(const f32x4*)(w_s + ((size_t)g * 128 + t) * 128 + s0), bq = *(const f32x4*)(w_s + ((size_t)g * 128 + t) * 128 + s0 + 4);
            v4u o; o.x = pk2(a[0] * rs[s0], a[1] * rs[s0 + 1]); o.y = pk2(a[2] * rs[s0 + 2], a[3] * rs[s0 + 3]); o.z = pk2(bq[0] * rs[s0 + 4], bq[1] * rs[s0 + 5]); o.w = pk2(bq[2] * rs[s0 + 6], bq[3] * rs[s0 + 7]);
            *(LAS v4u*)(Wp + t * 136 + s0) = o; }
        __syncthreads();
        bf16x8 wf[4];
#pragma unroll
        for (int ks = 0; ks < 4; ++ks) wf[ks] = *(const LAS bf16x8*)(Wp + (16 * w + fr) * 136 + ks * 32 + 8 * fq);
        const int t = 16 * w + fr; const float bs = b_s[g * 128 + t];
#pragma unroll 2
        for (int dt = 0; dt < 16; ++dt) {
            f32x4 acc = (f32x4){0.f, 0.f, 0.f, 0.f};
#pragma unroll
            for (int ks = 0; ks < 4; ++ks) { bf16x8 vf;
#pragma unroll
                for (int i = 0; i < 8; ++i) vf[i] = (short)Vr[(ks * 32 + 8 * fq + i) * 268 + 16 * dt + fr];
                acc = mfma16(vf, wf[ks], acc); }
            const int dcol = g * 256 + 16 * dt + 4 * fq;
            const v2u uu = *(const v2u*)(U + (row0 + t) * D + dcol); const f32x4 gv = *(const f32x4*)(g_v + dcol);
            *(unsigned*)((unsigned char*)HN + (row0 + t) * D + dcol) = pk4_fp8(bflo(uu.x) * (acc[0] * gv[0] + bs), bfhi(uu.x) * (acc[1] * gv[1] + bs), bflo(uu.y) * (acc[2] * gv[2] + bs), bfhi(uu.y) * (acc[3] * gv[3] + bs));
        }
    }
}


#ifndef PROBE_HASH_N
#define PROBE_HASH_N ((size_t)M * D)
#endif
__device__ __forceinline__ void p_hash_bf16(const Frame& F, size_t wsoff, float* dout) {
    const bf16* src = (const bf16*)(F.ws + wsoff);
    for (size_t i = (size_t)F.bid * NTHR + F.tid; i < (size_t)M * D; i += (size_t)F.G * NTHR) { const unsigned h = ((unsigned)src[i < (size_t)PROBE_HASH_N ? i : 0] + 1u) * 2654435761u; dout[i] = (float)(h >> 8) * (1.0f / 16777216.0f); }
}
__device__ __forceinline__ void p_hash_f32(const Frame& F, size_t wsoff, float* dout) {
    const unsigned* src = (const unsigned*)(F.ws + wsoff);
    for (size_t i = (size_t)F.bid * NTHR + F.tid; i < (size_t)M * D; i += (size_t)F.G * NTHR) { const unsigned h = (src[i] + 1u) * 2654435761u; dout[i] = (float)(h >> 8) * (1.0f / 16777216.0f); }
}

__device__ __forceinline__ void p_final_only(const Frame& F, const float* g_final, float* dout) {
    const bf16* HLAT = (const bf16*)(F.ws + WS_HLAT);
    const int gw = F.bid * NWAVES + F.wave, NGW = F.G * NWAVES, lane = F.lane;
    v2u nx[8];
    f32x4 g4r[8];
#pragma unroll
    for (int j = 0; j < 8; ++j) g4r[j] = ((const f32x4*)g_final)[lane + 64 * j];
    if (gw < M) {
#pragma unroll
        for (int j = 0; j < 8; ++j) nx[j] = ((const v2u*)(HLAT + (size_t)gw * D))[lane + 64 * j]; }
    for (int row = gw; row < M; row += NGW) {
        f32x4 v[8]; float s = 0.f;
#pragma unroll
        for (int j = 0; j < 8; ++j) { const v2u x = nx[j]; v[j] = (f32x4){bflo(x.x), bfhi(x.x), bflo(x.y), bfhi(x.y)}; s += (v[j][0] * v[j][0] + v[j][1] * v[j][1]) + (v[j][2] * v[j][2] + v[j][3] * v[j][3]); }
        { const int rn = (row + NGW < M) ? row + NGW : row;
#pragma unroll
          for (int j = 0; j < 8; ++j) nx[j] = ((const v2u*)(HLAT + (size_t)rn * D))[lane + 64 * j]; }
        const float rstd = 1.0f / sqrtf(wsum(s) * (1.0f / D) + EPS);
#pragma unroll
        for (int j = 0; j < 8; ++j) __builtin_nontemporal_store(v[j] * rstd * g4r[j], (f32x4*)(dout + (size_t)row * D) + lane + 64 * j);
    }
}

constexpr int NPHASE = 20;
__global__ void __launch_bounds__(NTHR, 2) fwd(Params P) {
    extern __shared__ __attribute__((aligned(16))) unsigned char lds_[];
    Frame F; F.lds = (LAS unsigned char*)lds_; F.ws = P.ws; F.tid = threadIdx.x; F.lane = F.tid & 63; F.wave = __builtin_amdgcn_readfirstlane(F.tid >> 6); F.G = gridDim.x; F.bid = blockIdx.x;
    unsigned char* ws = P.ws;
    volatile LAS unsigned* MISC = (volatile LAS unsigned*)(F.lds + LDS_MISC);
    if (F.tid < 16) MISC[F.tid] = 0u;
    __syncthreads();
    const int lo = P.ph_lo, hi = P.ph_hi;
    XcdBarrier bar; bar.bar = (unsigned*)(ws + WS_CTL) + CW_BAR; bar.x = 0; bar.st = MISC + 8;
    if (hi - lo > 1) bar = xcd_barrier_post((unsigned*)(ws + WS_CTL) + CW_BAR, MISC + 8);
#define IN(k) (lo <= (k) && (k) < hi)
#define SEAM(k) do { if (IN(k) && IN((k) + 1)) xcd_barrier(bar); } while (0)
#ifndef PROBE_DUP_MASK
#define PROBE_DUP_MASK 0u
#endif
#define NREP(k) (((PROBE_DUP_MASK >> (k)) & 1u) ? 2 : 1)
    float* MODV = (float*)(ws + WS_MODV);
    bf16* HN = (bf16*)(ws + WS_HN); bf16* HLAT = (bf16*)(ws + WS_HLAT);

    if (IN(0)) for (int rep_ = 0; rep_ < NREP(0); ++rep_) { if (rep_) xcd_barrier(bar); p0_prologue(F, P); } SEAM(0);
    if (IN(1)) for (int rep_ = 0; rep_ < NREP(1); ++rep_) { if (rep_) xcd_barrier(bar); p1_adaln_gates(F, P.in[I_X], P.in[I_CTX], MC, P.in[I_GMIX], MODV, 0, 2048, (unsigned char*)HN, (const float*)(ws + WS_WG), P.in[I_MLGB], (float*)(ws + WS_GATES)); } SEAM(1);
    if (IN(2)) for (int rep_ = 0; rep_ < NREP(2); ++rep_) { if (rep_) xcd_barrier(bar);
        { pg8::Gemm g{(const pg8::bf16_t*)HN, (const pg8::bf16_t*)(ws + WS_WIN0), M, 6144, D / 2}; pg8::StaticOrder S; S.init(M, 6144, F.G, F.bid);
          EpiML E{(bf16*)(ws + WS_QKRAW), (bf16*)(ws + WS_VTR), (bf16*)(ws + WS_OG), 0, W8_INV};
          pg8::gemm_phase<EpiML, pg8::StaticOrder, true, true, true>(F.lds, g, S, E); }
        __syncthreads();
        { pg8::Gemm g{(const pg8::bf16_t*)((const unsigned char*)HN + (size_t)M * D), (const pg8::bf16_t*)(ws + WS_WIN0 + (size_t)1024 * D), MC, 3072, D / 2}; pg8::StaticOrder S; S.init(MC, 3072, F.G, F.bid);
          EpiML E{(bf16*)(ws + WS_QKRAW) + (size_t)M * D, (bf16*)(ws + WS_VTR), nullptr, 1, W8_INV};
          pg8::gemm_phase<EpiML, pg8::StaticOrder, true, true, true>(F.lds, g, S, E); }
    } SEAM(2);
    if (IN(3)) for (int rep_ = 0; rep_ < NREP(3); ++rep_) { if (rep_) xcd_barrier(bar); p3_conv(F, P); } SEAM(3);
    if (IN(4)) for (int rep_ = 0; rep_ < NREP(4); ++rep_) { if (rep_) xcd_barrier(bar); p4_intra(F); } SEAM(4);
    if (IN(5)) for (int rep_ = 0; rep_ < NREP(5); ++rep_) { if (rep_) xcd_barrier(bar); p5_scan(F); } SEAM(5);
    if (IN(6)) for (int rep_ = 0; rep_ < NREP(6); ++rep_) { if (rep_) xcd_barrier(bar); p6_combine(F, P.in[I_MLHG]); } SEAM(6);
    if (IN(7)) for (int rep_ = 0; rep_ < NREP(7); ++rep_) { if (rep_) xcd_barrier(bar); pg8::Gemm g{(const pg8::bf16_t*)HN, (const pg8::bf16_t*)(ws + WS_WOUT0), M, D, D / 2}; pg8::StaticOrder S; S.init(M, D, F.G, F.bid);
        EpiResid<false> E{P.in[I_X], HLAT, MODV + 4096, W8_INV};
        pg8::gemm_phase<EpiResid<false>, pg8::StaticOrder, true, true, true>(F.lds, g, S, E); } SEAM(7);
    if (IN(8)) for (int rep_ = 0; rep_ < NREP(8); ++rep_) { if (rep_) xcd_barrier(bar); adaln_phase<false, true, true>(F, HLAT, nullptr, 0, P.in[I_GCHAN], MODV, 6144, 8192, HN, nullptr, nullptr, nullptr); } SEAM(8);
    if (IN(9)) for (int rep_ = 0; rep_ < NREP(9); ++rep_) { if (rep_) xcd_barrier(bar); pg8::Gemm g{(const pg8::bf16_t*)HN, (const pg8::bf16_t*)(ws + WS_WQ0), M, D, D}; pg8::StaticOrder S; S.init(M, D, F.G, F.bid);
        EpiPlain E{(bf16*)(ws + WS_OG), 1.0f};
        pg8::gemm_phase<EpiPlain, pg8::StaticOrder, true, true>(F.lds, g, S, E); } SEAM(9);
    if (IN(10)) for (int rep_ = 0; rep_ < NREP(10); ++rep_) { if (rep_) xcd_barrier(bar); p10_topk(F, 0, P); } SEAM(10);
    if (IN(11)) { for (int rep_ = 0; rep_ < NREP(24); ++rep_) { p11u_pass(F, 0); xcd_barrier(bar); } if (F.G == 256) p11v_pass<1>(F, 0, P.in[I_GMIX] + D, MODV + 3 * NMOD, (unsigned char*)HN, nullptr); else p11v_pass<0>(F, 0, nullptr, nullptr, nullptr, nullptr); } SEAM(11);
    if (IN(12)) for (int rep_ = 0; rep_ < NREP(12); ++rep_) { if (rep_) xcd_barrier(bar); if (F.G != 256) adaln_phase<false, false, true, true>(F, HLAT, nullptr, 0, P.in[I_GMIX] + D, MODV + 3 * NMOD, 0, 2048, HN, nullptr, nullptr, nullptr); } if (F.G != 256) SEAM(12);
    if (IN(13)) for (int rep_ = 0; rep_ < NREP(13); ++rep_) { if (rep_) xcd_barrier(bar); pg8::Gemm g{(const pg8::bf16_t*)HN, (const pg8::bf16_t*)(ws + WS_WIN1), M, 4096, D / 2}; pg8::StaticOrder S; S.init(M, 4096, F.G, F.bid);
        EpiCM E{(bf16*)(ws + WS_QKRAW), (bf16*)(ws + WS_V), (float*)(ws + WS_VSSP), W8_INV};
        pg8::gemm_phase<EpiCM, pg8::StaticOrder, true, true, true>(F.lds, g, S, E); } SEAM(13);
    if (IN(14)) for (int rep_ = 0; rep_ < NREP(14); ++rep_) { if (rep_) xcd_barrier(bar); p14_spatial(F, P); } SEAM(14);
    if (IN(15)) { pg8::Gemm g{(const pg8::bf16_t*)HN, (const pg8::bf16_t*)(ws + WS_WOUT1), M, D, D / 2}; pg8::StaticOrder S; S.init(M, D, F.G, F.bid);
        EpiResid<true> E{HLAT, HLAT, MODV + 3 * NMOD + 4096, W8_INV};
        pg8::gemm_phase<EpiResid<true>, pg8::StaticOrder, true, true, true>(F.lds, g, S, E); } SEAM(15);
    if (IN(16)) for (int rep_ = 0; rep_ < NREP(16); ++rep_) { if (rep_) xcd_barrier(bar); adaln_phase<false, true, true, true>(F, HLAT, nullptr, 0, P.in[I_GCHAN] + D, MODV + 3 * NMOD, 6144, 8192, HN, nullptr, nullptr, nullptr); } SEAM(16);
    if (IN(17)) for (int rep_ = 0; rep_ < NREP(17); ++rep_) { if (rep_) xcd_barrier(bar); pg8::Gemm g{(const pg8::bf16_t*)HN, (const pg8::bf16_t*)(ws + WS_WQ1), M, D, D / 2}; pg8::StaticOrder S; S.init(M, D, F.G, F.bid);
        EpiPlain E{(bf16*)(ws + WS_OG), W8_INV};
        pg8::gemm_phase<EpiPlain, pg8::StaticOrder, true, true, true>(F.lds, g, S, E); } SEAM(17);
    if (IN(18)) for (int rep_ = 0; rep_ < NREP(18); ++rep_) { if (rep_) xcd_barrier(bar); p10_topk(F, 1, P); } SEAM(18);
    if (IN(19)) { for (int rep_ = 0; rep_ < NREP(24); ++rep_) { p11u_pass(F, 1); xcd_barrier(bar); } if (F.G == 256) p11v_pass<2>(F, 1, P.in[I_GFINAL], nullptr, nullptr, P.out); else { p11v_pass<0>(F, 1, nullptr, nullptr, nullptr, nullptr); xcd_barrier(bar); p_final_only(F, P.in[I_GFINAL], P.out); } }
    if (IN(20)) { p_final_only(F, P.in[I_GFINAL], P.out); }
#ifndef PROBE_HASH_N
#define PROBE_HASH_N ((size_t)M * D)
#endif
#ifdef PROBE_HASH_OFF
    if (IN(21)) { if (PROBE_HASH_F32) p_hash_f32(F, PROBE_HASH_OFF, P.out); else p_hash_bf16(F, PROBE_HASH_OFF, P.out); }
#endif
#undef IN
#undef SEAM
}

#ifndef MK_ONE_LAUNCH
#define MK_ONE_LAUNCH 1
#endif
extern "C" void kernel_launch(void* const* d_in, const int* in_sizes, int n_in, void* d_out, int out_size, void* d_ws, size_t ws_size, hipStream_t stream) {
    static int grid = 0;
    if (grid == 0) {
        if (n_in != 24 || in_sizes[0] != M * D || out_size != M * D || ws_size < WS_END) { fprintf(stderr, "kernel_launch: unexpected shapes (n_in %d, in0 %d, out %d, ws %zu)\n", n_in, n_in > 0 ? in_sizes[0] : -1, out_size, ws_size); grid = -1; return; }
        int dev = 0, cus = 0, per_cu = 0;
        if (hipGetDevice(&dev) != hipSuccess || hipDeviceGetAttribute(&cus, hipDeviceAttributeMultiprocessorCount, dev) != hipSuccess) { grid = -1; return; }
        if (hipFuncSetAttribute((const void*)fwd, hipFuncAttributeMaxDynamicSharedMemorySize, LDS_BYTES) != hipSuccess) { fprintf(stderr, "kernel_launch: hipFuncSetAttribute failed\n"); grid = -1; return; }
        if (hipOccupancyMaxActiveBlocksPerMultiprocessor(&per_cu, (const void*)fwd, NTHR, LDS_BYTES) != hipSuccess || per_cu < 1) fprintf(stderr, "kernel_launch: occupancy query reports %d\n", per_cu);
        (void)hipGetLastError();
        grid = cus;
    }
    if (grid < 0) return;
    (void)hipMemsetAsync((char*)d_ws + WS_CTL, 0, CTL_ZERO_BYTES, stream);
    Params p{};
    for (int i = 0; i < 24; ++i) p.in[i] = (const float*)d_in[i];
    p.out = (float*)d_out; p.ws = (unsigned char*)d_ws;
#if MK_ONE_LAUNCH
    p.ph_lo = 0; p.ph_hi = NPHASE;
    hipLaunchKernelGGL(fwd, dim3(grid), dim3(NTHR), LDS_BYTES, stream, p);
#else
#ifdef MK_TRUNC
    for (int ph = 0; ph <= MK_TRUNC; ++ph) { p.ph_lo = ph; p.ph_hi = ph + 1; hipLaunchKernelGGL(fwd, dim3(grid), dim3(NTHR), LDS_BYTES, stream, p); }
#ifdef PROBE_HASH_OFF
    p.ph_lo = 21; p.ph_hi = 22; hipLaunchKernelGGL(fwd, dim3(grid), dim3(NTHR), LDS_BYTES, stream, p);
#else
    p.ph_lo = 20; p.ph_hi = 21; hipLaunchKernelGGL(fwd, dim3(grid), dim3(NTHR), LDS_BYTES, stream, p);
#endif
#else
    for (int ph = 0; ph < NPHASE; ++ph) { p.ph_lo = ph; p.ph_hi = ph + 1; hipLaunchKernelGGL(fwd, dim3(grid), dim3(NTHR), LDS_BYTES, stream, p); }
#endif
#endif
}
```

```cpp
#include <hip/hip_runtime.h>
#include <cstdio>
#include <cstdint>
namespace pg8 {
#define PG8_LAS __attribute__((address_space(3)))
typedef unsigned short bf16_t;
typedef short bf16x8 __attribute__((ext_vector_type(8)));
typedef float f32x4 __attribute__((ext_vector_type(4)));
typedef unsigned u32x4 __attribute__((ext_vector_type(4)));
constexpr int BM = 256, BK = 64, HALF = 128, HTB = HALF * BK * 2  , STAGE_BYTES = 8 * HTB, NXCD = 8, WGM = 8;

__host__ __device__ __forceinline__ int lds_byte(int r, int c) { const int st = (r >> 4) * 2 + (c >> 5), rr = r & 15, cc = c & 31, ob = rr * 64 + cc * 2; return st * 1024 + (ob ^ (((ob >> 9) & 1) << 5)); }
__host__ __device__ __forceinline__ void stage_rc(int b, int& R, int& C) { const int st = b / 1024, sb = b % 1024, swz = sb ^ (((sb >> 9) & 1) << 5); R = (st >> 1) * 16 + swz / 64; C = (st & 1) * 32 + (swz % 64) / 2; }
__host__ __device__ __forceinline__ int perm32(int rho) { const int n = rho >> 4, i = rho & 15; return 8 * (i >> 2) + 4 * n + (i & 3); }

struct Unit { int pm, pn; };
struct Gemm { const bf16_t* A; const bf16_t* Bt; int M, N, K; };

struct StaticOrder {
    int nM, nN, nwg, G, c, wgm;
    __host__ __device__ void init(int M, int N, int G_, int c_) { nM = M / BM; nN = N / BM; nwg = nM * nN; G = G_; c = c_; wgm = (nN == 16) ? 2 : 4; }
    __host__ __device__ bool next(int i, Unit& u) const {
        const long L = (long)i * G + c; if (L >= nwg) return false;
        int wgid = (int)L; { const int q = nwg / NXCD, r = nwg % NXCD, xcd = wgid % NXCD, off = wgid / NXCD; wgid = (xcd < r ? xcd * (q + 1) : r * (q + 1) + (xcd - r) * q) + off; }
        const int nig = wgm * nN, gid = wgid / nig, fm = gid * wgm, gsz = (nM - fm) < wgm ? (nM - fm) : wgm;
        u.pm = fm + ((wgid % nig) % gsz); u.pn = (wgid % nig) / gsz; return true;
    }
    __device__ __forceinline__ void a_ready(const Unit&) const {}
    __device__ __forceinline__ void done(const Unit&) const {}
};
__device__ __forceinline__ unsigned cvt_pk_bf16(float lo, float hi) { unsigned r; asm volatile("v_cvt_pk_bf16_f32 %0, %1, %2" : "=v"(r) : "v"(lo), "v"(hi)); return r; }
typedef float f32x2 __attribute__((ext_vector_type(2)));
template <class Epi, class Sched, bool ALIGN_EPI = false, bool SP2 = false, bool FP8 = false>
__device__ __forceinline__ void gemm_phase(PG8_LAS unsigned char* lds, const Gemm g, const Sched& S, const Epi& E) {
    const int tid = threadIdx.x, wid = __builtin_amdgcn_readfirstlane(tid >> 6), lane = tid & 63, wr = wid >> 2, wc = wid & 3, fr = lane & 15, fq = lane >> 4;
    const int K = g.K, nt = K / BK;
    unsigned voffA[2], voffB[2];
#pragma unroll
    for (int i = 0; i < 2; ++i) { int R, C; stage_rc(tid * 16 + i * 8192, R, C); const int Rb = Epi::PERM ? ((R & ~31) + perm32(R & 31)) : R;
        voffA[i] = (unsigned)(R * K + C) * 2u; voffB[i] = (unsigned)(Rb * K + C) * 2u; }
    const size_t kstep = (size_t)(BK * 2);
    const size_t hstep = (size_t)HALF * K * 2;
    const size_t tstep = 2 * hstep;
    const unsigned ldsw = (unsigned)wid * 1024u;
    const int aoff = lds_byte(wr * 64 + fr, fq * 8), boff = lds_byte(wc * 32 + fr, fq * 8);
#define PG8_SA(b, h) (((b) * 2 + (h)) * HTB)
#define PG8_SB(b, h) ((4 + (b) * 2 + (h)) * HTB)
#define PG8_STAGE(bufoff, gbase, voff) do { _Pragma("unroll") for (int _i = 0; _i < 2; ++_i) \
        __builtin_amdgcn_global_load_lds((const unsigned*)((const char*)(gbase) + (voff)[_i]), (PG8_LAS unsigned*)(lds + (bufoff) + ldsw + _i * 8192), 16, 0, 0); } while (0)
#define PG8_LDA(dst, b, h) do { _Pragma("unroll") for (int m = 0; m < 4; ++m) { const pg8_v4i l0_ = *(const PG8_LAS pg8_v4i*)(lds + PG8_SA(b, h) + aoff + m * 2048), l1_ = *(const PG8_LAS pg8_v4i*)(lds + PG8_SA(b, h) + aoff + m * 2048 + 1024); dst[m] = __builtin_shufflevector(l0_, l1_, 0, 1, 2, 3, 4, 5, 6, 7); } } while (0)
#define PG8_LDB(dst, b, h) do { _Pragma("unroll") for (int n = 0; n < 2; ++n) { const pg8_v4i l0_ = *(const PG8_LAS pg8_v4i*)(lds + PG8_SB(b, h) + boff + n * 2048), l1_ = *(const PG8_LAS pg8_v4i*)(lds + PG8_SB(b, h) + boff + n * 2048 + 1024); dst[n] = __builtin_shufflevector(l0_, l1_, 0, 1, 2, 3, 4, 5, 6, 7); } } while (0)
#define PG8_MMA(ai, bj, At, Bt) do { __builtin_amdgcn_s_setprio(1); _Pragma("unroll") for (int m = 0; m < 4; ++m) _Pragma("unroll") for (int n = 0; n < 2; ++n) { \
        if constexpr (FP8) { asm volatile("v_mfma_f32_16x16x128_f8f6f4 %0, %1, %2, %0" : "+v"(acc[ai][bj][m][n]) : "v"(Bt[n]), "v"(At[m])); }     \
        else { acc[ai][bj][m][n] = __builtin_amdgcn_mfma_f32_16x16x32_bf16(__builtin_bit_cast(bf16x8, __builtin_shufflevector(Bt[n], Bt[n], 0, 1, 2, 3)), __builtin_bit_cast(bf16x8, __builtin_shufflevector(At[m], At[m], 0, 1, 2, 3)), acc[ai][bj][m][n], 0, 0, 0); \
               acc[ai][bj][m][n] = __builtin_amdgcn_mfma_f32_16x16x32_bf16(__builtin_bit_cast(bf16x8, __builtin_shufflevector(Bt[n], Bt[n], 4, 5, 6, 7)), __builtin_bit_cast(bf16x8, __builtin_shufflevector(At[m], At[m], 4, 5, 6, 7)), acc[ai][bj][m][n], 0, 0, 0); } } \
        __builtin_amdgcn_s_setprio(0); } while (0)
#define PG8_WAIT_V(n) asm volatile("s_waitcnt vmcnt(" #n ")" ::: "memory")
#define PG8_WAIT_L(n) asm volatile("s_waitcnt lgkmcnt(" #n ")" ::: "memory")
#define PG8_BAR __builtin_amdgcn_s_barrier()
#define PG8_SCHED __builtin_amdgcn_sched_barrier(0)
    Unit cur, nxt; int ui = 0;
    if (!S.next(0, cur)) return;
    f32x4 acc[2][2][4][2];
#pragma unroll
    for (int a = 0; a < 2; ++a)
#pragma unroll
        for (int b = 0; b < 2; ++b)
#pragma unroll
            for (int m = 0; m < 4; ++m)
#pragma unroll
                for (int n = 0; n < 2; ++n) acc[a][b][m][n] = (f32x4){0.f, 0.f, 0.f, 0.f};
    typedef int pg8_v4i __attribute__((ext_vector_type(4))); typedef int pg8_v8i __attribute__((ext_vector_type(8)));
    pg8_v8i At[4], B0[2], B1[2];
    const char* cA = (const char*)g.A + (size_t)cur.pm * tstep; const char* cB = (const char*)g.Bt + (size_t)cur.pn * tstep;
    S.a_ready(cur);
    if constexpr (SP2) {
        PG8_STAGE(PG8_SB(0, 0), cB, voffB); PG8_STAGE(PG8_SB(0, 1), cB + hstep, voffB); PG8_STAGE(PG8_SA(0, 0), cA, voffA); PG8_STAGE(PG8_SA(0, 1), cA + hstep, voffA);
        if (wr == 1) PG8_BAR;
        PG8_WAIT_V(2); PG8_BAR;
        PG8_STAGE(PG8_SB(1, 0), cB + kstep, voffB); PG8_STAGE(PG8_SA(1, 0), cA + kstep, voffA); PG8_STAGE(PG8_SB(1, 1), cB + hstep + kstep, voffB);
        PG8_WAIT_V(6); PG8_BAR;
    } else {
        PG8_STAGE(PG8_SB(0, 0), cB, voffB); PG8_STAGE(PG8_SA(0, 0), cA, voffA); PG8_STAGE(PG8_SB(0, 1), cB + hstep, voffB); PG8_STAGE(PG8_SA(0, 1), cA + hstep, voffA);
        if (wr == 1) PG8_BAR;
        PG8_WAIT_V(4); PG8_BAR;
        PG8_STAGE(PG8_SB(1, 0), cB + kstep, voffB); PG8_STAGE(PG8_SA(1, 0), cA + kstep, voffA); PG8_STAGE(PG8_SB(1, 1), cB + hstep + kstep, voffB);
        PG8_WAIT_V(6); PG8_BAR;
    }
    for (;;) {
        const bool has_next = S.next(ui + 1, nxt);
        const char* nA = has_next ? (const char*)g.A + (size_t)nxt.pm * tstep : cA; const char* nB = has_next ? (const char*)g.Bt + (size_t)nxt.pn * tstep : cB;
        for (int t = 0; t < nt; t += 2) {
            const bool last = (t == nt - 2);
            const char* a1 = cA + (size_t)(t + 1) * kstep;
            const char* a2 = last ? nA : cA + (size_t)(t + 2) * kstep; const char* b2 = last ? nB : cB + (size_t)(t + 2) * kstep;
            const char* a3 = a2 + kstep; const char* b3 = b2 + kstep;
            if (last && has_next) S.a_ready(nxt);
            if constexpr (SP2) {
            PG8_LDB(B0, 0, 0); PG8_LDB(B1, 0, 1); PG8_SCHED; PG8_LDA(At, 0, 0); PG8_STAGE(PG8_SA(1, 1), a1 + hstep, voffA);
            PG8_WAIT_V(8); PG8_WAIT_L(0); PG8_BAR; PG8_MMA(0, 0, At, B0); PG8_MMA(0, 1, At, B1); PG8_BAR; PG8_SCHED;
            PG8_LDA(At, 0, 1); PG8_STAGE(PG8_SB(0, 0), b2, voffB); PG8_STAGE(PG8_SB(0, 1), b2 + hstep, voffB); PG8_STAGE(PG8_SA(0, 0), a2, voffA);
            PG8_WAIT_V(8); PG8_WAIT_L(0); PG8_BAR; PG8_MMA(1, 0, At, B0); PG8_MMA(1, 1, At, B1); PG8_BAR; PG8_SCHED;
            PG8_LDB(B0, 1, 0); PG8_LDB(B1, 1, 1); PG8_SCHED; PG8_LDA(At, 1, 0); PG8_STAGE(PG8_SA(0, 1), a2 + hstep, voffA);
            PG8_WAIT_V(8); PG8_WAIT_L(0); PG8_BAR; PG8_MMA(0, 0, At, B0); PG8_MMA(0, 1, At, B1); PG8_BAR; PG8_SCHED;
            PG8_LDA(At, 1, 1); PG8_STAGE(PG8_SB(1, 0), b3, voffB); PG8_STAGE(PG8_SB(1, 1), b3 + hstep, voffB); PG8_STAGE(PG8_SA(1, 0), a3, voffA);
            PG8_WAIT_V(8); PG8_WAIT_L(0); PG8_BAR; PG8_MMA(1, 0, At, B0); PG8_MMA(1, 1, At, B1); PG8_BAR; PG8_SCHED;
            } else {
            PG8_LDB(B0, 0, 0); PG8_SCHED; PG8_LDA(At, 0, 0); PG8_STAGE(PG8_SA(1, 1), a1 + hstep, voffA);
            PG8_WAIT_L(8); PG8_BAR; PG8_WAIT_L(0); PG8_MMA(0, 0, At, B0); PG8_BAR; PG8_SCHED;
            PG8_LDB(B1, 0, 1); PG8_STAGE(PG8_SB(0, 0), b2, voffB);
            PG8_BAR; PG8_WAIT_L(0); PG8_MMA(0, 1, At, B1); PG8_BAR;
            PG8_LDA(At, 0, 1); PG8_STAGE(PG8_SA(0, 0), a2, voffA);
            PG8_BAR; PG8_WAIT_L(0); PG8_MMA(1, 0, At, B0); PG8_BAR; PG8_SCHED;
            PG8_STAGE(PG8_SB(0, 1), b2 + hstep, voffB);
            PG8_WAIT_V(6); PG8_BAR; PG8_MMA(1, 1, At, B1); PG8_BAR;
            PG8_LDB(B0, 1, 0); PG8_SCHED; PG8_LDA(At, 1, 0); PG8_STAGE(PG8_SA(0, 1), a2 + hstep, voffA);
            PG8_WAIT_L(8); PG8_BAR; PG8_WAIT_L(0); PG8_MMA(0, 0, At, B0); PG8_BAR; PG8_SCHED;
            PG8_LDB(B1, 1, 1); PG8_STAGE(PG8_SB(1, 0), b3, voffB);
            PG8_BAR; PG8_WAIT_L(0); PG8_MMA(0, 1, At, B1); PG8_BAR;
            PG8_LDA(At, 1, 1); PG8_STAGE(PG8_SA(1, 0), a3, voffA);
            PG8_BAR; PG8_WAIT_L(0); PG8_MMA(1, 0, At, B0); PG8_BAR; PG8_SCHED;
            PG8_STAGE(PG8_SB(1, 1), b3 + hstep, voffB);
            PG8_WAIT_V(6); PG8_BAR; PG8_MMA(1, 1, At, B1); PG8_BAR;
            }
        }
        if constexpr (FP8) asm volatile("s_nop 7\n\ts_nop 7" ::: "memory");
        if constexpr (ALIGN_EPI) { if (wr == 0) PG8_BAR; }
        if constexpr (!Epi::AFTER_DRAIN) { E(acc, cur, wr, wc, fr, fq); S.done(cur); }
        if (!has_next) break;
#pragma unroll
        for (int a = 0; a < 2; ++a)
#pragma unroll
            for (int b = 0; b < 2; ++b)
#pragma unroll
                for (int m = 0; m < 4; ++m)
#pragma unroll
                    for (int n = 0; n < 2; ++n) acc[a][b][m][n] = (f32x4){0.f, 0.f, 0.f, 0.f};
        cur = nxt; cA = nA; cB = nB; ++ui;
        if constexpr (ALIGN_EPI) { if (wr == 1) PG8_BAR; }
    }
    PG8_WAIT_V(0);
    if constexpr (!ALIGN_EPI) { if (wr == 0) PG8_BAR; }
    PG8_BAR;
    if constexpr (Epi::AFTER_DRAIN) { E.fused(acc, cur, wr, wc, fr, fq, lds, wid, lane); S.done(cur); }
#undef PG8_SA
#undef PG8_SB
#undef PG8_STAGE
#undef PG8_LDA
#undef PG8_LDB
#undef PG8_MMA
#undef PG8_WAIT_V
#undef PG8_WAIT_L
#undef PG8_BAR
#undef PG8_SCHED
}
}

#define GAS __attribute__((address_space(1)))
#define LAS __attribute__((address_space(3)))
typedef unsigned short bf16;
typedef unsigned v4u __attribute__((ext_vector_type(4)));
typedef unsigned v2u __attribute__((ext_vector_type(2)));
typedef float f32x4 __attribute__((ext_vector_type(4)));
typedef short bf16x8 __attribute__((ext_vector_type(8)));

constexpr int NWAVES = 8, NTHR = 512;
constexpr int D = 2048, SEQ = 8192, M = 16384, CTXL = 256, MC = 512, MT = M + MC;
constexpr int NMOD = 12288;
constexpr int NH = 4, DQK = 256, DV = 512, CHK = 128, NCH = 64, NCHT = 66;
constexpr int NEXP = 16384;
constexpr float EPS = 1e-6f;
constexpr float W8_SCALE = 64.0f, W8_INV = 1.0f / 64.0f;

constexpr size_t MiB = (size_t)1 << 20;
constexpr size_t WS_CTL = 0, CTL_ZERO_BYTES = 1 * MiB;
constexpr size_t WS_MODV = 1 * MiB;
constexpr size_t WS_WG = 1 * MiB + 512 * 1024;
constexpr size_t WS_VSS = 1 * MiB + 768 * 1024;
constexpr size_t WS_BCUM = 2 * MiB;
constexpr size_t WS_WST = 2 * MiB + 512 * 1024;
constexpr size_t WS_MPREV = 3 * MiB + 256 * 1024;
constexpr size_t WS_ASTATE = WS_MPREV + 8192;
constexpr size_t WS_AINT = 4 * MiB;
constexpr size_t WS_EXPNM = 4 * MiB + 512 * 1024;
constexpr size_t WS_GATES = 5 * MiB;
constexpr size_t WS_KEYS = 7 * MiB;
constexpr size_t WS_WIN0 = 8 * MiB, WS_WOUT0 = 32 * MiB, WS_WQ0 = 40 * MiB, WS_WIN1 = 48 * MiB, WS_WOUT1 = 64 * MiB, WS_WQ1 = 72 * MiB;
constexpr size_t WS_UT0 = 80 * MiB, WS_VT0 = 96 * MiB, WS_UT1 = 112 * MiB, WS_VT1 = 128 * MiB;
constexpr size_t WS_TSC = 208 * MiB;
constexpr size_t WS_XQ = 212 * MiB;
constexpr size_t WS_SX = 244 * MiB;
constexpr size_t WS_HLAT = 336 * MiB;
constexpr size_t WS_HN = 464 * MiB;
constexpr size_t WS_QKRAW = 532 * MiB;
constexpr size_t WS_V = 600 * MiB;
constexpr size_t WS_OG = 668 * MiB;
constexpr size_t WS_QC = 732 * MiB;
constexpr size_t WS_EIDX = 732 * MiB, WS_EGATE = 740 * MiB, WS_ACT = 748 * MiB;
constexpr size_t WS_XCH = 756 * MiB;
constexpr size_t WS_KC = 764 * MiB;
constexpr size_t WS_WKT = 798 * MiB;
constexpr size_t WS_VTR = 864 * MiB;
constexpr size_t WS_PM = 930 * MiB;
constexpr size_t WS_VSSP = 962 * MiB;
constexpr size_t WS_QC8 = 964 * MiB;
constexpr size_t WS_END = 980 * MiB;
constexpr int CW_BAR = 4096;
constexpr int CW_XCH = 32768;

constexpr int LDS_BYTES = 147456;
constexpr int LDS_MISC = 145408;

#define LDS_WAIT() asm volatile("s_waitcnt lgkmcnt(0)" ::: "memory")
#define VM_WAIT() asm volatile("s_waitcnt vmcnt(0)" ::: "memory")

typedef __bf16 bf16x2_t __attribute__((ext_vector_type(2)));
typedef float f32x2_t __attribute__((ext_vector_type(2)));
__device__ __forceinline__ unsigned pk2c(float lo, float hi) { const bf16x2_t v = __builtin_convertvector((f32x2_t){lo, hi}, bf16x2_t); return __builtin_bit_cast(unsigned, v); }
__device__ __forceinline__ unsigned pk2(float lo, float hi) { unsigned r; asm volatile("v_cvt_pk_bf16_f32 %0, %1, %2" : "=v"(r) : "v"(lo), "v"(hi)); return r; }
__device__ __forceinline__ unsigned pk4_fp8(float a, float b, float c2, float d) { int w = __builtin_amdgcn_cvt_pk_fp8_f32(a, b, 0, false); w = __builtin_amdgcn_cvt_pk_fp8_f32(c2, d, w, true); return (unsigned)w; }
__device__ __forceinline__ unsigned e2m1_code(float x) { const float ax = fabsf(x);
    const unsigned m = (ax >= 0.25f) + (ax >= 0.75f) + (ax >= 1.25f) + (ax >= 1.75f) + (ax >= 2.5f) + (ax >= 3.5f) + (ax >= 5.0f); return m | (x < 0.f ? 8u : 0u); }
__device__ __forceinline__ float e2m1_val(unsigned cd) { const unsigned m = cd & 7u; const float a = m < 4u ? 0.5f * (float)m : (m == 4u ? 2.0f : m == 5u ? 3.0f : m == 6u ? 4.0f : 6.0f); return (cd & 8u) ? -a : a; }
__device__ __forceinline__ unsigned fp4x4(float a, float b, float c, float d) { unsigned w = __builtin_amdgcn_cvt_scalef32_pk_fp4_f32(0u, a, b, 1.0f, 0); return __builtin_amdgcn_cvt_scalef32_pk_fp4_f32(w, c, d, 1.0f, 1) & 0xffffu; }
__device__ __forceinline__ float bflo(unsigned u) { return __uint_as_float(u << 16); }
__device__ __forceinline__ float bfhi(unsigned u) { return __uint_as_float(u & 0xffff0000u); }
__device__ __forceinline__ float bf2f(bf16 b) { return __uint_as_float(((unsigned)b) << 16); }
__device__ __forceinline__ float fexp(float x) { return __builtin_amdgcn_exp2f(x * 1.4426950408889634f); }
__device__ __forceinline__ float sigmoidf_(float x) { return __builtin_amdgcn_rcpf(1.0f + fexp(-x)); }
__device__ __forceinline__ float siluf_(float x) { return x * sigmoidf_(x); }
__device__ __forceinline__ float gelu_tanh(float x) { const float u = 0.7978845608028654f * (x + 0.044715f * x * x * x); return x * __builtin_amdgcn_rcpf(1.0f + fexp(-2.0f * u)); }
__device__ __forceinline__ float log_sigmoid(float x) { return fminf(x, 0.f) - log1pf(expf(-fabsf(x))); }
#define WR_DPP(x, c) __int_as_float(__builtin_amdgcn_update_dpp(0, __float_as_int(x), (c), 0xf, 0xf, false))
#define WR_LANE(x, l) __int_as_float(__builtin_amdgcn_readlane(__float_as_int(x), (l)))
__device__ __forceinline__ float wmaxf_all(float v) {
    v = fmaxf(v, WR_DPP(v, 0x128)); v = fmaxf(v, WR_DPP(v, 0x124)); v = fmaxf(v, WR_DPP(v, 0x122)); v = fmaxf(v, WR_DPP(v, 0x121));
    return fmaxf(fmaxf(WR_LANE(v, 0), WR_LANE(v, 16)), fmaxf(WR_LANE(v, 32), WR_LANE(v, 48)));
}
__device__ __forceinline__ int row16_sum_i32(int v) {
    v += __builtin_amdgcn_update_dpp(0, v, 0x128, 0xf, 0xf, false);
    v += __builtin_amdgcn_update_dpp(0, v, 0x124, 0xf, 0xf, false);
    v += __builtin_amdgcn_update_dpp(0, v, 0x122, 0xf, 0xf, false);
    v += __builtin_amdgcn_update_dpp(0, v, 0x121, 0xf, 0xf, false);
    return v;
}
__device__ __forceinline__ unsigned q4(float a, float b, float c, float d, float inv, int bias) {
    int qa = (int)rintf(a * inv), qb = (int)rintf(b * inv), qc = (int)rintf(c * inv), qd = (int)rintf(d * inv);
    qa = min(127, max(-127, qa)) + bias; qb = min(127, max(-127, qb)) + bias; qc = min(127, max(-127, qc)) + bias; qd = min(127, max(-127, qd)) + bias;
    return (unsigned)(qa & 255) | ((unsigned)(qb & 255) << 8) | ((unsigned)(qc & 255) << 16) | ((unsigned)(qd & 255) << 24);
}
__device__ __forceinline__ float wsum(float v) {
    v += WR_DPP(v, 0x128); v += WR_DPP(v, 0x124); v += WR_DPP(v, 0x122); v += WR_DPP(v, 0x121);
    return (WR_LANE(v, 0) + WR_LANE(v, 16)) + (WR_LANE(v, 32) + WR_LANE(v, 48));
}

#define XB_TMO      128
#define XB_XCNT(j)  (256  + 64 * (j))
#define XB_XSUB(j)  (1280 + 64 * (j))
#define XB_XGEN(j)  (2304 + 64 * (j))
#define XB_TOP      3328
#define XB_TOPGEN   3392
#define XCD_BAR_WORDS 3456
#define XB_SPIN_CAP (1u << 22)

__device__ __forceinline__ unsigned xb_ld(unsigned* p)              { return __hip_atomic_load(p, __ATOMIC_RELAXED, __HIP_MEMORY_SCOPE_AGENT); }
__device__ __forceinline__ unsigned xb_add(unsigned* p, unsigned v) { return __hip_atomic_fetch_add(p, v, __ATOMIC_RELAXED, __HIP_MEMORY_SCOPE_AGENT); }
__device__ __forceinline__ unsigned xb_xcc_id() { return (unsigned)__builtin_amdgcn_s_getreg((3 << 11) | 20) & 0xFu; }
#define XB_SPIN(cond, bar) do { unsigned _sp = 0; while (cond) { __builtin_amdgcn_s_sleep(1); \
    if ((++_sp & 255u) == 0u) { if (xb_ld(&(bar)[XB_TMO])) break; if (_sp > XB_SPIN_CAP) { atomicAdd(&(bar)[XB_TMO], 1u); break; } } } } while (0)

struct XcdBarrier { unsigned* bar; unsigned x; volatile LAS unsigned* st; };

__device__ __forceinline__ XcdBarrier xcd_barrier_post(unsigned* bar, volatile LAS unsigned* st) {
    XcdBarrier b; b.bar = bar; b.x = xb_xcc_id(); b.st = st;
    if (threadIdx.x == 0) (void)xb_add(&bar[XB_XCNT(b.x)], 1u);
    return b;
}
__device__ __forceinline__ void xcd_barrier_complete(unsigned* bar, unsigned x, unsigned& nloc, unsigned& nx) {
    const unsigned G = gridDim.x * gridDim.y * gridDim.z;
    unsigned sum, cnt, mine, sp = 0u;
    for (;;) {
        sum = 0u; cnt = 0u; mine = 0u;
#pragma unroll
        for (unsigned j = 0; j < 16; ++j) { const unsigned c = xb_ld(&bar[XB_XCNT(j)]); sum += c; cnt += (c > 0u) ? 1u : 0u; mine = (j == x) ? c : mine; }
        if (sum == G) break;
        __builtin_amdgcn_s_sleep(1);
        if ((++sp & 255u) == 0u) { if (xb_ld(&bar[XB_TMO])) break; if (sp > XB_SPIN_CAP) { atomicAdd(&bar[XB_TMO], 1u); break; } }
    }
    nloc = mine > 0u ? mine : 1u; nx = cnt > 0u ? cnt : 1u;
}
__device__ __forceinline__ void xcd_barrier(const XcdBarrier& b) {
    asm volatile("s_waitcnt vmcnt(0)" ::: "memory");
    __syncthreads();
    if (threadIdx.x == 0) {
        unsigned* bar = b.bar;
        __builtin_amdgcn_s_waitcnt(0);
        unsigned nloc = b.st[0], nx = b.st[1];
        if (nloc == 0u) { xcd_barrier_complete(bar, b.x, nloc, nx); b.st[0] = nloc; b.st[1] = nx; }
        const unsigned old = xb_add(&bar[XB_XSUB(b.x)], 1u);
        const unsigned gen = old / nloc;
        if (old + 1u == (gen + 1u) * nloc) {
            __builtin_amdgcn_fence(__ATOMIC_RELEASE, "agent");
            asm volatile("s_waitcnt vmcnt(0)" ::: "memory");
            const unsigned og = xb_add(&bar[XB_TOP], 1u);
            const unsigned tg = og / nx;
            if (og + 1u == (tg + 1u) * nx) xb_add(&bar[XB_TOPGEN], 1u);
            else XB_SPIN(xb_ld(&bar[XB_TOPGEN]) == tg, bar);
            __builtin_amdgcn_fence(__ATOMIC_ACQUIRE, "agent");
            xb_add(&bar[XB_XGEN(b.x)], 1u);
            asm volatile("s_waitcnt vmcnt(0)" ::: "memory");
        } else {
            XB_SPIN(xb_ld(&bar[XB_XGEN(b.x)]) == gen, bar);
            __builtin_amdgcn_fence(__ATOMIC_ACQUIRE, "agent");
            asm volatile("s_waitcnt vmcnt(0)" ::: "memory");
        }
    }
    __syncthreads();
}

struct Params { const float* in[24]; float* out; unsigned char* ws; int ph_lo, ph_hi; };
struct Frame { LAS unsigned char* lds; unsigned char* ws; int tid, lane, wave, G, bid; };

enum { I_X = 0, I_C, I_CTX, I_CCTX, I_WMOD, I_BMOD, I_GMIX, I_GCHAN, I_MLWIN, I_MLCW, I_MLCB, I_MLGB, I_MLHG, I_MLWOUT, I_CMWIN, I_CMGV, I_CMWS, I_CMBS, I_CMWOUT, I_PWQ, I_PKEYS, I_PU, I_PV, I_GFINAL };

struct EpiML {
    static constexpr bool PERM = true, AFTER_DRAIN = false;
    bf16* qk; bf16* vtr; bf16* og; int ctx; float asc;
    __device__ __forceinline__ void operator()(const pg8::f32x4 (&acc)[2][2][4][2], const pg8::Unit& u, int wr, int wc, int fr, int fq) const {
        asm volatile("" : "+v"(fr), "+v"(fq));
        const int row0 = u.pm * 256 + wr * 64 + fr; const int pn = u.pn; bf16* base = qk; int colt; bool sg = false, isv = false;
        if (!ctx) { if (pn < 8) { base = qk; colt = pn * 256; } else if (pn < 16) { isv = true; colt = (pn - 8) * 256; } else { base = og; colt = (pn - 16) * 256; sg = true; } }
        else { if (pn < 4) { base = qk; colt = 1024 + pn * 256; } else { isv = true; colt = (pn - 4) * 256; } }
        const int col0 = colt + wc * 32 + 8 * fq;
#pragma unroll
        for (int ai = 0; ai < 2; ++ai)
#pragma unroll
            for (int m = 0; m < 4; ++m) { const int r = row0 + ai * 128 + m * 16; bf16* rowp = base + (size_t)r * D + col0;
                const int b = ctx ? (r >> 8) : (r >> 13), k = ctx ? ((r >> 7) & 1) : 2 + ((r >> 7) & 63), s = r & 127;
                bf16* vp = vtr + (((size_t)b * NCHT + k) * D + col0) * CHK + s;
#pragma unroll
                for (int bj = 0; bj < 2; ++bj) { pg8::f32x4 v0 = acc[ai][bj][m][0] * asc, v1 = acc[ai][bj][m][1] * asc;
                    if (sg) {
#pragma unroll
                        for (int j = 0; j < 4; ++j) { v0[j] = sigmoidf_(v0[j]); v1[j] = sigmoidf_(v1[j]); } }
                    v4u w; w.x = pk2(v0[0], v0[1]); w.y = pk2(v0[2], v0[3]); w.z = pk2(v1[0], v1[1]); w.w = pk2(v1[2], v1[3]);
                    if (!isv) *(v4u*)(rowp + bj * 128) = w;
                    else { bf16* q = vp + (size_t)(bj * 128) * CHK;
                        q[0 * CHK] = (bf16)(w.x & 0xffffu); q[1 * CHK] = (bf16)(w.x >> 16); q[2 * CHK] = (bf16)(w.y & 0xffffu); q[3 * CHK] = (bf16)(w.y >> 16);
                        q[4 * CHK] = (bf16)(w.z & 0xffffu); q[5 * CHK] = (bf16)(w.z >> 16); q[6 * CHK] = (bf16)(w.w & 0xffffu); q[7 * CHK] = (bf16)(w.w >> 16); } } }
    }
};
struct EpiPlain {
    static constexpr bool PERM = true, AFTER_DRAIN = false;
    bf16* O; float asc;
    __device__ __forceinline__ void operator()(const pg8::f32x4 (&acc)[2][2][4][2], const pg8::Unit& u, int wr, int wc, int fr, int fq) const {
        asm volatile("" : "+v"(fr), "+v"(fq));
        const int row0 = u.pm * 256 + wr * 64 + fr; const int col0 = u.pn * 256 + wc * 32 + 8 * fq;
#pragma unroll
        for (int ai = 0; ai < 2; ++ai)
#pragma unroll
            for (int m = 0; m < 4; ++m) { bf16* rowp = O + (size_t)(row0 + ai * 128 + m * 16) * D + col0;
#pragma unroll
                for (int bj = 0; bj < 2; ++bj) { const pg8::f32x4 v0 = acc[ai][bj][m][0] * asc, v1 = acc[ai][bj][m][1] * asc;
                    v4u w; w.x = pk2(v0[0], v0[1]); w.y = pk2(v0[2], v0[3]); w.z = pk2(v1[0], v1[1]); w.w = pk2(v1[2], v1[3]);
                    *(v4u*)(rowp + bj * 128) = w; } }
    }
};
struct EpiCM {
    static constexpr bool PERM = true, AFTER_DRAIN = false;
    bf16* U; bf16* V; float* vssp; float asc;
    __device__ __forceinline__ void operator()(const pg8::f32x4 (&acc)[2][2][4][2], const pg8::Unit& u, int wr, int wc, int fr, int fq) const {
        asm volatile("" : "+v"(fr), "+v"(fq));
        const int row0 = u.pm * 256 + wr * 64 + fr; const bool isv = u.pn >= 8; bf16* base = isv ? V : U;
        const int col0 = (isv ? u.pn - 8 : u.pn) * 256 + wc * 32 + 8 * fq;
#pragma unroll
        for (int ai = 0; ai < 2; ++ai)
#pragma unroll
            for (int m = 0; m < 4; ++m) { const int row = row0 + ai * 128 + m * 16; bf16* rowp = base + (size_t)row * D + col0; float ss = 0.f;
#pragma unroll
                for (int bj = 0; bj < 2; ++bj) { pg8::f32x4 v0 = acc[ai][bj][m][0] * asc, v1 = acc[ai][bj][m][1] * asc;
#pragma unroll
                    for (int j = 0; j < 4; ++j) { v0[j] = gelu_tanh(v0[j]); v1[j] = gelu_tanh(v1[j]); ss += v0[j] * v0[j] + v1[j] * v1[j]; }
                    v4u w; w.x = pk2(v0[0], v0[1]); w.y = pk2(v0[2], v0[3]); w.z = pk2(v1[0], v1[1]); w.w = pk2(v1[2], v1[3]);
                    *(v4u*)(rowp + bj * 128) = w; }
                if (isv) {
                    { const unsigned b = __float_as_uint(ss); const auto r = __builtin_amdgcn_permlane16_swap(b, b, false, false); ss = __uint_as_float(r[0]) + __uint_as_float(r[1]); }
                    { const unsigned b = __float_as_uint(ss); const auto r = __builtin_amdgcn_permlane32_swap(b, b, false, false); ss = __uint_as_float(r[0]) + __uint_as_float(r[1]); }
                    if (fq == 0) vssp[(size_t)row * 32 + (u.pn - 8) * 4 + wc] = ss; } }
    }
};
template <bool BASE_BF16> struct EpiResid {
    static constexpr bool PERM = true, AFTER_DRAIN = false;
    const void* base; bf16* out; const float* gate; float asc;
    __device__ __forceinline__ void operator()(const pg8::f32x4 (&acc)[2][2][4][2], const pg8::Unit& u, int wr, int wc, int fr, int fq) const {
        asm volatile("" : "+v"(fr), "+v"(fq));
        const int row0 = u.pm * 256 + wr * 64 + fr, col0 = u.pn * 256 + wc * 32 + 8 * fq;
        const float* gt = gate + (size_t)((u.pm * 256) >> 13) * NMOD + col0;
        pg8::f32x4 gv[2][2];
#pragma unroll
        for (int bj = 0; bj < 2; ++bj)
#pragma unroll
            for (int n = 0; n < 2; ++n) gv[bj][n] = *(const pg8::f32x4*)(gt + bj * 128 + 4 * n) * asc;
#pragma unroll
        for (int ai = 0; ai < 2; ++ai)
#pragma unroll
            for (int m = 0; m < 4; ++m) { const size_t off = (size_t)(row0 + ai * 128 + m * 16) * D + col0;
#pragma unroll
                for (int bj = 0; bj < 2; ++bj) { pg8::f32x4 b0, b1;
                    if (BASE_BF16) { const v4u x = *(const v4u*)((const bf16*)base + off + bj * 128); b0 = (pg8::f32x4){bflo(x.x), bfhi(x.x), bflo(x.y), bfhi(x.y)}; b1 = (pg8::f32x4){bflo(x.z), bfhi(x.z), bflo(x.w), bfhi(x.w)}; }
                    else { b0 = __builtin_nontemporal_load((const pg8::f32x4*)((const float*)base + off + bj * 128)); b1 = __builtin_nontemporal_load((const pg8::f32x4*)((const float*)base + off + bj * 128 + 4)); }
                    const pg8::f32x4 r0 = b0 + gv[bj][0] * acc[ai][bj][m][0], r1 = b1 + gv[bj][1] * acc[ai][bj][m][1];
                    v4u w; w.x = pk2c(r0[0], r0[1]); w.y = pk2c(r0[2], r0[3]); w.z = pk2c(r1[0], r1[1]); w.w = pk2c(r1[2], r1[3]);
                    *(v4u*)(out + off + bj * 128) = w; } }
    }
};

__device__ __forceinline__ void tr_load(const float* W, int ldw, int nblk, int item, int lane, f32x4 (&r)[8]) {
    const int kb = item / nblk, nb = item % nblk, k0 = 64 * kb, n0 = 32 * nb, g = lane >> 3, c4 = lane & 7;
#pragma unroll
    for (int i = 0; i < 8; ++i) r[i] = __builtin_nontemporal_load((const f32x4*)(W + (size_t)(k0 + 8 * g + i) * ldw + n0 + 4 * c4));
}
__device__ __forceinline__ void tr_store_bf16(bf16* WT, int K, int nblk, int item, int lane, const f32x4 (&r)[8]) {
    const int kb = item / nblk, nb = item % nblk, k0 = 64 * kb, n0 = 32 * nb, g = lane >> 3, c4 = lane & 7;
#pragma unroll
    for (int c = 0; c < 4; ++c) { v4u o; o.x = pk2(r[0][c], r[1][c]); o.y = pk2(r[2][c], r[3][c]); o.z = pk2(r[4][c], r[5][c]); o.w = pk2(r[6][c], r[7][c]);
        *(v4u*)(WT + (size_t)(n0 + 4 * c4 + c) * K + k0 + 8 * g) = o; }
}
__device__ __forceinline__ void tr_store_fp8(unsigned char* WT, int K, int nblk, int item, int lane, const f32x4 (&r)[8], float scale) {
    const int kb = item / nblk, nb = item % nblk, k0 = 64 * kb, n0 = 32 * nb, g = lane >> 3, c4 = lane & 7;
#pragma unroll
    for (int c = 0; c < 4; ++c) { v2u o; o.x = pk4_fp8(r[0][c] * scale, r[1][c] * scale, r[2][c] * scale, r[3][c] * scale); o.y = pk4_fp8(r[4][c] * scale, r[5][c] * scale, r[6][c] * scale, r[7][c] * scale);
        *(v2u*)(WT + (size_t)(n0 + 4 * c4 + c) * K + k0 + 8 * g) = o; }
}
__device__ __forceinline__ void p0_prologue(const Frame& F, const Params& P) {
    unsigned char* ws = F.ws;
    const int gt = F.bid * NTHR + F.tid, NGT = F.G * NTHR;
    {
        LAS float* sil = (LAS float*)F.lds;
        LAS float* red = (LAS float*)(F.lds + 24576);
        for (int i = F.tid; i < 3 * D; i += NTHR) { const int r = i / D, k = i % D; const float cv = r < 2 ? P.in[I_C][r * D + k] : P.in[I_CCTX][k]; sil[i] = siluf_(cv); }
        __syncthreads();
        const int cg = F.tid & 15, rl = F.tid >> 4;
        for (int u = F.bid; u < 384; u += F.G) {
            const int layer = u / 192, col0 = (u % 192) * 64;
            const float* W = P.in[I_WMOD] + (size_t)layer * D * NMOD + col0 + cg * 4;
            float a[3][4];
#pragma unroll
            for (int r = 0; r < 3; ++r)
#pragma unroll
                for (int j = 0; j < 4; ++j) a[r][j] = 0.f;
#pragma unroll 8
            for (int k = rl; k < D; k += 32) {
                const f32x4 w = __builtin_nontemporal_load((const f32x4*)(W + (size_t)k * NMOD));
                const float s0 = sil[k], s1 = sil[D + k], s2 = sil[2 * D + k];
#pragma unroll
                for (int j = 0; j < 4; ++j) { a[0][j] += s0 * w[j]; a[1][j] += s1 * w[j]; a[2][j] += s2 * w[j]; }
            }
#pragma unroll
            for (int r = 0; r < 3; ++r)
#pragma unroll
                for (int j = 0; j < 4; ++j) red[(rl * 16 + cg) * 12 + r * 4 + j] = a[r][j];
            __syncthreads();
            if (F.tid < 192) { const int cj = F.tid & 63, r = F.tid >> 6; float s = 0.f;
                for (int q = 0; q < 32; ++q) s += red[(q * 16 + (cj >> 2)) * 12 + r * 4 + (cj & 3)];
                ((float*)(ws + WS_MODV))[((size_t)layer * 3 + r) * NMOD + col0 + cj] = s + P.in[I_BMOD][layer * NMOD + col0 + cj]; }
            __syncthreads();
        }
    }
    for (int i = gt; i < M; i += NGT) ((float*)(ws + WS_VSS))[i] = 0.f;
    for (int i = gt; i < 16 * D; i += NGT) { const int j = i / D, k = i % D; ((float*)(ws + WS_WG))[i] = P.in[I_MLWIN][(size_t)k * 6160 + 6144 + j]; }
    for (int i = gt; i < 2 * 8 * 2 * 128 * 128 / 2; i += NGT) { const float a = P.in[I_PKEYS][2 * i], b = P.in[I_PKEYS][2 * i + 1]; ((unsigned*)(ws + WS_KEYS))[i] = pk2(a, b); }
    {
        const int gw = F.bid * NWAVES + F.wave, NGW = F.G * NWAVES;
        constexpr int I0 = 32 * 192, I1 = 32 * 64, I2 = 32 * 128;
        constexpr int NIT = I0 + I1 + I1 + I2 + I1 + I1;
        for (int it = gw; it < NIT; it += NGW) {
            f32x4 r[8]; int q = it;
            if (q < I0) { tr_load(P.in[I_MLWIN], 6160, 192, q, F.lane, r); tr_store_fp8(ws + WS_WIN0, D, 192, q, F.lane, r, W8_SCALE); continue; } q -= I0;
            if (q < I1) { tr_load(P.in[I_MLWOUT], D, 64, q, F.lane, r); tr_store_fp8(ws + WS_WOUT0, D, 64, q, F.lane, r, W8_SCALE); continue; } q -= I1;
            if (q < I1) { tr_load(P.in[I_PWQ], D, 64, q, F.lane, r); tr_store_bf16((bf16*)(ws + WS_WQ0), D, 64, q, F.lane, r); continue; } q -= I1;
            if (q < I2) { tr_load(P.in[I_CMWIN], 4096, 128, q, F.lane, r); tr_store_fp8(ws + WS_WIN1, D, 128, q, F.lane, r, W8_SCALE); continue; } q -= I2;
            if (q < I1) { tr_load(P.in[I_CMWOUT], D, 64, q, F.lane, r); tr_store_fp8(ws + WS_WOUT1, D, 64, q, F.lane, r, W8_SCALE); continue; } q -= I1;
            tr_load(P.in[I_PWQ] + (size_t)D * D, D, 64, q, F.lane, r); tr_store_fp8(ws + WS_WQ1, D, 64, q, F.lane, r, W8_SCALE);
        }
    }
}

template <bool GATES, bool QUANT = false, bool SRC_BF16 = false, bool OUT_FP8 = false>
__device__ __forceinline__ void adaln_phase(const Frame& F, const void* srcAv, const float* srcB, int nctx, const float* gvec, const float* modv, int shoff, int scoff, bf16* dst,
                                            const float* wg, const float* gate_b, float* gates) {
    LAS float* wgl = (LAS float*)F.lds;
    if (GATES) { for (int i = F.tid; i < 16 * D / 4; i += NTHR) ((LAS f32x4*)wgl)[i] = ((const f32x4*)wg)[i]; __syncthreads(); }
    const int gw = F.bid * NWAVES + F.wave, NGW = F.G * NWAVES, lane = F.lane;
    const float* srcA = (const float*)srcAv; const bf16* srcAb = (const bf16*)srcAv;
    f32x4 nf[8]; v2u nb[8];
    if (gw < M + nctx) {
        const float* xr0 = gw < M ? srcA + (size_t)gw * D : srcB + (size_t)(gw - M) * D;
#pragma unroll
        for (int j = 0; j < 8; ++j) { if (SRC_BF16) nb[j] = ((const v2u*)(srcAb + (size_t)gw * D))[lane + 64 * j]; else nf[j] = ((const f32x4*)xr0)[lane + 64 * j]; } }
    for (int row = gw; row < M + nctx; row += NGW) {
        const float* mv = modv + (size_t)(row < M ? (row >> 13) : 2) * NMOD;
        f32x4 v[8]; float s = 0.f;
#pragma unroll
        for (int j = 0; j < 8; ++j) { if (SRC_BF16) v[j] = (f32x4){bflo(nb[j].x), bfhi(nb[j].x), bflo(nb[j].y), bfhi(nb[j].y)}; else v[j] = nf[j];
            s += (v[j][0] * v[j][0] + v[j][1] * v[j][1]) + (v[j][2] * v[j][2] + v[j][3] * v[j][3]); }
        { const int rn = (row + NGW < M + nctx) ? row + NGW : row;
          const float* xrn = rn < M ? srcA + (size_t)rn * D : srcB + (size_t)(rn - M) * D;
#pragma unroll
          for (int j = 0; j < 8; ++j) { if (SRC_BF16) nb[j] = ((const v2u*)(srcAb + (size_t)rn * D))[lane + 64 * j]; else nf[j] = ((const f32x4*)xrn)[lane + 64 * j]; } }
        const float rstd = 1.0f / sqrtf(wsum(s) * (1.0f / D) + EPS);
        v2u* o8 = (v2u*)(dst + (size_t)row * D);
#pragma unroll
        for (int j = 0; j < 8; ++j) { const int c4 = lane + 64 * j;
            const f32x4 g4 = ((const f32x4*)gvec)[c4], sc = ((const f32x4*)(mv + scoff))[c4], sh = ((const f32x4*)(mv + shoff))[c4];
            v[j] = v[j] * rstd * g4 * (sc + 1.0f) + sh;
            if (OUT_FP8) ((unsigned*)((unsigned char*)dst + (size_t)row * D))[c4] = pk4_fp8(v[j][0], v[j][1], v[j][2], v[j][3]);
            else { v2u w; w.x = pk2(v[j][0], v[j][1]); w.y = pk2(v[j][2], v[j][3]); o8[c4] = w; } }
        if (QUANT) {
            float mx = 0.f;
#pragma unroll
            for (int j = 0; j < 8; ++j) mx = fmaxf(mx, fmaxf(fmaxf(fabsf(v[j][0]), fabsf(v[j][1])), fmaxf(fabsf(v[j][2]), fabsf(v[j][3]))));
            mx = wmaxf_all(mx);
            const float sc = mx > 0.f ? mx * (1.0f / 119.0f) : 1.0f, inv = 1.0f / sc;
            unsigned short* xh = (unsigned short*)(F.ws + WS_XQ + (size_t)row * D); unsigned short* xl = xh + 512; int xs = 0;
#pragma unroll
            for (int j = 0; j < 8; ++j) { unsigned wh = 0u, wl = 0u;
#pragma unroll
                for (int i = 0; i < 4; ++i) { int q = (int)rintf(v[j][i] * inv); q = min(119, max(-119, q)); xs += q; const int ql = ((q + 8) & 15) - 8, qh = (q - ql) >> 4; wl |= (unsigned)(ql & 15) << (4 * i); wh |= (unsigned)(qh & 15) << (4 * i); }
                xh[lane + 64 * j] = (unsigned short)wh; xl[lane + 64 * j] = (unsigned short)wl; }
            xs = row16_sum_i32(xs); xs = (__builtin_amdgcn_readlane(xs, 0) + __builtin_amdgcn_readlane(xs, 16)) + (__builtin_amdgcn_readlane(xs, 32) + __builtin_amdgcn_readlane(xs, 48));
            if (lane == 0) { ((float*)(F.ws + WS_SX))[2 * row] = sc; ((float*)(F.ws + WS_SX))[2 * row + 1] = (float)xs; }
        }
        if (GATES) {
            float a[16];
#pragma unroll
            for (int q = 0; q < 16; ++q) { float t = 0.f;
#pragma unroll
                for (int j = 0; j < 8; ++j) { const f32x4 w4 = ((const LAS f32x4*)(wgl + q * D))[lane + 64 * j]; t += (v[j][0] * w4[0] + v[j][1] * w4[1]) + (v[j][2] * w4[2] + v[j][3] * w4[3]); }
                a[q] = t; __builtin_amdgcn_sched_barrier(0); }
            const bool h5 = (lane & 32) != 0, h4 = (lane & 16) != 0, h3 = (lane & 8) != 0, h2 = (lane & 4) != 0;
            float b8[8], b4[4], b2[2], b1;
#pragma unroll
            for (int i = 0; i < 8; ++i) { const float keep = h5 ? a[8 + i] : a[i], give = h5 ? a[i] : a[8 + i]; b8[i] = keep + __shfl_xor(give, 32); }
#pragma unroll
            for (int i = 0; i < 4; ++i) { const float keep = h4 ? b8[4 + i] : b8[i], give = h4 ? b8[i] : b8[4 + i]; b4[i] = keep + __shfl_xor(give, 16); }
#pragma unroll
            for (int i = 0; i < 2; ++i) { const float keep = h3 ? b4[2 + i] : b4[i], give = h3 ? b4[i] : b4[2 + i]; b2[i] = keep + __shfl_xor(give, 8); }
            { const float keep = h2 ? b2[1] : b2[0], give = h2 ? b2[0] : b2[1]; b1 = keep + __shfl_xor(give, 4); }
            b1 += __shfl_xor(b1, 2); b1 += __shfl_xor(b1, 1);
            if ((lane & 3) == 0) { const int q = (h5 ? 8 : 0) + (h4 ? 4 : 0) + (h3 ? 2 : 0) + (h2 ? 1 : 0);
                float gq = b1 + gate_b[q]; if ((q >> 2) & 1) gq = log_sigmoid(gq); gates[(size_t)row * 16 + q] = gq; }
        }
    }
}

__device__ __forceinline__ void p1_adaln_gates(const Frame& F, const float* srcA, const float* srcB, int nctx, const float* gvec, const float* modv, int shoff, int scoff, unsigned char* dst,
                                               const float* wg, const float* gate_b, float* gates) {
    constexpr int LDW = 2056;
    LAS bf16* wgb = (LAS bf16*)F.lds;
    LAS bf16* tile = (LAS bf16*)(F.lds + 16 * LDW * 2);
    LAS float* part = (LAS float*)(F.lds + 2 * 16 * LDW * 2);
    const int lane = F.lane, w = F.wave, fr = lane & 15, fq = lane >> 4, tid = F.tid;
    for (int i = tid; i < 16 * D / 4; i += NTHR) { const f32x4 x = ((const f32x4*)wg)[i]; const int q = (4 * i) / D, k = (4 * i) % D;
        v2u o; o.x = pk2(x[0], x[1]); o.y = pk2(x[2], x[3]); *(LAS v2u*)(wgb + q * LDW + k) = o; }
    __syncthreads();
    const int NR = M + nctx, NG = (NR + 15) / 16;
    for (int gi = F.bid; gi < NG; gi += F.G) {
        const int r0 = gi * 16;
#pragma unroll
        for (int rr = 0; rr < 2; ++rr) {
            const int rl = 2 * w + rr, row = r0 + rl;
            if (row < NR) {
                const float* xr = row < M ? srcA + (size_t)row * D : srcB + (size_t)(row - M) * D;
                const float* mv = modv + (size_t)(row < M ? (row >> 13) : 2) * NMOD;
                f32x4 v[8]; float s = 0.f;
#pragma unroll
                for (int j = 0; j < 8; ++j) { v[j] = __builtin_nontemporal_load((const f32x4*)xr + lane + 64 * j); s += (v[j][0] * v[j][0] + v[j][1] * v[j][1]) + (v[j][2] * v[j][2] + v[j][3] * v[j][3]); }
                const float rstd = 1.0f / sqrtf(wsum(s) * (1.0f / D) + EPS);
#pragma unroll
                for (int j = 0; j < 8; ++j) { const int c4 = lane + 64 * j;
                    const f32x4 g4 = ((const f32x4*)gvec)[c4], sc = ((const f32x4*)(mv + scoff))[c4], sh = ((const f32x4*)(mv + shoff))[c4];
                    v[j] = v[j] * rstd * g4 * (sc + 1.0f) + sh;
                    ((unsigned*)(dst + (size_t)row * D))[c4] = pk4_fp8(v[j][0], v[j][1], v[j][2], v[j][3]);
                    v2u o; o.x = pk2(v[j][0], v[j][1]); o.y = pk2(v[j][2], v[j][3]); *(LAS v2u*)(tile + rl * LDW + 4 * c4) = o; }
            } else {
#pragma unroll
                for (int j = 0; j < 8; ++j) *(LAS v2u*)(tile + rl * LDW + 4 * (lane + 64 * j)) = (v2u){0u, 0u};
            }
        }
        __syncthreads();
        { f32x4 acc = (f32x4){0.f, 0.f, 0.f, 0.f};
#pragma unroll
          for (int ks = 0; ks < 8; ++ks) { const int k0 = 256 * w + 32 * ks + 8 * fq;
              const bf16x8 af = *(const LAS bf16x8*)(wgb + fr * LDW + k0), bfr = *(const LAS bf16x8*)(tile + fr * LDW + k0);
              acc = __builtin_amdgcn_mfma_f32_16x16x32_bf16(af, bfr, acc, 0, 0, 0); }
#pragma unroll
          for (int r = 0; r < 4; ++r) part[w * 256 + (4 * fq + r) * 16 + fr] = acc[r]; }
        __syncthreads();
        if (tid < 256) { const int q = tid >> 4, cI = tid & 15, row = r0 + cI; float s = 0.f;
#pragma unroll
            for (int ww = 0; ww < 8; ++ww) s += part[ww * 256 + tid];
            if (row < NR) { float gq = s + gate_b[q]; if ((q >> 2) & 1) gq = log_sigmoid(gq); gates[(size_t)row * 16 + q] = gq; } }
    }
}

__device__ __forceinline__ void wscan_add2(float& a, float& b, int lane) {
    float t = a + b;
#pragma unroll
    for (int o = 1; o < 64; o <<= 1) { const float u = __shfl_up(t, o); if (lane >= o) t += u; }
    const float excl = t - (a + b); a = excl + a; b = a + b;
}
__device__ __forceinline__ void wscan_max2(float& a, float& b, int lane) {
    float t = fmaxf(a, b);
#pragma unroll
    for (int o = 1; o < 64; o <<= 1) { const float u = __shfl_up(t, o); if (lane >= o) t = fmaxf(t, u); }
    float excl = __shfl_up(t, 1); if (lane == 0) excl = -INFINITY;
    a = fmaxf(excl, a); b = fmaxf(a, b);
}
__device__ __forceinline__ float wmaxall(float v) {
#pragma unroll
    for (int o = 1; o < 64; o <<= 1) v = fmaxf(v, __shfl_xor(v, o));
    return v;
}

__device__ __forceinline__ void p3_conv(const Frame& F, const Params& P) {
    unsigned char* ws = F.ws;
    const bf16* QKRAW = (const bf16*)(ws + WS_QKRAW); const bf16* VV = (const bf16*)(ws + WS_V);
    bf16* QC = (bf16*)(ws + WS_QC); bf16* KC = (bf16*)(ws + WS_KC); bf16* VTR = (bf16*)(ws + WS_VTR);
    const float* GATES = (const float*)(ws + WS_GATES);
    const float* cw = P.in[I_MLCW]; const float* cbias = P.in[I_MLCB];
    LAS float* wl = (LAS float*)F.lds;
    LAS bf16* tile = (LAS bf16*)(F.lds + 4096);
    constexpr int U_GS = 16, U_LC = 4096, U_LV = 0, U_CC = 64, U_CV = 0, U_ALL = U_GS + U_LC + U_LV + U_CC + U_CV;
    for (int uu = F.bid; uu < U_GS + U_CC; uu += F.G) {
        const int u = uu < U_GS ? uu : uu + U_LC + U_LV;
        int r = u;
        if (r < U_GS) {
            const int dir = r >> 3, b = (r >> 2) & 1, h = r & 3;
            LAS float* beta = (LAS float*)(F.lds + 8192);
            LAS float* bend = (LAS float*)(F.lds + 8192 + 66 * 512);
            LAS float* wmx = bend + 66; LAS float* mnw = wmx + 66;
            float* BCUM = (float*)(ws + WS_BCUM) + (size_t)r * SEQ; float* WST = (float*)(ws + WS_WST) + (size_t)r * (NCHT * CHK);
            float* MPREV = (float*)(ws + WS_MPREV) + r * NCHT; float* ASTATE = (float*)(ws + WS_ASTATE) + r * NCHT;
            for (int k = F.wave; k < NCHT; k += NWAVES) {
                const int row0 = k < 2 ? M + b * CTXL + k * CHK : b * SEQ + (k - 2) * CHK;
                const int j0 = 2 * F.lane, j1 = j0 + 1, s0 = dir ? 127 - j0 : j0, s1 = dir ? 127 - j1 : j1;
                const float f0 = GATES[(size_t)(row0 + s0) * 16 + (2 * dir + 1) * 4 + h], f1 = GATES[(size_t)(row0 + s1) * 16 + (2 * dir + 1) * 4 + h];
                const float i0 = GATES[(size_t)(row0 + s0) * 16 + (2 * dir) * 4 + h], i1 = GATES[(size_t)(row0 + s1) * 16 + (2 * dir) * 4 + h];
                float b0 = f0, b1 = f1; wscan_add2(b0, b1, F.lane);
                const float be = __shfl(b1, 63);
                const float t0 = i0 - b0, t1 = i1 - b1;
                beta[k * 128 + s0] = t0; beta[k * 128 + s1] = t1;
                const float wm = wmaxall(fmaxf(t0, t1)) + be;
                if (F.lane == 0) { bend[k] = be; wmx[k] = wm; }
                if (k >= 2) { BCUM[(k - 2) * CHK + s0] = b0; BCUM[(k - 2) * CHK + s1] = b1; }
            }
            __syncthreads();
            if (F.tid == 0) { float m = 0.f;
                for (int idx = 0; idx < NCHT; ++idx) { const int k = dir ? (idx < 2 ? 1 - idx : 67 - idx) : idx;
                    const float mn = fmaxf(bend[k] + m, wmx[k]); MPREV[k] = m; ASTATE[k] = expf(bend[k] + m - mn); mnw[k] = mn; m = mn; } }
            __syncthreads();
            for (int i = F.tid; i < NCHT * CHK; i += NTHR) { const int k = i >> 7; WST[i] = expf(bend[k] + beta[i] - mnw[k]); }
            __syncthreads();
            continue;
        }
        r -= U_GS;
        if (r < U_LC || (r >= U_LC + U_LV && r < U_LC + U_LV + U_CC)) {
            const bool isctx = r >= U_LC; if (isctx) r -= U_LC + U_LV;
            int b, c, cb;
            if (!isctx) { cb = r & 31; c = (r >> 5) & 63; b = r >> 11; } else { cb = 16 + (r & 15); c = (r >> 4) & 1; b = r >> 5; }
            const int chb = cb * 64;
            for (int i = F.tid; i < 9 * 64 + 64; i += NTHR) wl[i] = i < 576 ? cw[(i >> 6) * D + chb + (i & 63)] : cbias[chb + (i - 576)];
            __syncthreads();
#pragma unroll 1
            for (int it = 0; it < 2; ++it) {
                const int item = F.tid + NTHR * it, tl = item >> 3, cg = item & 7, ch0 = chb + cg * 8;
                float a[8];
#pragma unroll
                for (int q = 0; q < 8; ++q) a[q] = wl[576 + cg * 8 + q];
                if (!isctx) {
                    const int t = c * CHK + tl, gr = t >> 6, gc = t & 63;
#pragma unroll
                    for (int di = 0; di < 3; ++di)
#pragma unroll
                        for (int dj = 0; dj < 3; ++dj) { const int rr = gr + di - 1, c2 = gc + dj - 1;
                            if (rr >= 0 && rr < 128 && c2 >= 0 && c2 < 64) {
                                const v4u x = *(const v4u*)(QKRAW + ((size_t)b * SEQ + rr * 64 + c2) * D + ch0);
                                const LAS float* w = wl + (di * 3 + dj) * 64 + cg * 8;
                                a[0] += bflo(x.x) * w[0]; a[1] += bfhi(x.x) * w[1]; a[2] += bflo(x.y) * w[2]; a[3] += bfhi(x.y) * w[3];
                                a[4] += bflo(x.z) * w[4]; a[5] += bfhi(x.z) * w[5]; a[6] += bflo(x.w) * w[6]; a[7] += bfhi(x.w) * w[7]; } }
                } else {
                    const int s = c * CHK + tl;
#pragma unroll
                    for (int dj = 0; dj < 3; ++dj) { const int s2 = s + dj - 1;
                        if (s2 >= 0 && s2 < CTXL) {
                            const v4u x = *(const v4u*)(QKRAW + ((size_t)M + b * CTXL + s2) * D + ch0);
                            const LAS float* w = wl + (3 + dj) * 64 + cg * 8;
                            a[0] += bflo(x.x) * w[0]; a[1] += bfhi(x.x) * w[1]; a[2] += bflo(x.y) * w[2]; a[3] += bfhi(x.y) * w[3];
                            a[4] += bflo(x.z) * w[4]; a[5] += bfhi(x.z) * w[5]; a[6] += bflo(x.w) * w[6]; a[7] += bfhi(x.w) * w[7]; } }
                }
                const float sc = ch0 >= 1024 ? 0.0625f : 1.0f;
#pragma unroll
                for (int q = 0; q < 8; ++q) a[q] = siluf_(a[q]) * sc;
                v4u o; o.x = pk2(a[0], a[1]); o.y = pk2(a[2], a[3]); o.z = pk2(a[4], a[5]); o.w = pk2(a[6], a[7]);
                const size_t row = isctx ? (size_t)M + b * CTXL + c * CHK + tl : (size_t)b * SEQ + c * CHK + tl;
                if (ch0 < 1024) { *(v4u*)(QC + row * 1024 + ch0) = o; v2u o8; o8.x = pk4_fp8(a[0], a[1], a[2], a[3]); o8.y = pk4_fp8(a[4], a[5], a[6], a[7]); *(v2u*)(ws + WS_QC8 + row * 1024 + ch0) = o8; }
                else *(v4u*)(KC + row * 1024 + (ch0 - 1024)) = o;
            }
            __syncthreads();
            continue;
        }
        {
            int b, k, cb;
            if (r < U_LC + U_LV) { r -= U_LC; cb = r & 31; k = 2 + ((r >> 5) & 63); b = r >> 11; } else { r -= U_LC + U_LV + U_CC; cb = r & 31; k = (r >> 5) & 1; b = r >> 6; }
            const size_t row0 = k < 2 ? (size_t)M + b * CTXL + k * CHK : (size_t)b * SEQ + (k - 2) * CHK;
#pragma unroll
            for (int it = 0; it < 2; ++it) { const int item = F.tid + NTHR * it, s = item >> 3, cg = item & 7;
                const v4u x = *(const v4u*)(VV + (row0 + s) * D + cb * 64 + cg * 8);
                LAS unsigned* tp = (LAS unsigned*)(tile + s * 66 + cg * 8); tp[0] = x.x; tp[1] = x.y; tp[2] = x.z; tp[3] = x.w; }
            __syncthreads();
#pragma unroll
            for (int it = 0; it < 2; ++it) { const int item = F.tid + NTHR * it, sg = item & 15, e = item >> 4;
                unsigned short q[8];
#pragma unroll
                for (int i = 0; i < 8; ++i) q[i] = tile[(sg * 8 + i) * 66 + e];
                v4u o; o.x = q[0] | ((unsigned)q[1] << 16); o.y = q[2] | ((unsigned)q[3] << 16); o.z = q[4] | ((unsigned)q[5] << 16); o.w = q[6] | ((unsigned)q[7] << 16);
                *(v4u*)(VTR + (((size_t)b * NCHT + k) * D + cb * 64 + e) * CHK + sg * 8) = o; }
            __syncthreads();
        }
    }
    {
        LAS unsigned char* tl2 = F.lds + 4096;
        const bool skip16 = F.G > 32; const int nb = skip16 ? F.G - 16 : F.G, b0 = skip16 ? F.bid - 16 : F.bid;
        if (b0 >= 0) {
            v4u pre[4]; float wreg[2];
#define P3_FETCH(R) do { const int r_ = (R), b_ = r_ >> 11, c_ = (r_ >> 5) & 63, chb_ = (r_ & 31) * 64; \
                _Pragma("unroll") for (int it = 0; it < 4; ++it) { const int item = F.tid + NTHR * it, tok = item >> 3, cg = item & 7, grow = 2 * c_ - 1 + (tok >> 6); \
                    pre[it] = (v4u){0u, 0u, 0u, 0u}; if (grow >= 0 && grow < 128) pre[it] = *(const v4u*)(QKRAW + ((size_t)b_ * SEQ + grow * 64 + (tok & 63)) * D + chb_ + cg * 8); } \
                wreg[0] = cw[(F.tid >> 6) * D + chb_ + (F.tid & 63)]; \
                wreg[1] = 0.f; if (F.tid < 128) { const int i = 512 + F.tid; wreg[1] = i < 576 ? cw[(i >> 6) * D + chb_ + (i & 63)] : cbias[chb_ + (i - 576)]; } } while (0)
            int r = b0;
            if (r < U_LC) P3_FETCH(r);
#pragma unroll 1
            for (; r < U_LC; r += nb) {
                const int b = r >> 11, c = (r >> 5) & 63, chb = (r & 31) * 64;
#pragma unroll
                for (int it = 0; it < 4; ++it) { const int item = F.tid + NTHR * it; *(LAS v4u*)(tl2 + (item >> 3) * 144 + (item & 7) * 16) = pre[it]; }
                wl[F.tid] = wreg[0]; if (F.tid < 128) wl[512 + F.tid] = wreg[1];
                __syncthreads();
                if (r + nb < U_LC) P3_FETCH(r + nb);
#pragma unroll 1
                for (int it = 0; it < 2; ++it) {
                    const int item = F.tid + NTHR * it, tl = item >> 3, cg = item & 7, ch0 = chb + cg * 8, gc = tl & 63;
                    float a[8];
#pragma unroll
                    for (int q = 0; q < 8; ++q) a[q] = wl[576 + cg * 8 + q];
#pragma unroll
                    for (int di = 0; di < 3; ++di)
#pragma unroll
                        for (int dj = 0; dj < 3; ++dj) { const int c2 = gc + dj - 1;
                            if (c2 >= 0 && c2 < 64) {
                                const v4u x = *(const LAS v4u*)(tl2 + (64 + tl + (di - 1) * 64 + dj - 1) * 144 + cg * 16);
                                const LAS float* w = wl + (di * 3 + dj) * 64 + cg * 8;
                                a[0] += bflo(x.x) * w[0]; a[1] += bfhi(x.x) * w[1]; a[2] += bflo(x.y) * w[2]; a[3] += bfhi(x.y) * w[3];
                                a[4] += bflo(x.z) * w[4]; a[5] += bfhi(x.z) * w[5]; a[6] += bflo(x.w) * w[6]; a[7] += bfhi(x.w) * w[7]; } }
                    const float sc = ch0 >= 1024 ? 0.0625f : 1.0f;
#pragma unroll
                    for (int q = 0; q < 8; ++q) a[q] = siluf_(a[q]) * sc;
                    v4u o; o.x = pk2(a[0], a[1]); o.y = pk2(a[2], a[3]); o.z = pk2(a[4], a[5]); o.w = pk2(a[6], a[7]);
                    const size_t row = (size_t)b * SEQ + c * CHK + tl;
                    if (ch0 < 1024) { *(v4u*)(QC + row * 1024 + ch0) = o; v2u o8; o8.x = pk4_fp8(a[0], a[1], a[2], a[3]); o8.y = pk4_fp8(a[4], a[5], a[6], a[7]); *(v2u*)(ws + WS_QC8 + row * 1024 + ch0) = o8; }
                    else *(v4u*)(KC + row * 1024 + (ch0 - 1024)) = o;
                }
                __syncthreads();
            }
#undef P3_FETCH
        }
    }
}

__device__ __forceinline__ f32x4 mfma16(bf16x8 a, bf16x8 b, f32x4 c) { return __builtin_amdgcn_mfma_f32_16x16x32_bf16(a, b, c, 0, 0, 0); }

__device__ __forceinline__ void p4_intra(const Frame& F) {
    unsigned char* ws = F.ws;
    const bf16* QC = (const bf16*)(ws + WS_QC); const bf16* KC = (const bf16*)(ws + WS_KC);
    const float* GATES = (const float*)(ws + WS_GATES);
    bf16* PM = (bf16*)(ws + WS_PM);
    float* AINT = (float*)(ws + WS_AINT); float* EXPNM = (float*)(ws + WS_EXPNM);
    LAS bf16* Qs = (LAS bf16*)F.lds;
    LAS bf16* Ks = (LAS bf16*)(F.lds + 67584);
    LAS float* vec = (LAS float*)(F.lds + 135168);
    const int lane = F.lane, w = F.wave, fr = lane & 15, fq = lane >> 4;
    v4u pk_[8], pq_[8]; float pv_[3];
#define P4_DECODE(U, dir, b, h, k, lat) const bool lat = (U) < 1024; int dir, b, h, k; \
        if (lat) { dir = (U) & 1; k = 2 + (((U) >> 1) & 63); h = ((U) >> 7) & 3; b = (U) >> 9; } else { const int r_ = (U) - 1024; dir = r_ & 1; k = (r_ >> 1) & 1; h = (r_ >> 2) & 3; b = r_ >> 4; }
#define P4_FETCH(U) do { P4_DECODE(U, dir_, b_, h_, k_, lat_) const int seq_ = dir_ * 8 + b_ * 4 + h_; \
        const size_t row0_ = k_ < 2 ? (size_t)M + b_ * CTXL + k_ * CHK : (size_t)b_ * SEQ + (k_ - 2) * CHK; \
        _Pragma("unroll") for (int it = 0; it < 8; ++it) { const int item = F.tid + NTHR * it, row = item >> 5, ch = item & 31; \
            pk_[it] = *(const v4u*)(KC + (row0_ + row) * 1024 + h_ * 256 + ch * 8); \
            if (lat_) pq_[it] = *(const v4u*)(QC + (row0_ + row) * 1024 + h_ * 256 + ch * 8); } \
        if (F.tid < 128) { const int s = F.tid; \
            pv_[2] = ((const float*)(ws + WS_WST))[(size_t)seq_ * (NCHT * CHK) + k_ * CHK + s]; \
            if (lat_) { pv_[0] = ((const float*)(ws + WS_BCUM))[(size_t)seq_ * SEQ + (k_ - 2) * CHK + s]; pv_[1] = GATES[(row0_ + s) * 16 + 2 * dir_ * 4 + h_]; } } } while (0)
    if (F.bid < 1024 + 32) P4_FETCH(F.bid);
    for (int u = F.bid; u < 1024 + 32; u += F.G) {
        P4_DECODE(u, dir, b, h, k, lat)
        const int seq = dir * 8 + b * 4 + h;
#pragma unroll
        for (int it = 0; it < 8; ++it) { const int item = F.tid + NTHR * it, row = item >> 5, ch = item & 31;
            *(LAS v4u*)(Ks + row * 264 + ch * 8) = pk_[it];
            if (lat) *(LAS v4u*)(Qs + row * 264 + ch * 8) = pq_[it]; }
        if (F.tid < 128) { const int s = F.tid;
            vec[256 + s] = pv_[2];
            if (lat) { vec[s] = pv_[0]; vec[128 + s] = pv_[1] - pv_[0]; } }
        __syncthreads();
        if (u + F.G < 1024 + 32) P4_FETCH(u + F.G);
        if (lat) {
            if (w == 0) {
                const int j0 = 2 * lane, j1 = j0 + 1, s0 = dir ? 127 - j0 : j0, s1 = dir ? 127 - j1 : j1;
                float p0 = vec[128 + s0], p1 = vec[128 + s1]; wscan_max2(p0, p1, lane);
                const float mprev = ((const float*)(ws + WS_MPREV))[seq * NCHT + k];
                const float m0 = fmaxf(mprev, p0), m1 = fmaxf(mprev, p1);
                vec[384 + s0] = -m0; vec[384 + s1] = -m1;
                AINT[(size_t)u * CHK + s0] = expf(mprev - m0); AINT[(size_t)u * CHK + s1] = expf(mprev - m1);
                EXPNM[(size_t)u * CHK + s0] = expf(-(vec[s0] + m0)); EXPNM[(size_t)u * CHK + s1] = expf(-(vec[s1] + m1));
            }
            __syncthreads();
            f32x4 acc[8];
#pragma unroll
            for (int st = 0; st < 8; ++st) acc[st] = (f32x4){0.f, 0.f, 0.f, 0.f};
#pragma unroll
#define P4_LIVE(ST) (dir ? ((ST) >= w) : ((ST) <= w))
            for (int ks = 0; ks < 8; ++ks) {
                const bf16x8 qf = *(const LAS bf16x8*)(Qs + (16 * w + fr) * 264 + ks * 32 + 8 * fq);
#pragma unroll
                for (int st = 0; st < 8; ++st) if (P4_LIVE(st)) { const bf16x8 kf = *(const LAS bf16x8*)(Ks + (16 * st + fr) * 264 + ks * 32 + 8 * fq); acc[st] = mfma16(kf, qf, acc[st]); }
            }
            const int t = 16 * w + fr; const float al = vec[384 + t];
#pragma unroll
            for (int st = 0; st < 8; ++st) { const int sb = 16 * st + 4 * fq;
                if (P4_LIVE(st)) { float p[4];
#pragma unroll
                    for (int r = 0; r < 4; ++r) { const int s = sb + r; const bool ok = dir ? (s >= t) : (s <= t);
                        p[r] = ok ? expf(fminf(al + vec[128 + s], 0.f)) * acc[st][r] : 0.f; }
                    v2u o; o.x = pk2c(p[0], p[1]); o.y = pk2c(p[2], p[3]);
                    *(v2u*)(PM + ((size_t)u * CHK + t) * CHK + sb) = o; }
                else if ((st >> 1) == (w >> 1)) *(v2u*)(PM + ((size_t)u * CHK + t) * CHK + sb) = (v2u){0u, 0u};
            }
#undef P4_LIVE
        }
        {
            unsigned char* dstc = ws + WS_WKT + ((size_t)seq * NCHT + k) * (256 * 128);
#pragma unroll
            for (int it = 0; it < 4; ++it) { const int item = F.tid + NTHR * it, d = item >> 3, sg = item & 7; float q[16];
#pragma unroll
                for (int i = 0; i < 16; ++i) { const int s = sg * 16 + i; q[i] = bf2f(Ks[s * 264 + d]) * vec[256 + s] * 64.0f; }
                v4u o; o.x = pk4_fp8(q[0], q[1], q[2], q[3]); o.y = pk4_fp8(q[4], q[5], q[6], q[7]); o.z = pk4_fp8(q[8], q[9], q[10], q[11]); o.w = pk4_fp8(q[12], q[13], q[14], q[15]);
                *(v4u*)(dstc + (size_t)item * 16) = o; }
        }
        __syncthreads();
    }
}

#undef P4_FETCH
#undef P4_DECODE
__device__ __forceinline__ void p5_scan(const Frame& F) {
    unsigned char* ws = F.ws;
    const bf16* PM = (const bf16*)(ws + WS_PM); const unsigned char* WKT = ws + WS_WKT; const bf16* VTR = (const bf16*)(ws + WS_VTR);
    const float* AINT = (const float*)(ws + WS_AINT); const float* EXPNM = (const float*)(ws + WS_EXPNM); const float* ASTATE = (const float*)(ws + WS_ASTATE);
    LAS bf16* VTs = (LAS bf16*)F.lds;
    LAS unsigned char* V8 = F.lds + 17408;
    LAS unsigned char* C8 = F.lds + 26624;
    const int lane = F.lane, w = F.wave, fr = lane & 15, fq = lane >> 4, tid = F.tid;
    const int vb = (F.G == 256) ? ((F.bid & 7) * 32 + (F.bid >> 3)) : F.bid;
    typedef int i32x4 __attribute__((ext_vector_type(4))); typedef int i32x8 __attribute__((ext_vector_type(8)));
    bf16x8 ones; { const short o1 = (short)0x3F80;
#pragma unroll
        for (int i = 0; i < 8; ++i) ones[i] = o1; }
    i32x8 ones8; { const int o1 = 0x38383838;
#pragma unroll
        for (int i = 0; i < 8; ++i) ones8[i] = o1; }
#define MFMA8(A, B, C) __builtin_amdgcn_mfma_scale_f32_16x16x128_f8f6f4((A), (B), (C), 0, 0, 0, 0, 0, 0)
#define LD8(PTR) __builtin_shufflevector(*(const LAS i32x4*)(PTR), *(const LAS i32x4*)((PTR) + 64), 0, 1, 2, 3, 4, 5, 6, 7)
#define CAT8(X, Y) __builtin_shufflevector(__builtin_bit_cast(i32x4, (X)), __builtin_bit_cast(i32x4, (Y)), 0, 1, 2, 3, 4, 5, 6, 7)
    for (int unit = vb; unit < 256; unit += F.G) {
        const int seq = unit >> 4, j = unit & 15, dir = seq >> 3, b = (seq >> 2) & 1, h = seq & 3;
        bf16* HOUT = (bf16*)(ws + (dir ? WS_V : WS_QKRAW));
        f32x4 CT[2][3];
#pragma unroll
        for (int a = 0; a < 2; ++a)
#pragma unroll
            for (int e = 0; e < 3; ++e) CT[a][e] = (f32x4){0.f, 0.f, 0.f, 0.f};
        for (int i = tid; i < 2 * 48 * 272 / 4; i += NTHR) ((LAS unsigned*)C8)[i] = 0u;
        v4u qa[4], pa[4], wa[4], va, qb[4], pb[4], wb[4], vb_; float ga[3], gb[3];
        const unsigned voV = (unsigned)(((tid >> 4) * CHK + (tid & 15) * 8) * 2);
        const unsigned voQ = (unsigned)((16 * w + fr) * 1024 + 16 * fq), voP = (unsigned)(((16 * w + fr) * CHK + 8 * fq) * 2), voW = (unsigned)((32 * w + fr) * 128 + 16 * fq);
#define P5_KOF(I) (dir ? ((I) < 2 ? 1 - (I) : 67 - (I)) : (I))
#define P5_NEED(IT) (dir ? ((IT) >= (w >> 1)) : ((IT) <= (w >> 1)))
#define P5_FETCH(KK, preQ, preV, preP, preW, preG) do { const int kq_ = (KK), kk_ = kq_ < 0 ? 2 : kq_; \
            preG[2] = ASTATE[seq * NCHT + kk_]; \
            const unsigned char* bV_ = (const unsigned char*)(VTR + (((size_t)b * NCHT + kk_) * D + h * 512 + j * 32) * CHK); \
            preV = *(const v4u*)(bV_ + voV); \
            const unsigned char* bW_ = WKT + ((size_t)seq * NCHT + kk_) * (256 * 128); \
            _Pragma("unroll") for (int it = 0; it < 4; ++it) preW[it] = *(const v4u*)(bW_ + (it >> 1) * 2048 + (it & 1) * 64 + voW);     \
            { const int c_ = kk_ >= 2 ? kk_ - 2 : 0; const int u4_ = dir | (c_ << 1) | (h << 7) | (b << 9); const size_t rown_ = (size_t)b * SEQ + c_ * CHK; \
                const unsigned char* bQ_ = ws + WS_QC8 + rown_ * 1024 + h * 256; const unsigned char* bP_ = (const unsigned char*)(PM + (size_t)u4_ * CHK * CHK); \
                preG[0] = AINT[(size_t)u4_ * CHK + 16 * w + fr]; preG[1] = EXPNM[(size_t)u4_ * CHK + 16 * w + fr]; \
                _Pragma("unroll") for (int it = 0; it < 4; ++it) preQ[it] = *(const v4u*)(bQ_ + it * 64 + voQ);        \
                _Pragma("unroll") for (int it = 0; it < 4; ++it) preP[it] = *(const v4u*)(bP_ + (P5_NEED(it) ? it : (w >> 1)) * 64 + voP); } } while (0)
        P5_FETCH(P5_KOF(0), qa, va, pa, wa, ga); asm volatile("" ::: "memory");
        int tpa = 0, tpb = 0, sink = 0;
        __syncthreads();
        auto step = [&](const int idx, v4u (&preQ)[4], v4u& preV, v4u (&preP)[4], v4u (&preW)[4], float (&preG)[3], v4u (&nxtQ)[4], v4u& nxtV, v4u (&nxtP)[4], v4u (&nxtW)[4], float (&nxtG)[3], int& tp) __attribute__((always_inline)) {
            const int k = P5_KOF(idx), par = idx & 1;
            const bool lat = k >= 2;
            const int kn = (idx + 1 < NCHT) ? P5_KOF(idx + 1) : -1;
            const float a_state = preG[2], aint = preG[0] * (1.0f / 64.0f), expnm = preG[1];
            LAS bf16* VTc = VTs + par * (32 * 136); LAS unsigned char* V8c = V8 + par * (32 * 144); LAS unsigned char* C8c = C8 + par * (48 * 272); LAS unsigned char* C8n = C8 + (par ^ 1) * (48 * 272);
            { *(LAS v4u*)(VTc + (tid >> 4) * 136 + (tid & 15) * 8) = preV;
              v2u v8; v8.x = pk4_fp8(bflo(preV.x), bfhi(preV.x), bflo(preV.y), bfhi(preV.y)); v8.y = pk4_fp8(bflo(preV.z), bfhi(preV.z), bflo(preV.w), bfhi(preV.w));
              *(LAS v2u*)(V8c + (tid >> 4) * 144 + (tid & 15) * 8) = v8; }
            __syncthreads();
            P5_FETCH(kn, nxtQ, nxtV, nxtP, nxtW, nxtG);
            { const int kt0 = (idx + 3 < NCHT) ? P5_KOF(idx + 3) : 2, ct_ = kt0 >= 2 ? kt0 - 2 : 0; const int u4t = dir | (ct_ << 1) | (h << 7) | (b << 9);
              const int L = w * 64 + lane; const unsigned char* ta;
              if (L < 96) { const int sl = (j * 48 + L) % 768, ln = sl & 255;
                  ta = sl < 256 ? ws + WS_QC8 + ((size_t)b * SEQ + ct_ * CHK + (ln >> 1)) * 1024 + h * 256 + (ln & 1) * 128
                     : sl < 512 ? (const unsigned char*)(PM + (size_t)u4t * CHK * CHK) + ln * 128 : WKT + ((size_t)seq * NCHT + kt0) * (256 * 128) + ln * 128; }
              else ta = (const unsigned char*)(VTR + (((size_t)b * NCHT + kt0) * D + h * 512 + j * 32) * CHK) + (L & 63) * 128;
              sink += tp; tp = *(const int*)ta; }
            if (lat) {
                const int c = k - 2; const int u4 = dir | (c << 1) | (h << 7) | (b << 9);
                const size_t row0 = (size_t)b * SEQ + c * CHK;
                const int t = 16 * w + fr;
                f32x4 H[3];
#pragma unroll
                for (int e = 0; e < 3; ++e) H[e] = (f32x4){0.f, 0.f, 0.f, 0.f};
#pragma unroll
                for (int ks = 0; ks < 2; ++ks) { const i32x8 qf = CAT8(preQ[2 * ks], preQ[2 * ks + 1]);
#pragma unroll
                    for (int et = 0; et < 3; ++et) { const i32x8 cf = LD8(C8c + (16 * et + fr) * 272 + 128 * ks + 16 * fq); H[et] = MFMA8(cf, qf, H[et]); } }
#pragma unroll
                for (int et = 0; et < 3; ++et) H[et] = H[et] * aint;
#pragma unroll
                for (int ks = 0; ks < 4; ++ks) if (P5_NEED(ks)) { const bf16x8 pf = __builtin_bit_cast(bf16x8, preP[ks]);
                    const bf16x8 v0 = *(const LAS bf16x8*)(VTc + fr * 136 + ks * 32 + 8 * fq), v1 = *(const LAS bf16x8*)(VTc + (16 + fr) * 136 + ks * 32 + 8 * fq);
                    H[0] = mfma16(v0, pf, H[0]); H[1] = mfma16(v1, pf, H[1]); H[2] = mfma16(ones, pf, H[2]); }
                {
                    const float den = H[2][0];
                    const float inv = 1.0f / fmaxf(fabsf(den), expnm);
                    bf16* orow = HOUT + (row0 + t) * D + h * 512 + j * 32 + 4 * fq;
#pragma unroll
                    for (int et = 0; et < 2; ++et) { v2u o; o.x = pk2c(H[et][0] * inv, H[et][1] * inv); o.y = pk2c(H[et][2] * inv, H[et][3] * inv); *(v2u*)(orow + 16 * et) = o; }
                }
            }
            { const i32x8 vf0 = LD8(V8c + fr * 144 + 16 * fq), vf1 = LD8(V8c + (16 + fr) * 144 + 16 * fq);
#pragma unroll
              for (int dt = 0; dt < 2; ++dt) { const i32x8 wf = CAT8(preW[2 * dt], preW[2 * dt + 1]);
#pragma unroll
                  for (int et = 0; et < 3; ++et) CT[dt][et] = CT[dt][et] * a_state;
                  CT[dt][0] = MFMA8(wf, vf0, CT[dt][0]); CT[dt][1] = MFMA8(wf, vf1, CT[dt][1]); CT[dt][2] = MFMA8(wf, ones8, CT[dt][2]); } }
#pragma unroll
            for (int dt = 0; dt < 2; ++dt)
#pragma unroll
                for (int et = 0; et < 3; ++et) *(LAS unsigned*)(C8n + (16 * et + fr) * 272 + 32 * w + 16 * dt + 4 * fq) = pk4_fp8(CT[dt][et][0], CT[dt][et][1], CT[dt][et][2], CT[dt][et][3]);
        };
#pragma unroll 1
        for (int idx = 0; idx < NCHT; idx += 2) {
            step(idx, qa, va, pa, wa, ga, qb, vb_, pb, wb, gb, tpa);
            step(idx + 1, qb, vb_, pb, wb, gb, qa, va, pa, wa, ga, tpb);
        }
        sink += tpa + tpb; asm volatile("" :: "v"(sink));
        __syncthreads();
    }
#undef P5_FETCH
#undef P5_KOF
#undef P5_NEED
#undef CAT8
#undef MFMA8
#undef LD8
}

__device__ __forceinline__ void p6_combine(const Frame& F, const float* head_g) {
    unsigned char* ws = F.ws;
    const bf16* HF = (const bf16*)(ws + WS_QKRAW); const bf16* HB = (const bf16*)(ws + WS_V); const bf16* OG = (const bf16*)(ws + WS_OG); bf16* HN = (bf16*)(ws + WS_HN);
    const int gw = F.bid * NWAVES + F.wave, NGW = F.G * NWAVES, lane = F.lane;
    v4u na[4], nbb[4], no[4];
    if (gw < M) {
#pragma unroll
        for (int hh = 0; hh < 4; ++hh) { const size_t off = (size_t)gw * D + hh * 512 + lane * 8; na[hh] = *(const v4u*)(HF + off); nbb[hh] = *(const v4u*)(HB + off); no[hh] = *(const v4u*)(OG + off); } }
    for (int row = gw; row < M; row += NGW) {
        v4u ca[4], cb[4], co[4];
#pragma unroll
        for (int hh = 0; hh < 4; ++hh) { ca[hh] = na[hh]; cb[hh] = nbb[hh]; co[hh] = no[hh]; }
        { const int rn = (row + NGW < M) ? row + NGW : row;
#pragma unroll
          for (int hh = 0; hh < 4; ++hh) { const size_t off = (size_t)rn * D + hh * 512 + lane * 8; na[hh] = *(const v4u*)(HF + off); nbb[hh] = *(const v4u*)(HB + off); no[hh] = *(const v4u*)(OG + off); } }
#pragma unroll
        for (int hh = 0; hh < 4; ++hh) { const size_t off = (size_t)row * D + hh * 512 + lane * 8;
            const v4u a = ca[hh], b = cb[hh], o = co[hh];
            float x[8] = { bflo(a.x) + bflo(b.x), bfhi(a.x) + bfhi(b.x), bflo(a.y) + bflo(b.y), bfhi(a.y) + bfhi(b.y), bflo(a.z) + bflo(b.z), bfhi(a.z) + bfhi(b.z), bflo(a.w) + bflo(b.w), bfhi(a.w) + bfhi(b.w) };
            float ss = 0.f;
#pragma unroll
            for (int i = 0; i < 8; ++i) ss += x[i] * x[i];
            const float rstd = 1.0f / sqrtf(wsum(ss) * (1.0f / 512.0f) + EPS);
            const f32x4 g0 = *(const f32x4*)(head_g + hh * 512 + lane * 8), g1 = *(const f32x4*)(head_g + hh * 512 + lane * 8 + 4);
            const float og[8] = { bflo(o.x), bfhi(o.x), bflo(o.y), bfhi(o.y), bflo(o.z), bfhi(o.z), bflo(o.w), bfhi(o.w) };
            float y[8];
#pragma unroll
            for (int i = 0; i < 8; ++i) { const float hn = x[i] * rstd * (i < 4 ? g0[i] : g1[i - 4]); y[i] = hn * og[i]; }
            v2u w; w.x = pk4_fp8(y[0], y[1], y[2], y[3]); w.y = pk4_fp8(y[4], y[5], y[6], y[7]);
            *(v2u*)((unsigned char*)HN + off) = w; }
    }
}

#define DPP_ROR(x, n) __builtin_amdgcn_update_dpp(0, (x), 0x120 + (n), 0xf, 0xf, false)
#define DPP_SHR0(x, n) __builtin_amdgcn_update_dpp(0, (x), 0x110 + (n), 0xf, 0xf, true)
__device__ __forceinline__ float row_min(float v) {
    v = fminf(v, __int_as_float(DPP_ROR(__float_as_int(v), 8))); v = fminf(v, __int_as_float(DPP_ROR(__float_as_int(v), 4)));
    v = fminf(v, __int_as_float(DPP_ROR(__float_as_int(v), 2))); v = fminf(v, __int_as_float(DPP_ROR(__float_as_int(v), 1))); return v; }
__device__ __forceinline__ float row_max(float v) {
    v = fmaxf(v, __int_as_float(DPP_ROR(__float_as_int(v), 8))); v = fmaxf(v, __int_as_float(DPP_ROR(__float_as_int(v), 4)));
    v = fmaxf(v, __int_as_float(DPP_ROR(__float_as_int(v), 2))); v = fmaxf(v, __int_as_float(DPP_ROR(__float_as_int(v), 1))); return v; }
__device__ __forceinline__ float row_sumf(float v) {
    v += __int_as_float(DPP_ROR(__float_as_int(v), 8)); v += __int_as_float(DPP_ROR(__float_as_int(v), 4));
    v += __int_as_float(DPP_ROR(__float_as_int(v), 2)); v += __int_as_float(DPP_ROR(__float_as_int(v), 1)); return v; }
__device__ __forceinline__ int row_sumi(int v) { return row16_sum_i32(v); }
__device__ __forceinline__ int row_incl_scan(int v, int) {
    v += DPP_SHR0(v, 1); v += DPP_SHR0(v, 2); v += DPP_SHR0(v, 4); v += DPP_SHR0(v, 8); return v; }
template <int NV> __device__ __forceinline__ float row_bisect16(const float (&v)[NV]) {
    float mn = v[0], mx = v[0];
#pragma unroll
    for (int j = 1; j < NV; ++j) { mn = fminf(mn, v[j]); mx = fmaxf(mx, v[j]); }
    float lo = row_min(mn), hi = row_max(mx); int cl = NV * 16;
    for (int it = 0; it < 64; ++it) {
        const float mid = 0.5f * (lo + hi);
        const bool active = (cl != 16) && (mid > lo) && (mid < hi);
        if (!__any(active)) break;
        int c = 0;
#pragma unroll
        for (int j = 0; j < NV; ++j) c += (v[j] >= mid) ? 1 : 0;
        c = row_sumi(c);
        if (active) { if (c >= 16) { lo = mid; cl = c; } else hi = mid; }
    }
    return lo;
}

template <int NV> __device__ __forceinline__ unsigned row_select16(const float (&v)[NV]) {
    typedef short s16x2 __attribute__((ext_vector_type(2))); typedef unsigned short u16x2 __attribute__((ext_vector_type(2)));
    float mn = v[0], mx = v[0];
#pragma unroll
    for (int j = 1; j < NV; ++j) { mn = fminf(mn, v[j]); mx = fmaxf(mx, v[j]); }
    mn = row_min(mn); mx = row_max(mx);
    const float sc = 32767.0f / fmaxf(mx - mn, 1e-30f);
    unsigned kp[NV / 2];
#pragma unroll
    for (int j = 0; j < NV / 2; ++j) { const unsigned k0 = min(32767u, (unsigned)((v[2 * j] - mn) * sc)), k1 = min(32767u, (unsigned)((v[2 * j + 1] - mn) * sc)); kp[j] = k0 | (k1 << 16); }
    unsigned T = 0u;
#pragma unroll 1
    for (int b = 14; b >= 0; --b) {
        const unsigned cand = T | (1u << b); const s16x2 c2 = __builtin_bit_cast(s16x2, cand * 0x00010001u);
        u16x2 acc = (u16x2){0, 0};
#pragma unroll
        for (int j = 0; j < NV / 2; ++j) { const s16x2 d = __builtin_bit_cast(s16x2, kp[j]) - c2; acc += __builtin_bit_cast(u16x2, d) >> (unsigned short)15; }
        const unsigned a = __builtin_bit_cast(unsigned, acc);
        const int lt = row_sumi((int)((a & 0xffffu) + (a >> 16)));
        if (NV * 16 - lt >= 16) T = cand;
    }
    unsigned selm = 0u;
#pragma unroll
    for (int j = 0; j < NV; ++j) { const unsigned k = (j & 1) ? (kp[j >> 1] >> 16) : (kp[j >> 1] & 0xffffu); selm |= (k >= T ? 1u : 0u) << j; }
    return selm;
}

template <int NV> __device__ __forceinline__ void row_select16_x2(const float (&va)[NV], const float (&vb)[NV], unsigned& selma, unsigned& selmb) {
    typedef short s16x2 __attribute__((ext_vector_type(2))); typedef unsigned short u16x2 __attribute__((ext_vector_type(2)));
    float mna = va[0], mxa = va[0], mnb = vb[0], mxb = vb[0];
#pragma unroll
    for (int j = 1; j < NV; ++j) { mna = fminf(mna, va[j]); mxa = fmaxf(mxa, va[j]); mnb = fminf(mnb, vb[j]); mxb = fmaxf(mxb, vb[j]); }
    mna = row_min(mna); mxa = row_max(mxa); mnb = row_min(mnb); mxb = row_max(mxb);
    const float sca = 32767.0f / fmaxf(mxa - mna, 1e-30f), scb = 32767.0f / fmaxf(mxb - mnb, 1e-30f);
    unsigned kpa[NV / 2], kpb[NV / 2];
#pragma unroll
    for (int j = 0; j < NV / 2; ++j) { const unsigned a0 = min(32767u, (unsigned)((va[2 * j] - mna) * sca)), a1 = min(32767u, (unsigned)((va[2 * j + 1] - mna) * sca)); kpa[j] = a0 | (a1 << 16);
        const unsigned b0 = min(32767u, (unsigned)((vb[2 * j] - mnb) * scb)), b1 = min(32767u, (unsigned)((vb[2 * j + 1] - mnb) * scb)); kpb[j] = b0 | (b1 << 16); }
    unsigned Ta = 0u, Tb = 0u;
#pragma unroll 1
    for (int b = 14; b >= 0; --b) {
        const unsigned ca = Ta | (1u << b), cb = Tb | (1u << b);
        const s16x2 c2a = __builtin_bit_cast(s16x2, ca * 0x00010001u), c2b = __builtin_bit_cast(s16x2, cb * 0x00010001u);
        u16x2 acca = (u16x2){0, 0}, accb = (u16x2){0, 0};
#pragma unroll
        for (int j = 0; j < NV / 2; ++j) { const s16x2 da = __builtin_bit_cast(s16x2, kpa[j]) - c2a, db = __builtin_bit_cast(s16x2, kpb[j]) - c2b;
            acca += __builtin_bit_cast(u16x2, da) >> (unsigned short)15; accb += __builtin_bit_cast(u16x2, db) >> (unsigned short)15; }
        const unsigned a = __builtin_bit_cast(unsigned, acca), bq = __builtin_bit_cast(unsigned, accb);
        const int lt = row_sumi((int)(((a & 0xffffu) + (a >> 16)) | (((bq & 0xffffu) + (bq >> 16)) << 16)));
        if (NV * 16 - (lt & 0xffff) >= 16) Ta = ca;
        if (NV * 16 - (lt >> 16) >= 16) Tb = cb;
    }
    selma = 0u; selmb = 0u;
#pragma unroll
    for (int j = 0; j < NV; ++j) { const unsigned ka = (j & 1) ? (kpa[j >> 1] >> 16) : (kpa[j >> 1] & 0xffffu), kb = (j & 1) ? (kpb[j >> 1] >> 16) : (kpb[j >> 1] & 0xffffu);
        selma |= (ka >= Ta ? 1u : 0u) << j; selmb |= (kb >= Tb ? 1u : 0u) << j; }
}

__device__ __forceinline__ void p10_topk(const Frame& F, int layer, const Params& P) {
    const float* pu = P.in[I_PU]; const float* pv = P.in[I_PV];
    unsigned char* ws = F.ws;
    const bf16* QP = (const bf16*)(ws + WS_OG); const bf16* KEYS = (const bf16*)(ws + WS_KEYS) + (size_t)layer * (8 * 2 * 128 * 128);
    int* EIDX = (int*)(ws + WS_EIDX); float* EGATE = (float*)(ws + WS_EGATE);
    LAS bf16* keysL = (LAS bf16*)F.lds;
    LAS bf16* At = (LAS bf16*)(F.lds + 69632);
    LAS float* sc = (LAS float*)(F.lds + 86528);
    LAS float* sel_s = (LAS float*)(F.lds + 120320);
    LAS int* sel_i = (LAS int*)(F.lds + 128512);
    LAS float* fin_s = (LAS float*)(F.lds + 136704);
    LAS int* fin_i = (LAS int*)(F.lds + 140800);
    const int lane = F.lane, w = F.wave, fr = lane & 15, fq = lane >> 4, tid = F.tid;
    for (int blk = F.bid; blk < M / 64; blk += F.G) {
        v4u kreg[8], areg[2];
#pragma unroll
        for (int it = 0; it < 8; ++it) { const int item = tid + NTHR * it, row = item >> 4, ch = item & 15; kreg[it] = *(const v4u*)(KEYS + (size_t)row * 128 + ch * 8); }
#pragma unroll
        for (int it = 0; it < 2; ++it) { const int item = tid + NTHR * it, row = item >> 5, ch = item & 31; areg[it] = *(const v4u*)(QP + (size_t)(blk * 64 + row) * D + ch * 8); }
#pragma unroll 1
        for (int h = 0; h < 8; ++h) {
#pragma unroll 1
            for (int tile = 0; tile < 2; ++tile) {
                const int t0 = blk * 64 + tile * 32;
                const int tqr = (blk * 16 + h * 2 + tile) * 8 + w, tqt = tqr >> 14, tqe = tqr & (NEXP - 1);
                f32x4 tqv[4][2];
                { const float* src = (tqt ? pv : pu) + ((size_t)layer * NEXP + tqe) * D;
#pragma unroll
                  for (int j = 0; j < 4; ++j)
#pragma unroll
                      for (int q = 0; q < 2; ++q) tqv[j][q] = __builtin_nontemporal_load((const f32x4*)src + 2 * lane + 128 * j + q); }
                __syncthreads();
                if (tile == 0) {
#pragma unroll
                    for (int it = 0; it < 8; ++it) { const int item = tid + NTHR * it, row = item >> 4, ch = item & 15; *(LAS v4u*)(keysL + row * 136 + ch * 8) = kreg[it]; } }
#pragma unroll
                for (int it = 0; it < 2; ++it) { const int item = tid + NTHR * it, row = item >> 5, ch = item & 31; *(LAS v4u*)(At + row * 264 + ch * 8) = areg[it]; }
                __syncthreads();
                { const int hn = tile ? h + 1 : h, tn = tile ? 0 : 1;
                  if (hn < 8) {
#pragma unroll
                      for (int it = 0; it < 2; ++it) { const int item = tid + NTHR * it, row = item >> 5, ch = item & 31; areg[it] = *(const v4u*)(QP + (size_t)(blk * 64 + tn * 32 + row) * D + hn * 256 + ch * 8); }
                      if (tile) {
#pragma unroll
                          for (int it = 0; it < 8; ++it) { const int item = tid + NTHR * it, row = item >> 4, ch = item & 15; kreg[it] = *(const v4u*)(KEYS + ((size_t)hn * 256 + row) * 128 + ch * 8); } } } }
#pragma unroll
                for (int p = 0; p < 2; ++p)
#pragma unroll
                    for (int tt = 0; tt < 2; ++tt) { f32x4 acc = (f32x4){0.f, 0.f, 0.f, 0.f};
#pragma unroll
                        for (int ks = 0; ks < 4; ++ks) { const bf16x8 af = *(const LAS bf16x8*)(At + (16 * tt + fr) * 264 + p * 128 + ks * 32 + 8 * fq);
                            const bf16x8 kf = *(const LAS bf16x8*)(keysL + (p * 128 + 16 * w + fr) * 136 + ks * 32 + 8 * fq); acc = mfma16(kf, af, acc); }
                        *(LAS f32x4*)(sc + ((16 * tt + fr) * 2 + p) * 132 + 16 * w + 4 * fq) = acc; }
                __syncthreads();
                {
                    const int tla = 4 * w + (fq >> 1), tlb = tla + 2, p = fq & 1;
                    float va[8], vb[8];
                    { const f32x4 a = *(const LAS f32x4*)(sc + (tla * 2 + p) * 132 + fr * 8), b = *(const LAS f32x4*)(sc + (tla * 2 + p) * 132 + fr * 8 + 4);
                      va[0] = a[0]; va[1] = a[1]; va[2] = a[2]; va[3] = a[3]; va[4] = b[0]; va[5] = b[1]; va[6] = b[2]; va[7] = b[3]; }
                    { const f32x4 a = *(const LAS f32x4*)(sc + (tlb * 2 + p) * 132 + fr * 8), b = *(const LAS f32x4*)(sc + (tlb * 2 + p) * 132 + fr * 8 + 4);
                      vb[0] = a[0]; vb[1] = a[1]; vb[2] = a[2]; vb[3] = a[3]; vb[4] = b[0]; vb[5] = b[1]; vb[6] = b[2]; vb[7] = b[3]; }
                    unsigned selma, selmb; row_select16_x2<8>(va, vb, selma, selmb);
                    { const int ns = __popc(selma); int pos = row_incl_scan(ns, fr) - ns; const int o = ((tile * 32 + tla) * 2 + p) * 16;
#pragma unroll
                      for (int j = 0; j < 8; ++j) if ((selma >> j) & 1u) { if (pos < 16) { sel_s[o + pos] = va[j]; sel_i[o + pos] = fr * 8 + j; } ++pos; } }
                    { const int ns = __popc(selmb); int pos = row_incl_scan(ns, fr) - ns; const int o = ((tile * 32 + tlb) * 2 + p) * 16;
#pragma unroll
                      for (int j = 0; j < 8; ++j) if ((selmb >> j) & 1u) { if (pos < 16) { sel_s[o + pos] = vb[j]; sel_i[o + pos] = fr * 8 + j; } ++pos; } }
                }
                LDS_WAIT(); asm volatile("" ::: "memory");
                { unsigned* dst = (unsigned*)(ws + (layer ? (tqt ? WS_VT1 : WS_UT1) : (tqt ? WS_VT0 : WS_UT0)) + (size_t)tqe * 1024);
                  float ss = 0.f;
#pragma unroll
                  for (int j = 0; j < 4; ++j)
#pragma unroll
                      for (int q = 0; q < 2; ++q) ss += (tqv[j][q][0] * tqv[j][q][0] + tqv[j][q][1] * tqv[j][q][1]) + (tqv[j][q][2] * tqv[j][q][2] + tqv[j][q][3] * tqv[j][q][3]);
                  ss = wsum(ss);
                  const float rms = sqrtf(ss * (1.0f / D));
                  const float step = ss > 0.f ? (tqt ? 0.47f * rms : 0.3352f * rms) : 1.0f, inv = 1.0f / step;
#pragma unroll
                  for (int j = 0; j < 4; ++j) { unsigned wq = 0u;
                      if (tqt) wq = fp4x4(tqv[j][0][0] * inv, tqv[j][0][1] * inv, tqv[j][0][2] * inv, tqv[j][0][3] * inv) | (fp4x4(tqv[j][1][0] * inv, tqv[j][1][1] * inv, tqv[j][1][2] * inv, tqv[j][1][3] * inv) << 16);
                      else {
#pragma unroll
                          for (int i = 0; i < 4; ++i) {
                              const unsigned lo = (unsigned)__builtin_amdgcn_fmed3f(fmaf(tqv[j][0][i], inv, 8.0f), 0.0f, 15.5f), hi = (unsigned)__builtin_amdgcn_fmed3f(fmaf(tqv[j][1][i], inv, 8.0f), 0.0f, 15.5f);
                              wq |= ((lo ^ 8u) << (4 * i)) | ((hi ^ 8u) << (16 + 4 * i)); } }
                      dst[lane + 64 * j] = wq; }
                  if (lane == 0) ((float*)(ws + WS_TSC))[((size_t)layer * NEXP + tqe) * 2 + tqt] = step; }
                if (tile == 1) {
                    const int tl = 4 * w + fq, oa = (tl * 2) * 16, ob = ((32 + tl) * 2) * 16;
                    const float s1a = sel_s[oa + fr], s1b = sel_s[ob + fr];
                    float ca[16], cb[16];
#pragma unroll
                    for (int q = 0; q < 4; ++q) { const f32x4 s2 = *(const LAS f32x4*)(sel_s + oa + 16 + 4 * q); ca[4 * q] = s1a + s2[0]; ca[4 * q + 1] = s1a + s2[1]; ca[4 * q + 2] = s1a + s2[2]; ca[4 * q + 3] = s1a + s2[3]; }
#pragma unroll
                    for (int q = 0; q < 4; ++q) { const f32x4 s2 = *(const LAS f32x4*)(sel_s + ob + 16 + 4 * q); cb[4 * q] = s1b + s2[0]; cb[4 * q + 1] = s1b + s2[1]; cb[4 * q + 2] = s1b + s2[2]; cb[4 * q + 3] = s1b + s2[3]; }
                    unsigned selma, selmb; row_select16_x2<16>(ca, cb, selma, selmb);
                    { const int ns = __popc(selma); int pos = row_incl_scan(ns, fr) - ns; const int i1 = sel_i[oa + fr];
#pragma unroll
                      for (int j = 0; j < 16; ++j) if ((selma >> j) & 1u) { if (pos < 16) { fin_s[tl * 16 + pos] = ca[j]; fin_i[tl * 16 + pos] = i1 * 128 + sel_i[oa + 16 + j]; } ++pos; } }
                    { const int ns = __popc(selmb); int pos = row_incl_scan(ns, fr) - ns; const int i1 = sel_i[ob + fr];
#pragma unroll
                      for (int j = 0; j < 16; ++j) if ((selmb >> j) & 1u) { if (pos < 16) { fin_s[(32 + tl) * 16 + pos] = cb[j]; fin_i[(32 + tl) * 16 + pos] = i1 * 128 + sel_i[ob + 16 + j]; } ++pos; } }
                    LDS_WAIT(); asm volatile("" ::: "memory");
#pragma unroll
                    for (int tt = 0; tt < 2; ++tt) {
                        const float ts = fin_s[(32 * tt + tl) * 16 + fr]; const int ei = fin_i[(32 * tt + tl) * 16 + fr];
                        const float mx = row_max(ts); const float ex = expf(ts - mx); const float sm = row_sumf(ex);
                        const size_t o = (size_t)(blk * 64 + 32 * tt + tl) * 128 + h * 16 + fr;
                        EIDX[o] = ei; EGATE[o] = ex / sm;
                    }
                    LDS_WAIT(); asm volatile("" ::: "memory");
                }
            }
        }
    }
}

__device__ __forceinline__ void p11u_pass(const Frame& F, int layer) {
    unsigned char* ws = F.ws;
    const unsigned char* UT = ws + (layer ? WS_UT1 : WS_UT0);
    typedef float f32x2v __attribute__((ext_vector_type(2)));
    const f32x2v* TSC = (const f32x2v*)(ws + WS_TSC) + (size_t)layer * NEXP;
    const unsigned char* XQ = ws + WS_XQ; const f32x2v* SX = (const f32x2v*)(ws + WS_SX);
    const int* EIDX = (const int*)(ws + WS_EIDX); const float* EGATE = (const float*)(ws + WS_EGATE); float* ACT = (float*)(ws + WS_ACT);
    const int lane = F.lane, g16 = lane >> 4, l16 = lane & 15;
    LAS unsigned char* xs = F.lds + F.wave * 12288;
    LAS int* list = (LAS int*)(F.lds + F.wave * 12288 + 8192);
    LAS float* glist = (LAS float*)(F.lds + F.wave * 12288 + 10240);
    const unsigned long long lt = (1ull << lane) - 1ull;
    for (int vb = F.bid; vb < 256; vb += F.G) {
        const int bk = vb & 7, tg = (vb >> 3) * 8 + F.wave;
#pragma unroll 1
        for (int sb = 0; sb < 16; ++sb) {
            const int tok0 = tg * 64 + sb * 4;
            int n = 0;
#pragma unroll
            for (int tl = 0; tl < 4; ++tl) {
                const int e0 = EIDX[(size_t)(tok0 + tl) * 128 + lane], e1 = EIDX[(size_t)(tok0 + tl) * 128 + 64 + lane];
                const float g0 = EGATE[(size_t)(tok0 + tl) * 128 + lane], g1 = EGATE[(size_t)(tok0 + tl) * 128 + 64 + lane];
                const v4u xa = *(const v4u*)(XQ + (size_t)(tok0 + tl) * D + 16 * lane), xb = *(const v4u*)(XQ + (size_t)(tok0 + tl) * D + 1024 + 16 * lane);
                *(LAS v4u*)(xs + tl * 2048 + 16 * lane) = xa; *(LAS v4u*)(xs + tl * 2048 + 1024 + 16 * lane) = xb;
                const bool s0 = (e0 >> 11) == bk, s1 = (e1 >> 11) == bk;
                const unsigned long long m0 = __ballot(s0), m1 = __ballot(s1);
                const int c0 = __popcll(m0);
                if (s0) { const int p = n + __popcll(m0 & lt); list[p] = (e0 << 10) | (tl << 7) | lane; glist[p] = g0; }
                if (s1) { const int p = n + c0 + __popcll(m1 & lt); list[p] = (e1 << 10) | (tl << 7) | (64 + lane); glist[p] = g1; }
                n += c0 + __popcll(m1);
            }
            LDS_WAIT(); asm volatile("" ::: "memory");
            v4u u[2][4]; f32x2v sc2[2], sx2[2]; float gk[2]; int tokk[2], kidx[2], tls[2]; bool valid[2];
#define U_FETCH(P0, U, SC2, SX2, GK, TOKK, KIDX, TLS, VALID) do { _Pragma("unroll") for (int h = 0; h < 2; ++h) { const int p = (P0) + 4 * h + g16; VALID[h] = p < n; const int pp = VALID[h] ? p : 0; const int ent = VALID[h] ? list[pp] : 0; GK[h] = glist[pp]; \
                    const int e = ent >> 10; TLS[h] = (ent >> 7) & 3; const int tok = tok0 + TLS[h]; KIDX[h] = ent & 127; TOKK[h] = tok; \
                    const unsigned char* rowp = UT + (size_t)e * 1024 + l16 * 16; \
                    _Pragma("unroll") for (int i = 0; i < 4; ++i) U[h][i] = *(const v4u*)(rowp + 256 * i); \
                    SC2[h] = TSC[e]; SX2[h] = SX[tok]; } } while (0)
#define U_COMP(U, SC2, SX2, GK, TOKK, KIDX, TLS, VALID) do { _Pragma("unroll") for (int h = 0; h < 2; ++h) { int acch = 0, accl = 0; const LAS unsigned char* xp = xs + TLS[h] * 2048 + l16 * 16;     \
                    _Pragma("unroll") for (int i = 0; i < 4; ++i) { const v4u xa = *(const LAS v4u*)(xp + 256 * i), xb = *(const LAS v4u*)(xp + 1024 + 256 * i); \
                        acch = __builtin_amdgcn_sdot8((int)U[h][i].x, (int)xa.x, acch, false); accl = __builtin_amdgcn_sdot8((int)U[h][i].x, (int)xb.x, accl, false); \
                        acch = __builtin_amdgcn_sdot8((int)U[h][i].y, (int)xa.y, acch, false); accl = __builtin_amdgcn_sdot8((int)U[h][i].y, (int)xb.y, accl, false); \
                        acch = __builtin_amdgcn_sdot8((int)U[h][i].z, (int)xa.z, acch, false); accl = __builtin_amdgcn_sdot8((int)U[h][i].z, (int)xb.z, accl, false); \
                        acch = __builtin_amdgcn_sdot8((int)U[h][i].w, (int)xa.w, acch, false); accl = __builtin_amdgcn_sdot8((int)U[h][i].w, (int)xb.w, accl, false); } \
                    const int acc = row16_sum_i32(16 * acch + accl); \
                    const float d = ((float)(2 * acc) + SX2[h].y) * (0.5f * SC2[h].x * SX2[h].x);       \
                    const float act = gelu_tanh(d) * GK[h] * SC2[h].y; \
                    if (VALID[h] && l16 == 0) ACT[(size_t)TOKK[h] * 128 + KIDX[h]] = act; } } while (0)
            v4u un[2][4]; f32x2v sc2n[2], sx2n[2]; float gkn[2]; int tokkn[2], kidxn[2], tlsn[2]; bool validn[2];
            U_FETCH(0, u, sc2, sx2, gk, tokk, kidx, tls, valid);
#pragma unroll 1
            for (int p0 = 0; p0 < n; p0 += 16) {
                U_FETCH(p0 + 8, un, sc2n, sx2n, gkn, tokkn, kidxn, tlsn, validn);
                U_COMP(u, sc2, sx2, gk, tokk, kidx, tls, valid);
                U_FETCH(p0 + 16, u, sc2, sx2, gk, tokk, kidx, tls, valid);
                if (p0 + 8 < n) U_COMP(un, sc2n, sx2n, gkn, tokkn, kidxn, tlsn, validn);
            }
#undef U_COMP
#undef U_FETCH
            LDS_WAIT(); asm volatile("" ::: "memory");
        }
    }
}
template <int TAIL> __device__ __forceinline__ void p11v_pass(const Frame& F, int layer, const float* tgv, const float* tmod, unsigned char* thn, float* tout) {
    unsigned char* ws = F.ws;
    const unsigned char* VT = ws + (layer ? WS_VT1 : WS_VT0);
    bf16* HLAT = (bf16*)(ws + WS_HLAT);
    const int* EIDX = (const int*)(ws + WS_EIDX); const float* ACT = (const float*)(ws + WS_ACT);
    const float* MODV = (const float*)(ws + WS_MODV) + (size_t)layer * 3 * NMOD;
    const int lane = F.lane, l8 = lane & 7, g8 = lane >> 3, fr = lane & 15, fq = lane >> 4;
    typedef int i32x2 __attribute__((ext_vector_type(2))); typedef int i32x4 __attribute__((ext_vector_type(4))); typedef int i32x8 __attribute__((ext_vector_type(8)));
    typedef float f32x2v __attribute__((ext_vector_type(2)));
    LAS unsigned char* T = F.lds + F.wave * 17536;
    LAS unsigned char* apl = T + 16384;
    LAS float* outs = (LAS float*)(T + 16512);
    LAS unsigned char* twr = T + (16 * g8) * 128;
    const LAS unsigned char* trd = T + (32 * fq + fr) * 128;
    for (int vb = F.bid; vb < 256; vb += F.G) {
        const int s = vb & 7, tg = (vb >> 3) * 8 + F.wave;
        const unsigned char* vbase = VT + s * 128 + 16 * l8;
        i32x4 evn[4]; f32x2v a2; v4u w[16]; float part_mine = 0.f;
        { const int tok = tg * 64;
          i32x4 ev0[4];
#pragma unroll
          for (int j = 0; j < 4; ++j) ev0[j] = *(const i32x4*)(EIDX + (size_t)tok * 128 + 16 * g8 + 4 * j);
#pragma unroll
          for (int q = 0; q < 16; ++q) w[q] = *(const v4u*)(vbase + (size_t)ev0[q >> 2][q & 3] * 1024);
          a2 = *(const f32x2v*)(ACT + (size_t)tok * 128 + 2 * lane);
#pragma unroll
          for (int j = 0; j < 4; ++j) evn[j] = *(const i32x4*)(EIDX + (size_t)(tok + 1) * 128 + 16 * g8 + 4 * j); }
#pragma unroll 1
        for (int ti = 0; ti < 64; ++ti) {
            const int tok = tg * 64 + ti, tokn = tg * 64 + (ti < 63 ? ti + 1 : 63), tokn2 = tg * 64 + (ti < 62 ? ti + 2 : 63);
#pragma unroll
            for (int q = 0; q < 16; ++q) { const v4u x = (q & 1) ? (v4u){w[q].z, w[q].w, w[q].x, w[q].y} : w[q]; *(LAS v4u*)(twr + q * 128 + ((l8 ^ (q >> 1)) * 16)) = x; }
            float amax = fmaxf(fabsf(a2.x), fabsf(a2.y)); amax = wmaxf_all(amax);
            const float uh = amax > 0.f ? amax * (1.0f / 6.0f) : 1.0f, iuh = 1.0f / uh;
            { const unsigned ch = __builtin_amdgcn_cvt_scalef32_pk_fp4_f32(0u, a2.x * iuh, a2.y * iuh, 1.0f, 0) & 0xffu;
              const f32x2v dq = __builtin_amdgcn_cvt_scalef32_pk_f32_fp4(ch, 1.0f, 0);
              const unsigned cl = __builtin_amdgcn_cvt_scalef32_pk_fp4_f32(0u, (a2.x * iuh - dq[0]) * 6.0f, (a2.y * iuh - dq[1]) * 6.0f, 1.0f, 0) & 0xffu;
              apl[lane] = (unsigned char)ch; apl[64 + lane] = (unsigned char)cl; }
#pragma unroll
            for (int q = 0; q < 16; ++q) w[q] = *(const v4u*)(vbase + (size_t)evn[q >> 2][q & 3] * 1024);
            a2 = *(const f32x2v*)(ACT + (size_t)tokn * 128 + 2 * lane);
#pragma unroll
            for (int j = 0; j < 4; ++j) evn[j] = *(const i32x4*)(EIDX + (size_t)tokn2 * 128 + 16 * g8 + 4 * j);
            const int col = s * 256 + 4 * lane; const size_t off = (size_t)tok * D + col;
            const f32x4 gq = *(const f32x4*)(MODV + (size_t)(tok >> 13) * NMOD + 10240 + col); const v2u hx = *(const v2u*)(HLAT + off);
            LDS_WAIT(); asm volatile("" ::: "memory");
            i32x4 bq = (i32x4){0, 0, 0, 0};
            if (fr < 2) bq = *(const LAS i32x4*)(apl + fr * 64 + 16 * fq);
            const i32x8 b8 = (i32x8){bq[0], bq[1], bq[2], bq[3], 0, 0, 0, 0};
#pragma unroll
            for (int ct = 0; ct < 16; ++ct) {
                const LAS unsigned char* p = trd + ((ct ^ fr) * 8);
                const i32x2 r0 = __builtin_amdgcn_ds_read_tr4_b64_v2i32((LAS i32x2*)p), r1 = __builtin_amdgcn_ds_read_tr4_b64_v2i32((LAS i32x2*)(p + 2048));
                const i32x8 a8 = (i32x8){r0[0], r0[1], r1[0], r1[1], 0, 0, 0, 0};
                const f32x4 d = __builtin_amdgcn_mfma_scale_f32_16x16x128_f8f6f4(a8, b8, (f32x4){0.f, 0.f, 0.f, 0.f}, 4, 4, 0, 0, 0, 0);
                f32x4 dl;
#pragma unroll
                for (int r = 0; r < 4; ++r) dl[r] = __int_as_float(__builtin_amdgcn_update_dpp(0, __float_as_int(d[r]), 0x101, 0xf, 0xf, true));
                if (fr == 0) *(LAS f32x4*)(outs + ct * 16 + 4 * fq) = uh * (d + dl * (1.0f / 6.0f));
            }
            LDS_WAIT(); asm volatile("" ::: "memory");
            const f32x4 o = *(const LAS f32x4*)(outs + 4 * lane);
            f32x4 h0 = (f32x4){bflo(hx.x), bfhi(hx.x), bflo(hx.y), bfhi(hx.y)};
#pragma unroll
            for (int i = 0; i < 4; ++i) h0[i] += gq[i] * o[i];
            { v2u ho; ho.x = pk2c(h0[0], h0[1]); ho.y = pk2c(h0[2], h0[3]); *(v2u*)(HLAT + off) = ho;
              if (TAIL) { const float b0 = bflo(ho.x), b1 = bfhi(ho.x), b2 = bflo(ho.y), b3 = bfhi(ho.y); const float ss = wsum((b0 * b0 + b1 * b1) + (b2 * b2 + b3 * b3)); if (lane == ti) part_mine = ss; } }
            LDS_WAIT(); asm volatile("" ::: "memory");
        }
        if (TAIL) {
            float* xsl = (float*)(ws + WS_XCH) + ((size_t)(layer * 256 + tg) * 8) * 64;
            unsigned* xcnt = (unsigned*)(ws + WS_CTL) + CW_XCH + layer * 256 + tg;
            __hip_atomic_store(xsl + s * 64 + lane, part_mine, __ATOMIC_RELAXED, __HIP_MEMORY_SCOPE_AGENT);
            asm volatile("s_waitcnt vmcnt(0)" ::: "memory");
            if (lane == 0) (void)xb_add(xcnt, 1u);
            { unsigned sp = 0u; while (xb_ld(xcnt) < 8u) { __builtin_amdgcn_s_sleep(2); if (++sp > XB_SPIN_CAP) break; } }
            float tot = 0.f;
#pragma unroll
            for (int q = 0; q < 8; ++q) tot += __hip_atomic_load(xsl + q * 64 + lane, __ATOMIC_RELAXED, __HIP_MEMORY_SCOPE_AGENT);
            const float rstd_l = 1.0f / sqrtf(tot * (1.0f / D) + EPS);
            const int col = s * 256 + 4 * lane, bt = (tg * 64) >> 13;
            const f32x4 g4 = *(const f32x4*)(tgv + col);
            f32x4 am = g4, bm = (f32x4){0.f, 0.f, 0.f, 0.f};
            if (TAIL == 1) { const float* mv = tmod + (size_t)bt * NMOD; const f32x4 sc = *(const f32x4*)(mv + 2048 + col), sh = *(const f32x4*)(mv + col); am = g4 * (sc + 1.0f); bm = sh; }
#pragma unroll 1
            for (int t0 = 0; t0 < 64; t0 += 32) {
                v2u hx[32];
#pragma unroll
                for (int i = 0; i < 32; ++i) hx[i] = *(const v2u*)(HLAT + (size_t)(tg * 64 + t0 + i) * D + col);
#pragma unroll
                for (int i = 0; i < 32; ++i) { const size_t off = (size_t)(tg * 64 + t0 + i) * D + col;
                    const float rstd = __int_as_float(__builtin_amdgcn_readlane(__float_as_int(rstd_l), t0 + i));
                    const f32x4 y = (f32x4){bflo(hx[i].x), bfhi(hx[i].x), bflo(hx[i].y), bfhi(hx[i].y)} * rstd * am + bm;
                    if (TAIL == 1) *(unsigned*)(thn + off) = pk4_fp8(y[0], y[1], y[2], y[3]);
                    else __builtin_nontemporal_store(y, (f32x4*)(tout + off)); }
            }
        }
    }
}

__device__ __forceinline__ void p14_spatial(const Frame& F, const Params& P) {
    unsigned char* ws = F.ws;
    const bf16* U = (const bf16*)(ws + WS_QKRAW); const bf16* VV = (const bf16*)(ws + WS_V); bf16* HN = (bf16*)(ws + WS_HN);
    const float* VSSP = (const float*)(ws + WS_VSSP);
    const float* w_s = P.in[I_CMWS]; const float* b_s = P.in[I_CMBS]; const float* g_v = P.in[I_CMGV];
    LAS bf16* Wp = (LAS bf16*)F.lds;
    LAS bf16* Vr = (LAS bf16*)(F.lds + 34816);
    LAS float* rs = (LAS float*)(F.lds + 103424);
    const int lane = F.lane, w = F.wave, fr = lane & 15, fq = lane >> 4, tid = F.tid;
    for (int u = F.bid; u < 1024; u += F.G) {
        const int g = u & 7, c = (u >> 3) & 63, b = u >> 9; const size_t row0 = (size_t)b * SEQ + c * CHK;
        __syncthreads();
        if (tid < 128) { float s = 0.f; for (int i = 0; i < 32; ++i) s += VSSP[(row0 + tid) * 32 + i]; rs[tid] = 1.0f / sqrtf(s * (1.0f / D) + EPS); }
#pragma unroll
        for (int it = 0; it < 8; ++it) { const int item = tid + NTHR * it, s = item >> 5, ch = item & 31;
            const v4u x = *(const v4u*)(VV + (row0 + s) * D + g * 256 + ch * 8);
            LAS v2u* d2 = (LAS v2u*)(Vr + s * 268 + ch * 8); d2[0] = (v2u){x.x, x.y}; d2[1] = (v2u){x.z, x.w}; }
        __syncthreads();
#pragma unroll
        for (int it = 0; it < 4; ++it) { const int item = tid + NTHR * it, t = item >> 4, s0 = (item & 15) * 8;
            const f32x4 a = *(const f32x4*)(w_s + ((size_t)g * 128 + t) * 128 + s0), bq = *(const f32x4*)(w_s + ((size_t)g * 128 + t) * 128 + s0 + 4);
            v4u o; o.x = pk2(a[0] * rs[s0], a[1] * rs[s0 + 1]); o.y = pk2(a[2] * rs[s0 + 2], a[3] * rs[s0 + 3]); o.z = pk2(bq[0] * rs[s0 + 4], bq[1] * rs[s0 + 5]); o.w = pk2(bq[2] * rs[s0 + 6], bq[3] * rs[s0 + 7]);
            *(LAS v4u*)(Wp + t * 136 + s0) = o; }
        __syncthreads();
        bf16x8 wf[4];
#pragma unroll
        for (int ks = 0; ks < 4; ++ks) wf[ks] = *(const LAS bf16x8*)(Wp + (16 * w + fr) * 136 + ks * 32 + 8 * fq);
        const int t = 16 * w + fr; const float bs = b_s[g * 128 + t];
#pragma unroll 2
        for (int dt = 0; dt < 16; ++dt) {
            f32x4 acc = (f32x4){0.f, 0.f, 0.f, 0.f};
#pragma unroll
            for (int ks = 0; ks < 4; ++ks) { bf16x8 vf;
#pragma unroll
                for (int i = 0; i < 8; ++i) vf[i] = (short)Vr[(ks * 32 + 8 * fq + i) * 268 + 16 * dt + fr];
                acc = mfma16(vf, wf[ks], acc); }
            const int dcol = g * 256 + 16 * dt + 4 * fq;
            const v2u uu = *(const v2u*)(U + (row0 + t) * D + dcol); const f32x4 gv = *(const f32x4*)(g_v + dcol);
            *(unsigned*)((unsigned char*)HN + (row0 + t) * D + dcol) = pk4_fp8(bflo(uu.x) * (acc[0] * gv[0] + bs), bfhi(uu.x) * (acc[1] * gv[1] + bs), bflo(uu.y) * (acc[2] * gv[2] + bs), bfhi(uu.y) * (acc[3] * gv[3] + bs));
        }
    }
}


#ifndef PROBE_HASH_N
#define PROBE_HASH_N ((size_t)M * D)
#endif
__device__ __forceinline__ void p_hash_bf16(const Frame& F, size_t wsoff, float* dout) {
    const bf16* src = (const bf16*)(F.ws + wsoff);
    for (size_t i = (size_t)F.bid * NTHR + F.tid; i < (size_t)M * D; i += (size_t)F.G * NTHR) { const unsigned h = ((unsigned)src[i < (size_t)PROBE_HASH_N ? i : 0] + 1u) * 2654435761u; dout[i] = (float)(h >> 8) * (1.0f / 16777216.0f); }
}
__device__ __forceinline__ void p_hash_f32(const Frame& F, size_t wsoff, float* dout) {
    const unsigned* src = (const unsigned*)(F.ws + wsoff);
    for (size_t i = (size_t)F.bid * NTHR + F.tid; i < (size_t)M * D; i += (size_t)F.G * NTHR) { const unsigned h = (src[i] + 1u) * 2654435761u; dout[i] = (float)(h >> 8) * (1.0f / 16777216.0f); }
}

__device__ __forceinline__ void p_final_only(const Frame& F, const float* g_final, float* dout) {
    const bf16* HLAT = (const bf16*)(F.ws + WS_HLAT);
    const int gw = F.bid * NWAVES + F.wave, NGW = F.G * NWAVES, lane = F.lane;
    v2u nx[8];
    f32x4 g4r[8];
#pragma unroll
    for (int j = 0; j < 8; ++j) g4r[j] = ((const f32x4*)g_final)[lane + 64 * j];
    if (gw < M) {
#pragma unroll
        for (int j = 0; j < 8; ++j) nx[j] = ((const v2u*)(HLAT + (size_t)gw * D))[lane + 64 * j]; }
    for (int row = gw; row < M; row += NGW) {
        f32x4 v[8]; float s = 0.f;
#pragma unroll
        for (int j = 0; j < 8; ++j) { const v2u x = nx[j]; v[j] = (f32x4){bflo(x.x), bfhi(x.x), bflo(x.y), bfhi(x.y)}; s += (v[j][0] * v[j][0] + v[j][1] * v[j][1]) + (v[j][2] * v[j][2] + v[j][3] * v[j][3]); }
        { const int rn = (row + NGW < M) ? row + NGW : row;
#pragma unroll
          for (int j = 0; j < 8; ++j) nx[j] = ((const v2u*)(HLAT + (size_t)rn * D))[lane + 64 * j]; }
        const float rstd = 1.0f / sqrtf(wsum(s) * (1.0f / D) + EPS);
#pragma unroll
        for (int j = 0; j < 8; ++j) __builtin_nontemporal_store(v[j] * rstd * g4r[j], (f32x4*)(dout + (size_t)row * D) + lane + 64 * j);
    }
}

constexpr int NPHASE = 20;
__global__ void __launch_bounds__(NTHR, 2) fwd(Params P) {
    extern __shared__ __attribute__((aligned(16))) unsigned char lds_[];
    Frame F; F.lds = (LAS unsigned char*)lds_; F.ws = P.ws; F.tid = threadIdx.x; F.lane = F.tid & 63; F.wave = __builtin_amdgcn_readfirstlane(F.tid >> 6); F.G = gridDim.x; F.bid = blockIdx.x;
    unsigned char* ws = P.ws;
    volatile LAS unsigned* MISC = (volatile LAS unsigned*)(F.lds + LDS_MISC);
    if (F.tid < 16) MISC[F.tid] = 0u;
    __syncthreads();
    const int lo = P.ph_lo, hi = P.ph_hi;
    XcdBarrier bar; bar.bar = (unsigned*)(ws + WS_CTL) + CW_BAR; bar.x = 0; bar.st = MISC + 8;
    if (hi - lo > 1) bar = xcd_barrier_post((unsigned*)(ws + WS_CTL) + CW_BAR, MISC + 8);
#define IN(k) (lo <= (k) && (k) < hi)
#define SEAM(k) do { if (IN(k) && IN((k) + 1)) xcd_barrier(bar); } while (0)
#ifndef PROBE_DUP_MASK
#define PROBE_DUP_MASK 0u
#endif
#define NREP(k) (((PROBE_DUP_MASK >> (k)) & 1u) ? 2 : 1)
    float* MODV = (float*)(ws + WS_MODV);
    bf16* HN = (bf16*)(ws + WS_HN); bf16* HLAT = (bf16*)(ws + WS_HLAT);

    if (IN(0)) for (int rep_ = 0; rep_ < NREP(0); ++rep_) { if (rep_) xcd_barrier(bar); p0_prologue(F, P); } SEAM(0);
    if (IN(1)) for (int rep_ = 0; rep_ < NREP(1); ++rep_) { if (rep_) xcd_barrier(bar); p1_adaln_gates(F, P.in[I_X], P.in[I_CTX], MC, P.in[I_GMIX], MODV, 0, 2048, (unsigned char*)HN, (const float*)(ws + WS_WG), P.in[I_MLGB], (float*)(ws + WS_GATES)); } SEAM(1);
    if (IN(2)) for (int rep_ = 0; rep_ < NREP(2); ++rep_) { if (rep_) xcd_barrier(bar);
        { pg8::Gemm g{(const pg8::bf16_t*)HN, (const pg8::bf16_t*)(ws + WS_WIN0), M, 6144, D / 2}; pg8::StaticOrder S; S.init(M, 6144, F.G, F.bid);
          EpiML E{(bf16*)(ws + WS_QKRAW), (bf16*)(ws + WS_VTR), (bf16*)(ws + WS_OG), 0, W8_INV};
          pg8::gemm_phase<EpiML, pg8::StaticOrder, true, true, true>(F.lds, g, S, E); }
        __syncthreads();
        { pg8::Gemm g{(const pg8::bf16_t*)((const unsigned char*)HN + (size_t)M * D), (const pg8::bf16_t*)(ws + WS_WIN0 + (size_t)1024 * D), MC, 3072, D / 2}; pg8::StaticOrder S; S.init(MC, 3072, F.G, F.bid);
          EpiML E{(bf16*)(ws + WS_QKRAW) + (size_t)M * D, (bf16*)(ws + WS_VTR), nullptr, 1, W8_INV};
          pg8::gemm_phase<EpiML, pg8::StaticOrder, true, true, true>(F.lds, g, S, E); }
    } SEAM(2);
    if (IN(3)) for (int rep_ = 0; rep_ < NREP(3); ++rep_) { if (rep_) xcd_barrier(bar); p3_conv(F, P); } SEAM(3);
    if (IN(4)) for (int rep_ = 0; rep_ < NREP(4); ++rep_) { if (rep_) xcd_barrier(bar); p4_intra(F); } SEAM(4);
    if (IN(5)) for (int rep_ = 0; rep_ < NREP(5); ++rep_) { if (rep_) xcd_barrier(bar); p5_scan(F); } SEAM(5);
    if (IN(6)) for (int rep_ = 0; rep_ < NREP(6); ++rep_) { if (rep_) xcd_barrier(bar); p6_combine(F, P.in[I_MLHG]); } SEAM(6);
    if (IN(7)) for (int rep_ = 0; rep_ < NREP(7); ++rep_) { if (rep_) xcd_barrier(bar); pg8::Gemm g{(const pg8::bf16_t*)HN, (const pg8::bf16_t*)(ws + WS_WOUT0), M, D, D / 2}; pg8::StaticOrder S; S.init(M, D, F.G, F.bid);
        EpiResid<false> E{P.in[I_X], HLAT, MODV + 4096, W8_INV};
        pg8::gemm_phase<EpiResid<false>, pg8::StaticOrder, true, true, true>(F.lds, g, S, E); } SEAM(7);
    if (IN(8)) for (int rep_ = 0; rep_ < NREP(8); ++rep_) { if (rep_) xcd_barrier(bar); adaln_phase<false, true, true>(F, HLAT, nullptr, 0, P.in[I_GCHAN], MODV, 6144, 8192, HN, nullptr, nullptr, nullptr); } SEAM(8);
    if (IN(9)) for (int rep_ = 0; rep_ < NREP(9); ++rep_) { if (rep_) xcd_barrier(bar); pg8::Gemm g{(const pg8::bf16_t*)HN, (const pg8::bf16_t*)(ws + WS_WQ0), M, D, D}; pg8::StaticOrder S; S.init(M, D, F.G, F.bid);
        EpiPlain E{(bf16*)(ws + WS_OG), 1.0f};
        pg8::gemm_phase<EpiPlain, pg8::StaticOrder, true, true>(F.lds, g, S, E); } SEAM(9);
    if (IN(10)) for (int rep_ = 0; rep_ < NREP(10); ++rep_) { if (rep_) xcd_barrier(bar); p10_topk(F, 0, P); } SEAM(10);
    if (IN(11)) { for (int rep_ = 0; rep_ < NREP(24); ++rep_) { p11u_pass(F, 0); xcd_barrier(bar); } if (F.G == 256) p11v_pass<1>(F, 0, P.in[I_GMIX] + D, MODV + 3 * NMOD, (unsigned char*)HN, nullptr); else p11v_pass<0>(F, 0, nullptr, nullptr, nullptr, nullptr); } SEAM(11);
    if (IN(12)) for (int rep_ = 0; rep_ < NREP(12); ++rep_) { if (rep_) xcd_barrier(bar); if (F.G != 256) adaln_phase<false, false, true, true>(F, HLAT, nullptr, 0, P.in[I_GMIX] + D, MODV + 3 * NMOD, 0, 2048, HN, nullptr, nullptr, nullptr); } if (F.G != 256) SEAM(12);
    if (IN(13)) for (int rep_ = 0; rep_ < NREP(13); ++rep_) { if (rep_) xcd_barrier(bar); pg8::Gemm g{(const pg8::bf16_t*)HN, (const pg8::bf16_t*)(ws + WS_WIN1), M, 4096, D / 2}; pg8::StaticOrder S; S.init(M, 4096, F.G, F.bid);
        EpiCM E{(bf16*)(ws + WS_QKRAW), (bf16*)(ws + WS_V), (float*)(ws + WS_VSSP), W8_INV};
        pg8::gemm_phase<EpiCM, pg8::StaticOrder, true, true, true>(F.lds, g, S, E); } SEAM(13);
    if (IN(14)) for (int rep_ = 0; rep_ < NREP(14); ++rep_) { if (rep_) xcd_barrier(bar); p14_spatial(F, P); } SEAM(14);
    if (IN(15)) { pg8::Gemm g{(const pg8::bf16_t*)HN, (const pg8::bf16_t*)(ws + WS_WOUT1), M, D, D / 2}; pg8::StaticOrder S; S.init(M, D, F.G, F.bid);
        EpiResid<true> E{HLAT, HLAT, MODV + 3 * NMOD + 4096, W8_INV};
        pg8::gemm_phase<EpiResid<true>, pg8::StaticOrder, true, true, true>(F.lds, g, S, E); } SEAM(15);
    if (IN(16)) for (int rep_ = 0; rep_ < NREP(16); ++rep_) { if (rep_) xcd_barrier(bar); adaln_phase<false, true, true, true>(F, HLAT, nullptr, 0, P.in[I_GCHAN] + D, MODV + 3 * NMOD, 6144, 8192, HN, nullptr, nullptr, nullptr); } SEAM(16);
    if (IN(17)) for (int rep_ = 0; rep_ < NREP(17); ++rep_) { if (rep_) xcd_barrier(bar); pg8::Gemm g{(const pg8::bf16_t*)HN, (const pg8::bf16_t*)(ws + WS_WQ1), M, D, D / 2}; pg8::StaticOrder S; S.init(M, D, F.G, F.bid);
        EpiPlain E{(bf16*)(ws + WS_OG), W8_INV};
        pg8::gemm_phase<EpiPlain, pg8::StaticOrder, true, true, true>(F.lds, g, S, E); } SEAM(17);
    if (IN(18)) for (int rep_ = 0; rep_ < NREP(18); ++rep_) { if (rep_) xcd_barrier(bar); p10_topk(F, 1, P); } SEAM(18);
    if (IN(19)) { for (int rep_ = 0; rep_ < NREP(24); ++rep_) { p11u_pass(F, 1); xcd_barrier(bar); } { p11v_pass<0>(F, 1, nullptr, nullptr, nullptr, nullptr); xcd_barrier(bar); p_final_only(F, P.in[I_GFINAL], P.out); } }
    if (IN(20)) { p_final_only(F, P.in[I_GFINAL], P.out); }
#ifndef PROBE_HASH_N
#define PROBE_HASH_N ((size_t)M * D)
#endif
#ifdef PROBE_HASH_OFF
    if (IN(21)) { if (PROBE_HASH_F32) p_hash_f32(F, PROBE_HASH_OFF, P.out); else p_hash_bf16(F, PROBE_HASH_OFF, P.out); }
#endif
#undef IN
#undef SEAM
}

#ifndef MK_ONE_LAUNCH
#define MK_ONE_LAUNCH 1
#endif
extern "C" void kernel_launch(void* const* d_in, const int* in_sizes, int n_in, void* d_out, int out_size, void* d_ws, size_t ws_size, hipStream_t stream) {
    static int grid = 0;
    if (grid == 0) {
        if (n_in != 24 || in_sizes[0] != M * D || out_size != M * D || ws_size < WS_END) { fprintf(stderr, "kernel_launch: unexpected shapes (n_in %d, in0 %d, out %d, ws %zu)\n", n_in, n_in > 0 ? in_sizes[0] : -1, out_size, ws_size); grid = -1; return; }
        int dev = 0, cus = 0, per_cu = 0;
        if (hipGetDevice(&dev) != hipSuccess || hipDeviceGetAttribute(&cus, hipDeviceAttributeMultiprocessorCount, dev) != hipSuccess) { grid = -1; return; }
        if (hipFuncSetAttribute((const void*)fwd, hipFuncAttributeMaxDynamicSharedMemorySize, LDS_BYTES) != hipSuccess) { fprintf(stderr, "kernel_launch: hipFuncSetAttribute failed\n"); grid = -1; return; }
        if (hipOccupancyMaxActiveBlocksPerMultiprocessor(&per_cu, (const void*)fwd, NTHR, LDS_BYTES) != hipSuccess || per_cu < 1) fprintf(stderr, "kernel_launch: occupancy query reports %d\n", per_cu);
        (void)hipGetLastError();
        grid = cus;
    }
    if (grid < 0) return;
    (void)hipMemsetAsync((char*)d_ws + WS_CTL, 0, CTL_ZERO_BYTES, stream);
    Params p{};
    for (int i = 0; i < 24; ++i) p.in[i] = (const float*)d_in[i];
    p.out = (float*)d_out; p.ws = (unsigned char*)d_ws;
#if MK_ONE_LAUNCH
    p.ph_lo = 0; p.ph_hi = NPHASE;
    hipLaunchKernelGGL(fwd, dim3(grid), dim3(NTHR), LDS_BYTES, stream, p);
#else
#ifdef MK_TRUNC
    for (int ph = 0; ph <= MK_TRUNC; ++ph) { p.ph_lo = ph; p.ph_hi = ph + 1; hipLaunchKernelGGL(fwd, dim3(grid), dim3(NTHR), LDS_BYTES, stream, p); }
#ifdef PROBE_HASH_OFF
    p.ph_lo = 21; p.ph_hi = 22; hipLaunchKernelGGL(fwd, dim3(grid), dim3(NTHR), LDS_BYTES, stream, p);
#else
    p.ph_lo = 20; p.ph_hi = 21; hipLaunchKernelGGL(fwd, dim3(grid), dim3(NTHR), LDS_BYTES, stream, p);
#endif
#else
    for (int ph = 0; ph < NPHASE; ++ph) { p.ph_lo = ph; p.ph_hi = ph + 1; hipLaunchKernelGGL(fwd, dim3(grid), dim3(NTHR), LDS_BYTES, stream, p); }
#endif
#endif
}
```

```cpp
#include <hip/hip_runtime.h>
#include <cstdio>
#include <cstdint>
namespace pg8 {
#define PG8_LAS __attribute__((address_space(3)))
typedef unsigned short bf16_t;
typedef short bf16x8 __attribute__((ext_vector_type(8)));
typedef float f32x4 __attribute__((ext_vector_type(4)));
typedef unsigned u32x4 __attribute__((ext_vector_type(4)));
constexpr int BM = 256, BK = 64, HALF = 128, HTB = HALF * BK * 2  , STAGE_BYTES = 8 * HTB, NXCD = 8, WGM = 8;

__host__ __device__ __forceinline__ int lds_byte(int r, int c) { const int st = (r >> 4) * 2 + (c >> 5), rr = r & 15, cc = c & 31, ob = rr * 64 + cc * 2; return st * 1024 + (ob ^ (((ob >> 9) & 1) << 5)); }
__host__ __device__ __forceinline__ void stage_rc(int b, int& R, int& C) { const int st = b / 1024, sb = b % 1024, swz = sb ^ (((sb >> 9) & 1) << 5); R = (st >> 1) * 16 + swz / 64; C = (st & 1) * 32 + (swz % 64) / 2; }
__host__ __device__ __forceinline__ int perm32(int rho) { const int n = rho >> 4, i = rho & 15; return 8 * (i >> 2) + 4 * n + (i & 3); }

struct Unit { int pm, pn; };
struct Gemm { const bf16_t* A; const bf16_t* Bt; int M, N, K; };

struct StaticOrder {
    int nM, nN, nwg, G, c, wgm;
    __host__ __device__ void init(int M, int N, int G_, int c_) { nM = M / BM; nN = N / BM; nwg = nM * nN; G = G_; c = c_; wgm = (nN == 16) ? 2 : 4; }
    __host__ __device__ bool next(int i, Unit& u) const {
        const long L = (long)i * G + c; if (L >= nwg) return false;
        int wgid = (int)L; { const int q = nwg / NXCD, r = nwg % NXCD, xcd = wgid % NXCD, off = wgid / NXCD; wgid = (xcd < r ? xcd * (q + 1) : r * (q + 1) + (xcd - r) * q) + off; }
        const int nig = wgm * nN, gid = wgid / nig, fm = gid * wgm, gsz = (nM - fm) < wgm ? (nM - fm) : wgm;
        u.pm = fm + ((wgid % nig) % gsz); u.pn = (wgid % nig) / gsz; return true;
    }
    __device__ __forceinline__ void a_ready(const Unit&) const {}
    __device__ __forceinline__ void done(const Unit&) const {}
};
__device__ __forceinline__ unsigned cvt_pk_bf16(float lo, float hi) { unsigned r; asm volatile("v_cvt_pk_bf16_f32 %0, %1, %2" : "=v"(r) : "v"(lo), "v"(hi)); return r; }
typedef float f32x2 __attribute__((ext_vector_type(2)));
template <class Epi, class Sched, bool ALIGN_EPI = false, bool SP2 = false, bool FP8 = false>
__device__ __forceinline__ void gemm_phase(PG8_LAS unsigned char* lds, const Gemm g, const Sched& S, const Epi& E) {
    const int tid = threadIdx.x, wid = __builtin_amdgcn_readfirstlane(tid >> 6), lane = tid & 63, wr = wid >> 2, wc = wid & 3, fr = lane & 15, fq = lane >> 4;
    const int K = g.K, nt = K / BK;
    unsigned voffA[2], voffB[2];
#pragma unroll
    for (int i = 0; i < 2; ++i) { int R, C; stage_rc(tid * 16 + i * 8192, R, C); const int Rb = Epi::PERM ? ((R & ~31) + perm32(R & 31)) : R;
        voffA[i] = (unsigned)(R * K + C) * 2u; voffB[i] = (unsigned)(Rb * K + C) * 2u; }
    const size_t kstep = (size_t)(BK * 2);
    const size_t hstep = (size_t)HALF * K * 2;
    const size_t tstep = 2 * hstep;
    const unsigned ldsw = (unsigned)wid * 1024u;
    const int aoff = lds_byte(wr * 64 + fr, fq * 8), boff = lds_byte(wc * 32 + fr, fq * 8);
#define PG8_SA(b, h) (((b) * 2 + (h)) * HTB)
#define PG8_SB(b, h) ((4 + (b) * 2 + (h)) * HTB)
#define PG8_STAGE(bufoff, gbase, voff) do { _Pragma("unroll") for (int _i = 0; _i < 2; ++_i) \
        __builtin_amdgcn_global_load_lds((const unsigned*)((const char*)(gbase) + (voff)[_i]), (PG8_LAS unsigned*)(lds + (bufoff) + ldsw + _i * 8192), 16, 0, 0); } while (0)
#define PG8_LDA(dst, b, h) do { _Pragma("unroll") for (int m = 0; m < 4; ++m) { const pg8_v4i l0_ = *(const PG8_LAS pg8_v4i*)(lds + PG8_SA(b, h) + aoff + m * 2048), l1_ = *(const PG8_LAS pg8_v4i*)(lds + PG8_SA(b, h) + aoff + m * 2048 + 1024); dst[m] = __builtin_shufflevector(l0_, l1_, 0, 1, 2, 3, 4, 5, 6, 7); } } while (0)
#define PG8_LDB(dst, b, h) do { _Pragma("unroll") for (int n = 0; n < 2; ++n) { const pg8_v4i l0_ = *(const PG8_LAS pg8_v4i*)(lds + PG8_SB(b, h) + boff + n * 2048), l1_ = *(const PG8_LAS pg8_v4i*)(lds + PG8_SB(b, h) + boff + n * 2048 + 1024); dst[n] = __builtin_shufflevector(l0_, l1_, 0, 1, 2, 3, 4, 5, 6, 7); } } while (0)
#define PG8_MMA(ai, bj, At, Bt) do { __builtin_amdgcn_s_setprio(1); _Pragma("unroll") for (int m = 0; m < 4; ++m) _Pragma("unroll") for (int n = 0; n < 2; ++n) { \
        if constexpr (FP8) { asm volatile("v_mfma_f32_16x16x128_f8f6f4 %0, %1, %2, %0" : "+v"(acc[ai][bj][m][n]) : "v"(Bt[n]), "v"(At[m])); }     \
        else { acc[ai][bj][m][n] = __builtin_amdgcn_mfma_f32_16x16x32_bf16(__builtin_bit_cast(bf16x8, __builtin_shufflevector(Bt[n], Bt[n], 0, 1, 2, 3)), __builtin_bit_cast(bf16x8, __builtin_shufflevector(At[m], At[m], 0, 1, 2, 3)), acc[ai][bj][m][n], 0, 0, 0); \
               acc[ai][bj][m][n] = __builtin_amdgcn_mfma_f32_16x16x32_bf16(__builtin_bit_cast(bf16x8, __builtin_shufflevector(Bt[n], Bt[n], 4, 5, 6, 7)), __builtin_bit_cast(bf16x8, __builtin_shufflevector(At[m], At[m], 4, 5, 6, 7)), acc[ai][bj][m][n], 0, 0, 0); } } \
        __builtin_amdgcn_s_setprio(0); } while (0)
#define PG8_WAIT_V(n) asm volatile("s_waitcnt vmcnt(" #n ")" ::: "memory")
#define PG8_WAIT_L(n) asm volatile("s_waitcnt lgkmcnt(" #n ")" ::: "memory")
#define PG8_BAR __builtin_amdgcn_s_barrier()
#define PG8_SCHED __builtin_amdgcn_sched_barrier(0)
    Unit cur, nxt; int ui = 0;
    if (!S.next(0, cur)) return;
    f32x4 acc[2][2][4][2];
#pragma unroll
    for (int a = 0; a < 2; ++a)
#pragma unroll
        for (int b = 0; b < 2; ++b)
#pragma unroll
            for (int m = 0; m < 4; ++m)
#pragma unroll
                for (int n = 0; n < 2; ++n) acc[a][b][m][n] = (f32x4){0.f, 0.f, 0.f, 0.f};
    typedef int pg8_v4i __attribute__((ext_vector_type(4))); typedef int pg8_v8i __attribute__((ext_vector_type(8)));
    pg8_v8i At[4], B0[2], B1[2];
    const char* cA = (const char*)g.A + (size_t)cur.pm * tstep; const char* cB = (const char*)g.Bt + (size_t)cur.pn * tstep;
    S.a_ready(cur);
    if constexpr (SP2) {
        PG8_STAGE(PG8_SB(0, 0), cB, voffB); PG8_STAGE(PG8_SB(0, 1), cB + hstep, voffB); PG8_STAGE(PG8_SA(0, 0), cA, voffA); PG8_STAGE(PG8_SA(0, 1), cA + hstep, voffA);
        if (wr == 1) PG8_BAR;
        PG8_WAIT_V(2); PG8_BAR;
        PG8_STAGE(PG8_SB(1, 0), cB + kstep, voffB); PG8_STAGE(PG8_SA(1, 0), cA + kstep, voffA); PG8_STAGE(PG8_SB(1, 1), cB + hstep + kstep, voffB);
        PG8_WAIT_V(6); PG8_BAR;
    } else {
        PG8_STAGE(PG8_SB(0, 0), cB, voffB); PG8_STAGE(PG8_SA(0, 0), cA, voffA); PG8_STAGE(PG8_SB(0, 1), cB + hstep, voffB); PG8_STAGE(PG8_SA(0, 1), cA + hstep, voffA);
        if (wr == 1) PG8_BAR;
        PG8_WAIT_V(4); PG8_BAR;
        PG8_STAGE(PG8_SB(1, 0), cB + kstep, voffB); PG8_STAGE(PG8_SA(1, 0), cA + kstep, voffA); PG8_STAGE(PG8_SB(1, 1), cB + hstep + kstep, voffB);
        PG8_WAIT_V(6); PG8_BAR;
    }
    for (;;) {
        const bool has_next = S.next(ui + 1, nxt);
        const char* nA = has_next ? (const char*)g.A + (size_t)nxt.pm * tstep : cA; const char* nB = has_next ? (const char*)g.Bt + (size_t)nxt.pn * tstep : cB;
        for (int t = 0; t < nt; t += 2) {
            const bool last = (t == nt - 2);
            const char* a1 = cA + (size_t)(t + 1) * kstep;
            const char* a2 = last ? nA : cA + (size_t)(t + 2) * kstep; const char* b2 = last ? nB : cB + (size_t)(t + 2) * kstep;
            const char* a3 = a2 + kstep; const char* b3 = b2 + kstep;
            if (last && has_next) S.a_ready(nxt);
            if constexpr (SP2) {
            PG8_LDB(B0, 0, 0); PG8_LDB(B1, 0, 1); PG8_SCHED; PG8_LDA(At, 0, 0); PG8_STAGE(PG8_SA(1, 1), a1 + hstep, voffA);
            PG8_WAIT_V(8); PG8_WAIT_L(0); PG8_BAR; PG8_MMA(0, 0, At, B0); PG8_MMA(0, 1, At, B1); PG8_BAR; PG8_SCHED;
            PG8_LDA(At, 0, 1); PG8_STAGE(PG8_SB(0, 0), b2, voffB); PG8_STAGE(PG8_SB(0, 1), b2 + hstep, voffB); PG8_STAGE(PG8_SA(0, 0), a2, voffA);
            PG8_WAIT_V(8); PG8_WAIT_L(0); PG8_BAR; PG8_MMA(1, 0, At, B0); PG8_MMA(1, 1, At, B1); PG8_BAR; PG8_SCHED;
            PG8_LDB(B0, 1, 0); PG8_LDB(B1, 1, 1); PG8_SCHED; PG8_LDA(At, 1, 0); PG8_STAGE(PG8_SA(0, 1), a2 + hstep, voffA);
            PG8_WAIT_V(8); PG8_WAIT_L(0); PG8_BAR; PG8_MMA(0, 0, At, B0); PG8_MMA(0, 1, At, B1); PG8_BAR; PG8_SCHED;
            PG8_LDA(At, 1, 1); PG8_STAGE(PG8_SB(1, 0), b3, voffB); PG8_STAGE(PG8_SB(1, 1), b3 + hstep, voffB); PG8_STAGE(PG8_SA(1, 0), a3, voffA);
            PG8_WAIT_V(8); PG8_WAIT_L(0); PG8_BAR; PG8_MMA(1, 0, At, B0); PG8_MMA(1, 1, At, B1); PG8_BAR; PG8_SCHED;
            } else {
            PG8_LDB(B0, 0, 0); PG8_SCHED; PG8_LDA(At, 0, 0); PG8_STAGE(PG8_SA(1, 1), a1 + hstep, voffA);
            PG8_WAIT_L(8); PG8_BAR; PG8_WAIT_L(0); PG8_MMA(0, 0, At, B0); PG8_BAR; PG8_SCHED;
            PG8_LDB(B1, 0, 1); PG8_STAGE(PG8_SB(0, 0), b2, voffB);
            PG8_BAR; PG8_WAIT_L(0); PG8_MMA(0, 1, At, B1); PG8_BAR;
            PG8_LDA(At, 0, 1); PG8_STAGE(PG8_SA(0, 0), a2, voffA);
            PG8_BAR; PG8_WAIT_L(0); PG8_MMA(1, 0, At, B0); PG8_BAR; PG8_SCHED;
            PG8_STAGE(PG8_SB(0, 1), b2 + hstep, voffB);
            PG8_WAIT_V(6); PG8_BAR; PG8_MMA(1, 1, At, B1); PG8_BAR;
            PG8_LDB(B0, 1, 0); PG8_SCHED; PG8_LDA(At, 1, 0); PG8_STAGE(PG8_SA(0, 1), a2 + hstep, voffA);
            PG8_WAIT_L(8); PG8_BAR; PG8_WAIT_L(0); PG8_MMA(0, 0, At, B0); PG8_BAR; PG8_SCHED;
            PG8_LDB(B1, 1, 1); PG8_STAGE(PG8_SB(1, 0), b3, voffB);
            PG8_BAR; PG8_WAIT_L(0); PG8_MMA(0, 1, At, B1); PG8_BAR;
            PG8_LDA(At, 1, 1); PG8_STAGE(PG8_SA(1, 0), a3, voffA);
            PG8_BAR; PG8_WAIT_L(0); PG8_MMA(1, 0, At, B0); PG8_BAR; PG8_SCHED;
            PG8_STAGE(PG8_SB(1, 1), b3 + hstep, voffB);
            PG8_WAIT_V(6); PG8_BAR; PG8_MMA(1, 1, At, B1); PG8_BAR;
            }
        }
        if constexpr (FP8) asm volatile("s_nop 7\n\ts_nop 7" ::: "memory");
        if constexpr (ALIGN_EPI) { if (wr == 0) PG8_BAR; }
        if constexpr (!Epi::AFTER_DRAIN) { E(acc, cur, wr, wc, fr, fq); S.done(cur); }
        if (!has_next) break;
#pragma unroll
        for (int a = 0; a < 2; ++a)
#pragma unroll
            for (int b = 0; b < 2; ++b)
#pragma unroll
                for (int m = 0; m < 4; ++m)
#pragma unroll
                    for (int n = 0; n < 2; ++n) acc[a][b][m][n] = (f32x4){0.f, 0.f, 0.f, 0.f};
        cur = nxt; cA = nA; cB = nB; ++ui;
        if constexpr (ALIGN_EPI) { if (wr == 1) PG8_BAR; }
    }
    PG8_WAIT_V(0);
    if constexpr (!ALIGN_EPI) { if (wr == 0) PG8_BAR; }
    PG8_BAR;
    if constexpr (Epi::AFTER_DRAIN) { E.fused(acc, cur, wr, wc, fr, fq, lds, wid, lane); S.done(cur); }
#undef PG8_SA
#undef PG8_SB
#undef PG8_STAGE
#undef PG8_LDA
#undef PG8_LDB
#undef PG8_MMA
#undef PG8_WAIT_V
#undef PG8_WAIT_L
#undef PG8_BAR
#undef PG8_SCHED
}
}

#define GAS __attribute__((address_space(1)))
#define LAS __attribute__((address_space(3)))
typedef unsigned short bf16;
typedef unsigned v4u __attribute__((ext_vector_type(4)));
typedef unsigned v2u __attribute__((ext_vector_type(2)));
typedef float f32x4 __attribute__((ext_vector_type(4)));
typedef short bf16x8 __attribute__((ext_vector_type(8)));

constexpr int NWAVES = 8, NTHR = 512;
constexpr int D = 2048, SEQ = 8192, M = 16384, CTXL = 256, MC = 512, MT = M + MC;
constexpr int NMOD = 12288;
constexpr int NH = 4, DQK = 256, DV = 512, CHK = 128, NCH = 64, NCHT = 66;
constexpr int NEXP = 16384;
constexpr float EPS = 1e-6f;
constexpr float W8_SCALE = 64.0f, W8_INV = 1.0f / 64.0f;

constexpr size_t MiB = (size_t)1 << 20;
constexpr size_t WS_CTL = 0, CTL_ZERO_BYTES = 1 * MiB;
constexpr size_t WS_MODV = 1 * MiB;
constexpr size_t WS_WG = 1 * MiB + 512 * 1024;
constexpr size_t WS_VSS = 1 * MiB + 768 * 1024;
constexpr size_t WS_BCUM = 2 * MiB;
constexpr size_t WS_WST = 2 * MiB + 512 * 1024;
constexpr size_t WS_MPREV = 3 * MiB + 256 * 1024;
constexpr size_t WS_ASTATE = WS_MPREV + 8192;
constexpr size_t WS_AINT = 4 * MiB;
constexpr size_t WS_EXPNM = 4 * MiB + 512 * 1024;
constexpr size_t WS_GATES = 5 * MiB;
constexpr size_t WS_KEYS = 7 * MiB;
constexpr size_t WS_WIN0 = 8 * MiB, WS_WOUT0 = 32 * MiB, WS_WQ0 = 40 * MiB, WS_WIN1 = 48 * MiB, WS_WOUT1 = 64 * MiB, WS_WQ1 = 72 * MiB;
constexpr size_t WS_UT0 = 80 * MiB, WS_VT0 = 96 * MiB, WS_UT1 = 112 * MiB, WS_VT1 = 128 * MiB;
constexpr size_t WS_TSC = 208 * MiB;
constexpr size_t WS_XQ = 212 * MiB;
constexpr size_t WS_SX = 244 * MiB;
constexpr size_t WS_HLAT = 336 * MiB;
constexpr size_t WS_HN = 464 * MiB;
constexpr size_t WS_QKRAW = 532 * MiB;
constexpr size_t WS_V = 600 * MiB;
constexpr size_t WS_OG = 668 * MiB;
constexpr size_t WS_QC = 732 * MiB;
constexpr size_t WS_EIDX = 732 * MiB, WS_EGATE = 740 * MiB, WS_ACT = 748 * MiB;
constexpr size_t WS_XCH = 756 * MiB;
constexpr size_t WS_KC = 764 * MiB;
constexpr size_t WS_WKT = 798 * MiB;
constexpr size_t WS_VTR = 864 * MiB;
constexpr size_t WS_PM = 930 * MiB;
constexpr size_t WS_VSSP = 962 * MiB;
constexpr size_t WS_QC8 = 964 * MiB;
constexpr size_t WS_END = 980 * MiB;
constexpr int CW_BAR = 4096;
constexpr int CW_XCH = 32768;

constexpr int LDS_BYTES = 147456;
constexpr int LDS_MISC = 145408;

#define LDS_WAIT() asm volatile("s_waitcnt lgkmcnt(0)" ::: "memory")
#define VM_WAIT() asm volatile("s_waitcnt vmcnt(0)" ::: "memory")

typedef __bf16 bf16x2_t __attribute__((ext_vector_type(2)));
typedef float f32x2_t __attribute__((ext_vector_type(2)));
__device__ __forceinline__ unsigned pk2c(float lo, float hi) { const bf16x2_t v = __builtin_convertvector((f32x2_t){lo, hi}, bf16x2_t); return __builtin_bit_cast(unsigned, v); }
__device__ __forceinline__ unsigned pk2(float lo, float hi) { unsigned r; asm volatile("v_cvt_pk_bf16_f32 %0, %1, %2" : "=v"(r) : "v"(lo), "v"(hi)); return r; }
__device__ __forceinline__ unsigned pk4_fp8(float a, float b, float c2, float d) { int w = __builtin_amdgcn_cvt_pk_fp8_f32(a, b, 0, false); w = __builtin_amdgcn_cvt_pk_fp8_f32(c2, d, w, true); return (unsigned)w; }
__device__ __forceinline__ unsigned e2m1_code(float x) { const float ax = fabsf(x);
    const unsigned m = (ax >= 0.25f) + (ax >= 0.75f) + (ax >= 1.25f) + (ax >= 1.75f) + (ax >= 2.5f) + (ax >= 3.5f) + (ax >= 5.0f); return m | (x < 0.f ? 8u : 0u); }
__device__ __forceinline__ float e2m1_val(unsigned cd) { const unsigned m = cd & 7u; const float a = m < 4u ? 0.5f * (float)m : (m == 4u ? 2.0f : m == 5u ? 3.0f : m == 6u ? 4.0f : 6.0f); return (cd & 8u) ? -a : a; }
__device__ __forceinline__ unsigned fp4x4(float a, float b, float c, float d) { unsigned w = __builtin_amdgcn_cvt_scalef32_pk_fp4_f32(0u, a, b, 1.0f, 0); return __builtin_amdgcn_cvt_scalef32_pk_fp4_f32(w, c, d, 1.0f, 1) & 0xffffu; }
__device__ __forceinline__ float bflo(unsigned u) { return __uint_as_float(u << 16); }
__device__ __forceinline__ float bfhi(unsigned u) { return __uint_as_float(u & 0xffff0000u); }
__device__ __forceinline__ float bf2f(bf16 b) { return __uint_as_float(((unsigned)b) << 16); }
__device__ __forceinline__ float fexp(float x) { return __builtin_amdgcn_exp2f(x * 1.4426950408889634f); }
__device__ __forceinline__ float sigmoidf_(float x) { return __builtin_amdgcn_rcpf(1.0f + fexp(-x)); }
__device__ __forceinline__ float siluf_(float x) { return x * sigmoidf_(x); }
__device__ __forceinline__ float gelu_tanh(float x) { const float u = 0.7978845608028654f * (x + 0.044715f * x * x * x); return x * __builtin_amdgcn_rcpf(1.0f + fexp(-2.0f * u)); }
__device__ __forceinline__ float log_sigmoid(float x) { return fminf(x, 0.f) - log1pf(expf(-fabsf(x))); }
#define WR_DPP(x, c) __int_as_float(__builtin_amdgcn_update_dpp(0, __float_as_int(x), (c), 0xf, 0xf, false))
#define WR_LANE(x, l) __int_as_float(__builtin_amdgcn_readlane(__float_as_int(x), (l)))
__device__ __forceinline__ float wmaxf_all(float v) {
    v = fmaxf(v, WR_DPP(v, 0x128)); v = fmaxf(v, WR_DPP(v, 0x124)); v = fmaxf(v, WR_DPP(v, 0x122)); v = fmaxf(v, WR_DPP(v, 0x121));
    return fmaxf(fmaxf(WR_LANE(v, 0), WR_LANE(v, 16)), fmaxf(WR_LANE(v, 32), WR_LANE(v, 48)));
}
__device__ __forceinline__ int row16_sum_i32(int v) {
    v += __builtin_amdgcn_update_dpp(0, v, 0x128, 0xf, 0xf, false);
    v += __builtin_amdgcn_update_dpp(0, v, 0x124, 0xf, 0xf, false);
    v += __builtin_amdgcn_update_dpp(0, v, 0x122, 0xf, 0xf, false);
    v += __builtin_amdgcn_update_dpp(0, v, 0x121, 0xf, 0xf, false);
    return v;
}
__device__ __forceinline__ unsigned q4(float a, float b, float c, float d, float inv, int bias) {
    int qa = (int)rintf(a * inv), qb = (int)rintf(b * inv), qc = (int)rintf(c * inv), qd = (int)rintf(d * inv);
    qa = min(127, max(-127, qa)) + bias; qb = min(127, max(-127, qb)) + bias; qc = min(127, max(-127, qc)) + bias; qd = min(127, max(-127, qd)) + bias;
    return (unsigned)(qa & 255) | ((unsigned)(qb & 255) << 8) | ((unsigned)(qc & 255) << 16) | ((unsigned)(qd & 255) << 24);
}
__device__ __forceinline__ float wsum(float v) {
    v += WR_DPP(v, 0x128); v += WR_DPP(v, 0x124); v += WR_DPP(v, 0x122); v += WR_DPP(v, 0x121);
    return (WR_LANE(v, 0) + WR_LANE(v, 16)) + (WR_LANE(v, 32) + WR_LANE(v, 48));
}

#define XB_TMO      128
#define XB_XCNT(j)  (256  + 64 * (j))
#define XB_XSUB(j)  (1280 + 64 * (j))
#define XB_XGEN(j)  (2304 + 64 * (j))
#define XB_TOP      3328
#define XB_TOPGEN   3392
#define XCD_BAR_WORDS 3456
#define XB_SPIN_CAP (1u << 22)

__device__ __forceinline__ unsigned xb_ld(unsigned* p)              { return __hip_atomic_load(p, __ATOMIC_RELAXED, __HIP_MEMORY_SCOPE_AGENT); }
__device__ __forceinline__ unsigned xb_add(unsigned* p, unsigned v) { return __hip_atomic_fetch_add(p, v, __ATOMIC_RELAXED, __HIP_MEMORY_SCOPE_AGENT); }
__device__ __forceinline__ unsigned xb_xcc_id() { return (unsigned)__builtin_amdgcn_s_getreg((3 << 11) | 20) & 0xFu; }
#define XB_SPIN(cond, bar) do { unsigned _sp = 0; while (cond) { __builtin_amdgcn_s_sleep(1); \
    if ((++_sp & 255u) == 0u) { if (xb_ld(&(bar)[XB_TMO])) break; if (_sp > XB_SPIN_CAP) { atomicAdd(&(bar)[XB_TMO], 1u); break; } } } } while (0)

struct XcdBarrier { unsigned* bar; unsigned x; volatile LAS unsigned* st; };

__device__ __forceinline__ XcdBarrier xcd_barrier_post(unsigned* bar, volatile LAS unsigned* st) {
    XcdBarrier b; b.bar = bar; b.x = xb_xcc_id(); b.st = st;
    if (threadIdx.x == 0) (void)xb_add(&bar[XB_XCNT(b.x)], 1u);
    return b;
}
__device__ __forceinline__ void xcd_barrier_complete(unsigned* bar, unsigned x, unsigned& nloc, unsigned& nx) {
    const unsigned G = gridDim.x * gridDim.y * gridDim.z;
    unsigned sum, cnt, mine, sp = 0u;
    for (;;) {
        sum = 0u; cnt = 0u; mine = 0u;
#pragma unroll
        for (unsigned j = 0; j < 16; ++j) { const unsigned c = xb_ld(&bar[XB_XCNT(j)]); sum += c; cnt += (c > 0u) ? 1u : 0u; mine = (j == x) ? c : mine; }
        if (sum == G) break;
        __builtin_amdgcn_s_sleep(1);
        if ((++sp & 255u) == 0u) { if (xb_ld(&bar[XB_TMO])) break; if (sp > XB_SPIN_CAP) { atomicAdd(&bar[XB_TMO], 1u); break; } }
    }
    nloc = mine > 0u ? mine : 1u; nx = cnt > 0u ? cnt : 1u;
}
__device__ __forceinline__ void xcd_barrier(const XcdBarrier& b) {
    asm volatile("s_waitcnt vmcnt(0)" ::: "memory");
    __syncthreads();
    if (threadIdx.x == 0) {
        unsigned* bar = b.bar;
        __builtin_amdgcn_s_waitcnt(0);
        unsigned nloc = b.st[0], nx = b.st[1];
        if (nloc == 0u) { xcd_barrier_complete(bar, b.x, nloc, nx); b.st[0] = nloc; b.st[1] = nx; }
        const unsigned old = xb_add(&bar[XB_XSUB(b.x)], 1u);
        const unsigned gen = old / nloc;
        if (old + 1u == (gen + 1u) * nloc) {
            __builtin_amdgcn_fence(__ATOMIC_RELEASE, "agent");
            asm volatile("s_waitcnt vmcnt(0)" ::: "memory");
            const unsigned og = xb_add(&bar[XB_TOP], 1u);
            const unsigned tg = og / nx;
            if (og + 1u == (tg + 1u) * nx) xb_add(&bar[XB_TOPGEN], 1u);
            else XB_SPIN(xb_ld(&bar[XB_TOPGEN]) == tg, bar);
            __builtin_amdgcn_fence(__ATOMIC_ACQUIRE, "agent");
            xb_add(&bar[XB_XGEN(b.x)], 1u);
            asm volatile("s_waitcnt vmcnt(0)" ::: "memory");
        } else {
            XB_SPIN(xb_ld(&bar[XB_XGEN(b.x)]) == gen, bar);
            __builtin_amdgcn_fence(__ATOMIC_ACQUIRE, "agent");
            asm volatile("s_waitcnt vmcnt(0)" ::: "memory");
        }
    }
    __syncthreads();
}

struct Params { const float* in[24]; float* out; unsigned char* ws; int ph_lo, ph_hi; };
struct Frame { LAS unsigned char* lds; unsigned char* ws; int tid, lane, wave, G, bid; };

enum { I_X = 0, I_C, I_CTX, I_CCTX, I_WMOD, I_BMOD, I_GMIX, I_GCHAN, I_MLWIN, I_MLCW, I_MLCB, I_MLGB, I_MLHG, I_MLWOUT, I_CMWIN, I_CMGV, I_CMWS, I_CMBS, I_CMWOUT, I_PWQ, I_PKEYS, I_PU, I_PV, I_GFINAL };

struct EpiML {
    static constexpr bool PERM = true, AFTER_DRAIN = false;
    bf16* qk; bf16* vtr; bf16* og; int ctx; float asc;
    __device__ __forceinline__ void operator()(const pg8::f32x4 (&acc)[2][2][4][2], const pg8::Unit& u, int wr, int wc, int fr, int fq) const {
        asm volatile("" : "+v"(fr), "+v"(fq));
        const int row0 = u.pm * 256 + wr * 64 + fr; const int pn = u.pn; bf16* base = qk; int colt; bool sg = false, isv = false;
        if (!ctx) { if (pn < 8) { base = qk; colt = pn * 256; } else if (pn < 16) { isv = true; colt = (pn - 8) * 256; } else { base = og; colt = (pn - 16) * 256; sg = true; } }
        else { if (pn < 4) { base = qk; colt = 1024 + pn * 256; } else { isv = true; colt = (pn - 4) * 256; } }
        const int col0 = colt + wc * 32 + 8 * fq;
#pragma unroll
        for (int ai = 0; ai < 2; ++ai)
#pragma unroll
            for (int m = 0; m < 4; ++m) { const int r = row0 + ai * 128 + m * 16; bf16* rowp = base + (size_t)r * D + col0;
                const int b = ctx ? (r >> 8) : (r >> 13), k = ctx ? ((r >> 7) & 1) : 2 + ((r >> 7) & 63), s = r & 127;
                bf16* vp = vtr + (((size_t)b * NCHT + k) * D + col0) * CHK + s;
#pragma unroll
                for (int bj = 0; bj < 2; ++bj) { pg8::f32x4 v0 = acc[ai][bj][m][0] * asc, v1 = acc[ai][bj][m][1] * asc;
                    if (sg) {
#pragma unroll
                        for (int j = 0; j < 4; ++j) { v0[j] = sigmoidf_(v0[j]); v1[j] = sigmoidf_(v1[j]); } }
                    v4u w; w.x = pk2(v0[0], v0[1]); w.y = pk2(v0[2], v0[3]); w.z = pk2(v1[0], v1[1]); w.w = pk2(v1[2], v1[3]);
                    if (!isv) *(v4u*)(rowp + bj * 128) = w;
                    else { bf16* q = vp + (size_t)(bj * 128) * CHK;
                        q[0 * CHK] = (bf16)(w.x & 0xffffu); q[1 * CHK] = (bf16)(w.x >> 16); q[2 * CHK] = (bf16)(w.y & 0xffffu); q[3 * CHK] = (bf16)(w.y >> 16);
                        q[4 * CHK] = (bf16)(w.z & 0xffffu); q[5 * CHK] = (bf16)(w.z >> 16); q[6 * CHK] = (bf16)(w.w & 0xffffu); q[7 * CHK] = (bf16)(w.w >> 16); } } }
    }
};
struct EpiPlain {
    static constexpr bool PERM = true, AFTER_DRAIN = false;
    bf16* O; float asc;
    __device__ __forceinline__ void operator()(const pg8::f32x4 (&acc)[2][2][4][2], const pg8::Unit& u, int wr, int wc, int fr, int fq) const {
        asm volatile("" : "+v"(fr), "+v"(fq));
        const int row0 = u.pm * 256 + wr * 64 + fr; const int col0 = u.pn * 256 + wc * 32 + 8 * fq;
#pragma unroll
        for (int ai = 0; ai < 2; ++ai)
#pragma unroll
            for (int m = 0; m < 4; ++m) { bf16* rowp = O + (size_t)(row0 + ai * 128 + m * 16) * D + col0;
#pragma unroll
                for (int bj = 0; bj < 2; ++bj) { const pg8::f32x4 v0 = acc[ai][bj][m][0] * asc, v1 = acc[ai][bj][m][1] * asc;
                    v4u w; w.x = pk2(v0[0], v0[1]); w.y = pk2(v0[2], v0[3]); w.z = pk2(v1[0], v1[1]); w.w = pk2(v1[2], v1[3]);
                    *(v4u*)(rowp + bj * 128) = w; } }
    }
};
struct EpiCM {
    static constexpr bool PERM = true, AFTER_DRAIN = false;
    bf16* U; bf16* V; float* vssp; float asc;
    __device__ __forceinline__ void operator()(const pg8::f32x4 (&acc)[2][2][4][2], const pg8::Unit& u, int wr, int wc, int fr, int fq) const {
        asm volatile("" : "+v"(fr), "+v"(fq));
        const int row0 = u.pm * 256 + wr * 64 + fr; const bool isv = u.pn >= 8; bf16* base = isv ? V : U;
        const int col0 = (isv ? u.pn - 8 : u.pn) * 256 + wc * 32 + 8 * fq;
#pragma unroll
        for (int ai = 0; ai < 2; ++ai)
#pragma unroll
            for (int m = 0; m < 4; ++m) { const int row = row0 + ai * 128 + m * 16; bf16* rowp = base + (size_t)row * D + col0; float ss = 0.f;
#pragma unroll
                for (int bj = 0; bj < 2; ++bj) { pg8::f32x4 v0 = acc[ai][bj][m][0] * asc, v1 = acc[ai][bj][m][1] * asc;
#pragma unroll
                    for (int j = 0; j < 4; ++j) { v0[j] = gelu_tanh(v0[j]); v1[j] = gelu_tanh(v1[j]); ss += v0[j] * v0[j] + v1[j] * v1[j]; }
                    v4u w; w.x = pk2(v0[0], v0[1]); w.y = pk2(v0[2], v0[3]); w.z = pk2(v1[0], v1[1]); w.w = pk2(v1[2], v1[3]);
                    *(v4u*)(rowp + bj * 128) = w; }
                if (isv) {
                    { const unsigned b = __float_as_uint(ss); const auto r = __builtin_amdgcn_permlane16_swap(b, b, false, false); ss = __uint_as_float(r[0]) + __uint_as_float(r[1]); }
                    { const unsigned b = __float_as_uint(ss); const auto r = __builtin_amdgcn_permlane32_swap(b, b, false, false); ss = __uint_as_float(r[0]) + __uint_as_float(r[1]); }
                    if (fq == 0) vssp[(size_t)row * 32 + (u.pn - 8) * 4 + wc] = ss; } }
    }
};
template <bool BASE_BF16> struct EpiResid {
    static constexpr bool PERM = true, AFTER_DRAIN = false;
    const void* base; bf16* out; const float* gate; float asc;
    __device__ __forceinline__ void operator()(const pg8::f32x4 (&acc)[2][2][4][2], const pg8::Unit& u, int wr, int wc, int fr, int fq) const {
        asm volatile("" : "+v"(fr), "+v"(fq));
        const int row0 = u.pm * 256 + wr * 64 + fr, col0 = u.pn * 256 + wc * 32 + 8 * fq;
        const float* gt = gate + (size_t)((u.pm * 256) >> 13) * NMOD + col0;
        pg8::f32x4 gv[2][2];
#pragma unroll
        for (int bj = 0; bj < 2; ++bj)
#pragma unroll
            for (int n = 0; n < 2; ++n) gv[bj][n] = *(const pg8::f32x4*)(gt + bj * 128 + 4 * n) * asc;
#pragma unroll
        for (int ai = 0; ai < 2; ++ai)
#pragma unroll
            for (int m = 0; m < 4; ++m) { const size_t off = (size_t)(row0 + ai * 128 + m * 16) * D + col0;
#pragma unroll
                for (int bj = 0; bj < 2; ++bj) { pg8::f32x4 b0, b1;
                    if (BASE_BF16) { const v4u x = *(const v4u*)((const bf16*)base + off + bj * 128); b0 = (pg8::f32x4){bflo(x.x), bfhi(x.x), bflo(x.y), bfhi(x.y)}; b1 = (pg8::f32x4){bflo(x.z), bfhi(x.z), bflo(x.w), bfhi(x.w)}; }
                    else { b0 = __builtin_nontemporal_load((const pg8::f32x4*)((const float*)base + off + bj * 128)); b1 = __builtin_nontemporal_load((const pg8::f32x4*)((const float*)base + off + bj * 128 + 4)); }
                    const pg8::f32x4 r0 = b0 + gv[bj][0] * acc[ai][bj][m][0], r1 = b1 + gv[bj][1] * acc[ai][bj][m][1];
                    v4u w; w.x = pk2c(r0[0], r0[1]); w.y = pk2c(r0[2], r0[3]); w.z = pk2c(r1[0], r1[1]); w.w = pk2c(r1[2], r1[3]);
                    *(v4u*)(out + off + bj * 128) = w; } }
    }
};

__device__ __forceinline__ void tr_load(const float* W, int ldw, int nblk, int item, int lane, f32x4 (&r)[8]) {
    const int kb = item / nblk, nb = item % nblk, k0 = 64 * kb, n0 = 32 * nb, g = lane >> 3, c4 = lane & 7;
#pragma unroll
    for (int i = 0; i < 8; ++i) r[i] = __builtin_nontemporal_load((const f32x4*)(W + (size_t)(k0 + 8 * g + i) * ldw + n0 + 4 * c4));
}
__device__ __forceinline__ void tr_store_bf16(bf16* WT, int K, int nblk, int item, int lane, const f32x4 (&r)[8]) {
    const int kb = item / nblk, nb = item % nblk, k0 = 64 * kb, n0 = 32 * nb, g = lane >> 3, c4 = lane & 7;
#pragma unroll
    for (int c = 0; c < 4; ++c) { v4u o; o.x = pk2(r[0][c], r[1][c]); o.y = pk2(r[2][c], r[3][c]); o.z = pk2(r[4][c], r[5][c]); o.w = pk2(r[6][c], r[7][c]);
        *(v4u*)(WT + (size_t)(n0 + 4 * c4 + c) * K + k0 + 8 * g) = o; }
}
__device__ __forceinline__ void tr_store_fp8(unsigned char* WT, int K, int nblk, int item, int lane, const f32x4 (&r)[8], float scale) {
    const int kb = item / nblk, nb = item % nblk, k0 = 64 * kb, n0 = 32 * nb, g = lane >> 3, c4 = lane & 7;
#pragma unroll
    for (int c = 0; c < 4; ++c) { v2u o; o.x = pk4_fp8(r[0][c] * scale, r[1][c] * scale, r[2][c] * scale, r[3][c] * scale); o.y = pk4_fp8(r[4][c] * scale, r[5][c] * scale, r[6][c] * scale, r[7][c] * scale);
        *(v2u*)(WT + (size_t)(n0 + 4 * c4 + c) * K + k0 + 8 * g) = o; }
}
__device__ __forceinline__ void p0_prologue(const Frame& F, const Params& P) {
    unsigned char* ws = F.ws;
    const int gt = F.bid * NTHR + F.tid, NGT = F.G * NTHR;
    {
        LAS float* sil = (LAS float*)F.lds;
        LAS float* red = (LAS float*)(F.lds + 24576);
        for (int i = F.tid; i < 3 * D; i += NTHR) { const int r = i / D, k = i % D; const float cv = r < 2 ? P.in[I_C][r * D + k] : P.in[I_CCTX][k]; sil[i] = siluf_(cv); }
        __syncthreads();
        const int cg = F.tid & 15, rl = F.tid >> 4;
        for (int u = F.bid; u < 384; u += F.G) {
            const int layer = u / 192, col0 = (u % 192) * 64;
            const float* W = P.in[I_WMOD] + (size_t)layer * D * NMOD + col0 + cg * 4;
            float a[3][4];
#pragma unroll
            for (int r = 0; r < 3; ++r)
#pragma unroll
                for (int j = 0; j < 4; ++j) a[r][j] = 0.f;
#pragma unroll 8
            for (int k = rl; k < D; k += 32) {
                const f32x4 w = __builtin_nontemporal_load((const f32x4*)(W + (size_t)k * NMOD));
                const float s0 = sil[k], s1 = sil[D + k], s2 = sil[2 * D + k];
#pragma unroll
                for (int j = 0; j < 4; ++j) { a[0][j] += s0 * w[j]; a[1][j] += s1 * w[j]; a[2][j] += s2 * w[j]; }
            }
#pragma unroll
            for (int r = 0; r < 3; ++r)
#pragma unroll
                for (int j = 0; j < 4; ++j) red[(rl * 16 + cg) * 12 + r * 4 + j] = a[r][j];
            __syncthreads();
            if (F.tid < 192) { const int cj = F.tid & 63, r = F.tid >> 6; float s = 0.f;
                for (int q = 0; q < 32; ++q) s += red[(q * 16 + (cj >> 2)) * 12 + r * 4 + (cj & 3)];
                ((float*)(ws + WS_MODV))[((size_t)layer * 3 + r) * NMOD + col0 + cj] = s + P.in[I_BMOD][layer * NMOD + col0 + cj]; }
            __syncthreads();
        }
    }
    for (int i = gt; i < M; i += NGT) ((float*)(ws + WS_VSS))[i] = 0.f;
    for (int i = gt; i < 16 * D; i += NGT) { const int j = i / D, k = i % D; ((float*)(ws + WS_WG))[i] = P.in[I_MLWIN][(size_t)k * 6160 + 6144 + j]; }
    for (int i = gt; i < 2 * 8 * 2 * 128 * 128 / 2; i += NGT) { const float a = P.in[I_PKEYS][2 * i], b = P.in[I_PKEYS][2 * i + 1]; ((unsigned*)(ws + WS_KEYS))[i] = pk2(a, b); }
    {
        const int gw = F.bid * NWAVES + F.wave, NGW = F.G * NWAVES;
        constexpr int I0 = 32 * 192, I1 = 32 * 64, I2 = 32 * 128;
        constexpr int NIT = I0 + I1 + I1 + I2 + I1 + I1;
        for (int it = gw; it < NIT; it += NGW) {
            f32x4 r[8]; int q = it;
            if (q < I0) { tr_load(P.in[I_MLWIN], 6160, 192, q, F.lane, r); tr_store_fp8(ws + WS_WIN0, D, 192, q, F.lane, r, W8_SCALE); continue; } q -= I0;
            if (q < I1) { tr_load(P.in[I_MLWOUT], D, 64, q, F.lane, r); tr_store_fp8(ws + WS_WOUT0, D, 64, q, F.lane, r, W8_SCALE); continue; } q -= I1;
            if (q < I1) { tr_load(P.in[I_PWQ], D, 64, q, F.lane, r); tr_store_bf16((bf16*)(ws + WS_WQ0), D, 64, q, F.lane, r); continue; } q -= I1;
            if (q < I2) { tr_load(P.in[I_CMWIN], 4096, 128, q, F.lane, r); tr_store_fp8(ws + WS_WIN1, D, 128, q, F.lane, r, W8_SCALE); continue; } q -= I2;
            if (q < I1) { tr_load(P.in[I_CMWOUT], D, 64, q, F.lane, r); tr_store_fp8(ws + WS_WOUT1, D, 64, q, F.lane, r, W8_SCALE); continue; } q -= I1;
            tr_load(P.in[I_PWQ] + (size_t)D * D, D, 64, q, F.lane, r); tr_store_fp8(ws + WS_WQ1, D, 64, q, F.lane, r, W8_SCALE);
        }
    }
}

template <bool GATES, bool QUANT = false, bool SRC_BF16 = false, bool OUT_FP8 = false>
__device__ __forceinline__ void adaln_phase(const Frame& F, const void* srcAv, const float* srcB, int nctx, const float* gvec, const float* modv, int shoff, int scoff, bf16* dst,
                                            const float* wg, const float* gate_b, float* gates) {
    LAS float* wgl = (LAS float*)F.lds;
    if (GATES) { for (int i = F.tid; i < 16 * D / 4; i += NTHR) ((LAS f32x4*)wgl)[i] = ((const f32x4*)wg)[i]; __syncthreads(); }
    const int gw = F.bid * NWAVES + F.wave, NGW = F.G * NWAVES, lane = F.lane;
    const float* srcA = (const float*)srcAv; const bf16* srcAb = (const bf16*)srcAv;
    f32x4 nf[8]; v2u nb[8];
    if (gw < M + nctx) {
        const float* xr0 = gw < M ? srcA + (size_t)gw * D : srcB + (size_t)(gw - M) * D;
#pragma unroll
        for (int j = 0; j < 8; ++j) { if (SRC_BF16) nb[j] = ((const v2u*)(srcAb + (size_t)gw * D))[lane + 64 * j]; else nf[j] = ((const f32x4*)xr0)[lane + 64 * j]; } }
    for (int row = gw; row < M + nctx; row += NGW) {
        const float* mv = modv + (size_t)(row < M ? (row >> 13) : 2) * NMOD;
        f32x4 v[8]; float s = 0.f;
#pragma unroll
        for (int j = 0; j < 8; ++j) { if (SRC_BF16) v[j] = (f32x4){bflo(nb[j].x), bfhi(nb[j].x), bflo(nb[j].y), bfhi(nb[j].y)}; else v[j] = nf[j];
            s += (v[j][0] * v[j][0] + v[j][1] * v[j][1]) + (v[j][2] * v[j][2] + v[j][3] * v[j][3]); }
        { const int rn = (row + NGW < M + nctx) ? row + NGW : row;
          const float* xrn = rn < M ? srcA + (size_t)rn * D : srcB + (size_t)(rn - M) * D;
#pragma unroll
          for (int j = 0; j < 8; ++j) { if (SRC_BF16) nb[j] = ((const v2u*)(srcAb + (size_t)rn * D))[lane + 64 * j]; else nf[j] = ((const f32x4*)xrn)[lane + 64 * j]; } }
        const float rstd = 1.0f / sqrtf(wsum(s) * (1.0f / D) + EPS);
        v2u* o8 = (v2u*)(dst + (size_t)row * D);
#pragma unroll
        for (int j = 0; j < 8; ++j) { const int c4 = lane + 64 * j;
            const f32x4 g4 = ((const f32x4*)gvec)[c4], sc = ((const f32x4*)(mv + scoff))[c4], sh = ((const f32x4*)(mv + shoff))[c4];
            v[j] = v[j] * rstd * g4 * (sc + 1.0f) + sh;
            if (OUT_FP8) ((unsigned*)((unsigned char*)dst + (size_t)row * D))[c4] = pk4_fp8(v[j][0], v[j][1], v[j][2], v[j][3]);
            else { v2u w; w.x = pk2(v[j][0], v[j][1]); w.y = pk2(v[j][2], v[j][3]); o8[c4] = w; } }
        if (QUANT) {
            float mx = 0.f;
#pragma unroll
            for (int j = 0; j < 8; ++j) mx = fmaxf(mx, fmaxf(fmaxf(fabsf(v[j][0]), fabsf(v[j][1])), fmaxf(fabsf(v[j][2]), fabsf(v[j][3]))));
            mx = wmaxf_all(mx);
            const float sc = mx > 0.f ? mx * (1.0f / 119.0f) : 1.0f, inv = 1.0f / sc;
            unsigned short* xh = (unsigned short*)(F.ws + WS_XQ + (size_t)row * D); unsigned short* xl = xh + 512; int xs = 0;
#pragma unroll
            for (int j = 0; j < 8; ++j) { unsigned wh = 0u, wl = 0u;
#pragma unroll
                for (int i = 0; i < 4; ++i) { int q = (int)rintf(v[j][i] * inv); q = min(119, max(-119, q)); xs += q; const int ql = ((q + 8) & 15) - 8, qh = (q - ql) >> 4; wl |= (unsigned)(ql & 15) << (4 * i); wh |= (unsigned)(qh & 15) << (4 * i); }
                xh[lane + 64 * j] = (unsigned short)wh; xl[lane + 64 * j] = (unsigned short)wl; }
            xs = row16_sum_i32(xs); xs = (__builtin_amdgcn_readlane(xs, 0) + __builtin_amdgcn_readlane(xs, 16)) + (__builtin_amdgcn_readlane(xs, 32) + __builtin_amdgcn_readlane(xs, 48));
            if (lane == 0) { ((float*)(F.ws + WS_SX))[2 * row] = sc; ((float*)(F.ws + WS_SX))[2 * row + 1] = (float)xs; }
        }
        if (GATES) {
            float a[16];
#pragma unroll
            for (int q = 0; q < 16; ++q) { float t = 0.f;
#pragma unroll
                for (int j = 0; j < 8; ++j) { const f32x4 w4 = ((const LAS f32x4*)(wgl + q * D))[lane + 64 * j]; t += (v[j][0] * w4[0] + v[j][1] * w4[1]) + (v[j][2] * w4[2] + v[j][3] * w4[3]); }
                a[q] = t; __builtin_amdgcn_sched_barrier(0); }
            const bool h5 = (lane & 32) != 0, h4 = (lane & 16) != 0, h3 = (lane & 8) != 0, h2 = (lane & 4) != 0;
            float b8[8], b4[4], b2[2], b1;
#pragma unroll
            for (int i = 0; i < 8; ++i) { const float keep = h5 ? a[8 + i] : a[i], give = h5 ? a[i] : a[8 + i]; b8[i] = keep + __shfl_xor(give, 32); }
#pragma unroll
            for (int i = 0; i < 4; ++i) { const float keep = h4 ? b8[4 + i] : b8[i], give = h4 ? b8[i] : b8[4 + i]; b4[i] = keep + __shfl_xor(give, 16); }
#pragma unroll
            for (int i = 0; i < 2; ++i) { const float keep = h3 ? b4[2 + i] : b4[i], give = h3 ? b4[i] : b4[2 + i]; b2[i] = keep + __shfl_xor(give, 8); }
            { const float keep = h2 ? b2[1] : b2[0], give = h2 ? b2[0] : b2[1]; b1 = keep + __shfl_xor(give, 4); }
            b1 += __shfl_xor(b1, 2); b1 += __shfl_xor(b1, 1);
            if ((lane & 3) == 0) { const int q = (h5 ? 8 : 0) + (h4 ? 4 : 0) + (h3 ? 2 : 0) + (h2 ? 1 : 0);
                float gq = b1 + gate_b[q]; if ((q >> 2) & 1) gq = log_sigmoid(gq); gates[(size_t)row * 16 + q] = gq; }
        }
    }
}

__device__ __forceinline__ void p1_adaln_gates(const Frame& F, const float* srcA, const float* srcB, int nctx, const float* gvec, const float* modv, int shoff, int scoff, unsigned char* dst,
                                               const float* wg, const float* gate_b, float* gates) {
    constexpr int LDW = 2056;
    LAS bf16* wgb = (LAS bf16*)F.lds;
    LAS bf16* tile = (LAS bf16*)(F.lds + 16 * LDW * 2);
    LAS float* part = (LAS float*)(F.lds + 2 * 16 * LDW * 2);
    const int lane = F.lane, w = F.wave, fr = lane & 15, fq = lane >> 4, tid = F.tid;
    for (int i = tid; i < 16 * D / 4; i += NTHR) { const f32x4 x = ((const f32x4*)wg)[i]; const int q = (4 * i) / D, k = (4 * i) % D;
        v2u o; o.x = pk2(x[0], x[1]); o.y = pk2(x[2], x[3]); *(LAS v2u*)(wgb + q * LDW + k) = o; }
    __syncthreads();
    const int NR = M + nctx, NG = (NR + 15) / 16;
    for (int gi = F.bid; gi < NG; gi += F.G) {
        const int r0 = gi * 16;
#pragma unroll
        for (int rr = 0; rr < 2; ++rr) {
            const int rl = 2 * w + rr, row = r0 + rl;
            if (row < NR) {
                const float* xr = row < M ? srcA + (size_t)row * D : srcB + (size_t)(row - M) * D;
                const float* mv = modv + (size_t)(row < M ? (row >> 13) : 2) * NMOD;
                f32x4 v[8]; float s = 0.f;
#pragma unroll
                for (int j = 0; j < 8; ++j) { v[j] = __builtin_nontemporal_load((const f32x4*)xr + lane + 64 * j); s += (v[j][0] * v[j][0] + v[j][1] * v[j][1]) + (v[j][2] * v[j][2] + v[j][3] * v[j][3]); }
                const float rstd = 1.0f / sqrtf(wsum(s) * (1.0f / D) + EPS);
#pragma unroll
                for (int j = 0; j < 8; ++j) { const int c4 = lane + 64 * j;
                    const f32x4 g4 = ((const f32x4*)gvec)[c4], sc = ((const f32x4*)(mv + scoff))[c4], sh = ((const f32x4*)(mv + shoff))[c4];
                    v[j] = v[j] * rstd * g4 * (sc + 1.0f) + sh;
                    ((unsigned*)(dst + (size_t)row * D))[c4] = pk4_fp8(v[j][0], v[j][1], v[j][2], v[j][3]);
                    v2u o; o.x = pk2(v[j][0], v[j][1]); o.y = pk2(v[j][2], v[j][3]); *(LAS v2u*)(tile + rl * LDW + 4 * c4) = o; }
            } else {
#pragma unroll
                for (int j = 0; j < 8; ++j) *(LAS v2u*)(tile + rl * LDW + 4 * (lane + 64 * j)) = (v2u){0u, 0u};
            }
        }
        __syncthreads();
        { f32x4 acc = (f32x4){0.f, 0.f, 0.f, 0.f};
#pragma unroll
          for (int ks = 0; ks < 8; ++ks) { const int k0 = 256 * w + 32 * ks + 8 * fq;
              const bf16x8 af = *(const LAS bf16x8*)(wgb + fr * LDW + k0), bfr = *(const LAS bf16x8*)(tile + fr * LDW + k0);
              acc = __builtin_amdgcn_mfma_f32_16x16x32_bf16(af, bfr, acc, 0, 0, 0); }
#pragma unroll
          for (int r = 0; r < 4; ++r) part[w * 256 + (4 * fq + r) * 16 + fr] = acc[r]; }
        __syncthreads();
        if (tid < 256) { const int q = tid >> 4, cI = tid & 15, row = r0 + cI; float s = 0.f;
#pragma unroll
            for (int ww = 0; ww < 8; ++ww) s += part[ww * 256 + tid];
            if (row < NR) { float gq = s + gate_b[q]; if ((q >> 2) & 1) gq = log_sigmoid(gq); gates[(size_t)row * 16 + q] = gq; } }
    }
}

__device__ __forceinline__ void wscan_add2(float& a, float& b, int lane) {
    float t = a + b;
#pragma unroll
    for (int o = 1; o < 64; o <<= 1) { const float u = __shfl_up(t, o); if (lane >= o) t += u; }
    const float excl = t - (a + b); a = excl + a; b = a + b;
}
__device__ __forceinline__ void wscan_max2(float& a, float& b, int lane) {
    float t = fmaxf(a, b);
#pragma unroll
    for (int o = 1; o < 64; o <<= 1) { const float u = __shfl_up(t, o); if (lane >= o) t = fmaxf(t, u); }
    float excl = __shfl_up(t, 1); if (lane == 0) excl = -INFINITY;
    a = fmaxf(excl, a); b = fmaxf(a, b);
}
__device__ __forceinline__ float wmaxall(float v) {
#pragma unroll
    for (int o = 1; o < 64; o <<= 1) v = fmaxf(v, __shfl_xor(v, o));
    return v;
}

__device__ __forceinline__ void p3_conv(const Frame& F, const Params& P) {
    unsigned char* ws = F.ws;
    const bf16* QKRAW = (const bf16*)(ws + WS_QKRAW); const bf16* VV = (const bf16*)(ws + WS_V);
    bf16* QC = (bf16*)(ws + WS_QC); bf16* KC = (bf16*)(ws + WS_KC); bf16* VTR = (bf16*)(ws + WS_VTR);
    const float* GATES = (const float*)(ws + WS_GATES);
    const float* cw = P.in[I_MLCW]; const float* cbias = P.in[I_MLCB];
    LAS float* wl = (LAS float*)F.lds;
    LAS bf16* tile = (LAS bf16*)(F.lds + 4096);
    constexpr int U_GS = 16, U_LC = 4096, U_LV = 0, U_CC = 64, U_CV = 0, U_ALL = U_GS + U_LC + U_LV + U_CC + U_CV;
    for (int uu = F.bid; uu < U_GS + U_CC; uu += F.G) {
        const int u = uu < U_GS ? uu : uu + U_LC + U_LV;
        int r = u;
        if (r < U_GS) {
            const int dir = r >> 3, b = (r >> 2) & 1, h = r & 3;
            LAS float* beta = (LAS float*)(F.lds + 8192);
            LAS float* bend = (LAS float*)(F.lds + 8192 + 66 * 512);
            LAS float* wmx = bend + 66; LAS float* mnw = wmx + 66;
            float* BCUM = (float*)(ws + WS_BCUM) + (size_t)r * SEQ; float* WST = (float*)(ws + WS_WST) + (size_t)r * (NCHT * CHK);
            float* MPREV = (float*)(ws + WS_MPREV) + r * NCHT; float* ASTATE = (float*)(ws + WS_ASTATE) + r * NCHT;
            for (int k = F.wave; k < NCHT; k += NWAVES) {
                const int row0 = k < 2 ? M + b * CTXL + k * CHK : b * SEQ + (k - 2) * CHK;
                const int j0 = 2 * F.lane, j1 = j0 + 1, s0 = dir ? 127 - j0 : j0, s1 = dir ? 127 - j1 : j1;
                const float f0 = GATES[(size_t)(row0 + s0) * 16 + (2 * dir + 1) * 4 + h], f1 = GATES[(size_t)(row0 + s1) * 16 + (2 * dir + 1) * 4 + h];
                const float i0 = GATES[(size_t)(row0 + s0) * 16 + (2 * dir) * 4 + h], i1 = GATES[(size_t)(row0 + s1) * 16 + (2 * dir) * 4 + h];
                float b0 = f0, b1 = f1; wscan_add2(b0, b1, F.lane);
                const float be = __shfl(b1, 63);
                const float t0 = i0 - b0, t1 = i1 - b1;
                beta[k * 128 + s0] = t0; beta[k * 128 + s1] = t1;
                const float wm = wmaxall(fmaxf(t0, t1)) + be;
                if (F.lane == 0) { bend[k] = be; wmx[k] = wm; }
                if (k >= 2) { BCUM[(k - 2) * CHK + s0] = b0; BCUM[(k - 2) * CHK + s1] = b1; }
            }
            __syncthreads();
            if (F.tid == 0) { float m = 0.f;
                for (int idx = 0; idx < NCHT; ++idx) { const int k = dir ? (idx < 2 ? 1 - idx : 67 - idx) : idx;
                    const float mn = fmaxf(bend[k] + m, wmx[k]); MPREV[k] = m; ASTATE[k] = expf(bend[k] + m - mn); mnw[k] = mn; m = mn; } }
            __syncthreads();
            for (int i = F.tid; i < NCHT * CHK; i += NTHR) { const int k = i >> 7; WST[i] = expf(bend[k] + beta[i] - mnw[k]); }
            __syncthreads();
            continue;
        }
        r -= U_GS;
        if (r < U_LC || (r >= U_LC + U_LV && r < U_LC + U_LV + U_CC)) {
            const bool isctx = r >= U_LC; if (isctx) r -= U_LC + U_LV;
            int b, c, cb;
            if (!isctx) { cb = r & 31; c = (r >> 5) & 63; b = r >> 11; } else { cb = 16 + (r & 15); c = (r >> 4) & 1; b = r >> 5; }
            const int chb = cb * 64;
            for (int i = F.tid; i < 9 * 64 + 64; i += NTHR) wl[i] = i < 576 ? cw[(i >> 6) * D + chb + (i & 63)] : cbias[chb + (i - 576)];
            __syncthreads();
#pragma unroll 1
            for (int it = 0; it < 2; ++it) {
                const int item = F.tid + NTHR * it, tl = item >> 3, cg = item & 7, ch0 = chb + cg * 8;
                float a[8];
#pragma unroll
                for (int q = 0; q < 8; ++q) a[q] = wl[576 + cg * 8 + q];
                if (!isctx) {
                    const int t = c * CHK + tl, gr = t >> 6, gc = t & 63;
#pragma unroll
                    for (int di = 0; di < 3; ++di)
#pragma unroll
                        for (int dj = 0; dj < 3; ++dj) { const int rr = gr + di - 1, c2 = gc + dj - 1;
                            if (rr >= 0 && rr < 128 && c2 >= 0 && c2 < 64) {
                                const v4u x = *(const v4u*)(QKRAW + ((size_t)b * SEQ + rr * 64 + c2) * D + ch0);
                                const LAS float* w = wl + (di * 3 + dj) * 64 + cg * 8;
                                a[0] += bflo(x.x) * w[0]; a[1] += bfhi(x.x) * w[1]; a[2] += bflo(x.y) * w[2]; a[3] += bfhi(x.y) * w[3];
                                a[4] += bflo(x.z) * w[4]; a[5] += bfhi(x.z) * w[5]; a[6] += bflo(x.w) * w[6]; a[7] += bfhi(x.w) * w[7]; } }
                } else {
                    const int s = c * CHK + tl;
#pragma unroll
                    for (int dj = 0; dj < 3; ++dj) { const int s2 = s + dj - 1;
                        if (s2 >= 0 && s2 < CTXL) {
                            const v4u x = *(const v4u*)(QKRAW + ((size_t)M + b * CTXL + s2) * D + ch0);
                            const LAS float* w = wl + (3 + dj) * 64 + cg * 8;
                            a[0] += bflo(x.x) * w[0]; a[1] += bfhi(x.x) * w[1]; a[2] += bflo(x.y) * w[2]; a[3] += bfhi(x.y) * w[3];
                            a[4] += bflo(x.z) * w[4]; a[5] += bfhi(x.z) * w[5]; a[6] += bflo(x.w) * w[6]; a[7] += bfhi(x.w) * w[7]; } }
                }
                const float sc = ch0 >= 1024 ? 0.0625f : 1.0f;
#pragma unroll
                for (int q = 0; q < 8; ++q) a[q] = siluf_(a[q]) * sc;
                v4u o; o.x = pk2(a[0], a[1]); o.y = pk2(a[2], a[3]); o.z = pk2(a[4], a[5]); o.w = pk2(a[6], a[7]);
                const size_t row = isctx ? (size_t)M + b * CTXL + c * CHK + tl : (size_t)b * SEQ + c * CHK + tl;
                if (ch0 < 1024) { *(v4u*)(QC + row * 1024 + ch0) = o; v2u o8; o8.x = pk4_fp8(a[0], a[1], a[2], a[3]); o8.y = pk4_fp8(a[4], a[5], a[6], a[7]); *(v2u*)(ws + WS_QC8 + row * 1024 + ch0) = o8; }
                else *(v4u*)(KC + row * 1024 + (ch0 - 1024)) = o;
            }
            __syncthreads();
            continue;
        }
        {
            int b, k, cb;
            if (r < U_LC + U_LV) { r -= U_LC; cb = r & 31; k = 2 + ((r >> 5) & 63); b = r >> 11; } else { r -= U_LC + U_LV + U_CC; cb = r & 31; k = (r >> 5) & 1; b = r >> 6; }
            const size_t row0 = k < 2 ? (size_t)M + b * CTXL + k * CHK : (size_t)b * SEQ + (k - 2) * CHK;
#pragma unroll
            for (int it = 0; it < 2; ++it) { const int item = F.tid + NTHR * it, s = item >> 3, cg = item & 7;
                const v4u x = *(const v4u*)(VV + (row0 + s) * D + cb * 64 + cg * 8);
                LAS unsigned* tp = (LAS unsigned*)(tile + s * 66 + cg * 8); tp[0] = x.x; tp[1] = x.y; tp[2] = x.z; tp[3] = x.w; }
            __syncthreads();
#pragma unroll
            for (int it = 0; it < 2; ++it) { const int item = F.tid + NTHR * it, sg = item & 15, e = item >> 4;
                unsigned short q[8];
#pragma unroll
                for (int i = 0; i < 8; ++i) q[i] = tile[(sg * 8 + i) * 66 + e];
                v4u o; o.x = q[0] | ((unsigned)q[1] << 16); o.y = q[2] | ((unsigned)q[3] << 16); o.z = q[4] | ((unsigned)q[5] << 16); o.w = q[6] | ((unsigned)q[7] << 16);
                *(v4u*)(VTR + (((size_t)b * NCHT + k) * D + cb * 64 + e) * CHK + sg * 8) = o; }
            __syncthreads();
        }
    }
    {
        LAS unsigned char* tl2 = F.lds + 4096;
        const bool skip16 = F.G > 32; const int nb = skip16 ? F.G - 16 : F.G, b0 = skip16 ? F.bid - 16 : F.bid;
        if (b0 >= 0) {
            v4u pre[4]; float wreg[2];
#define P3_FETCH(R) do { const int r_ = (R), b_ = r_ >> 11, c_ = (r_ >> 5) & 63, chb_ = (r_ & 31) * 64; \
                _Pragma("unroll") for (int it = 0; it < 4; ++it) { const int item = F.tid + NTHR * it, tok = item >> 3, cg = item & 7, grow = 2 * c_ - 1 + (tok >> 6); \
                    pre[it] = (v4u){0u, 0u, 0u, 0u}; if (grow >= 0 && grow < 128) pre[it] = *(const v4u*)(QKRAW + ((size_t)b_ * SEQ + grow * 64 + (tok & 63)) * D + chb_ + cg * 8); } \
                wreg[0] = cw[(F.tid >> 6) * D + chb_ + (F.tid & 63)]; \
                wreg[1] = 0.f; if (F.tid < 128) { const int i = 512 + F.tid; wreg[1] = i < 576 ? cw[(i >> 6) * D + chb_ + (i & 63)] : cbias[chb_ + (i - 576)]; } } while (0)
            int r = b0;
            if (r < U_LC) P3_FETCH(r);
#pragma unroll 1
            for (; r < U_LC; r += nb) {
                const int b = r >> 11, c = (r >> 5) & 63, chb = (r & 31) * 64;
#pragma unroll
                for (int it = 0; it < 4; ++it) { const int item = F.tid + NTHR * it; *(LAS v4u*)(tl2 + (item >> 3) * 144 + (item & 7) * 16) = pre[it]; }
                wl[F.tid] = wreg[0]; if (F.tid < 128) wl[512 + F.tid] = wreg[1];
                __syncthreads();
                if (r + nb < U_LC) P3_FETCH(r + nb);
#pragma unroll 1
                for (int it = 0; it < 2; ++it) {
                    const int item = F.tid + NTHR * it, tl = item >> 3, cg = item & 7, ch0 = chb + cg * 8, gc = tl & 63;
                    float a[8];
#pragma unroll
                    for (int q = 0; q < 8; ++q) a[q] = wl[576 + cg * 8 + q];
#pragma unroll
                    for (int di = 0; di < 3; ++di)
#pragma unroll
                        for (int dj = 0; dj < 3; ++dj) { const int c2 = gc + dj - 1;
                            if (c2 >= 0 && c2 < 64) {
                                const v4u x = *(const LAS v4u*)(tl2 + (64 + tl + (di - 1) * 64 + dj - 1) * 144 + cg * 16);
                                const LAS float* w = wl + (di * 3 + dj) * 64 + cg * 8;
                                a[0] += bflo(x.x) * w[0]; a[1] += bfhi(x.x) * w[1]; a[2] += bflo(x.y) * w[2]; a[3] += bfhi(x.y) * w[3];
                                a[4] += bflo(x.z) * w[4]; a[5] += bfhi(x.z) * w[5]; a[6] += bflo(x.w) * w[6]; a[7] += bfhi(x.w) * w[7]; } }
                    const float sc = ch0 >= 1024 ? 0.0625f : 1.0f;
#pragma unroll
                    for (int q = 0; q < 8; ++q) a[q] = siluf_(a[q]) * sc;
                    v4u o; o.x = pk2(a[0], a[1]); o.y = pk2(a[2], a[3]); o.z = pk2(a[4], a[5]); o.w = pk2(a[6], a[7]);
                    const size_t row = (size_t)b * SEQ + c * CHK + tl;
                    if (ch0 < 1024) { *(v4u*)(QC + row * 1024 + ch0) = o; v2u o8; o8.x = pk4_fp8(a[0], a[1], a[2], a[3]); o8.y = pk4_fp8(a[4], a[5], a[6], a[7]); *(v2u*)(ws + WS_QC8 + row * 1024 + ch0) = o8; }
                    else *(v4u*)(KC + row * 1024 + (ch0 - 1024)) = o;
                }
                __syncthreads();
            }
#undef P3_FETCH
        }
    }
}

__device__ __forceinline__ f32x4 mfma16(bf16x8 a, bf16x8 b, f32x4 c) { return __builtin_amdgcn_mfma_f32_16x16x32_bf16(a, b, c, 0, 0, 0); }

__device__ __forceinline__ void p4_intra(const Frame& F) {
    unsigned char* ws = F.ws;
    const bf16* QC = (const bf16*)(ws + WS_QC); const bf16* KC = (const bf16*)(ws + WS_KC);
    const float* GATES = (const float*)(ws + WS_GATES);
    bf16* PM = (bf16*)(ws + WS_PM);
    float* AINT = (float*)(ws + WS_AINT); float* EXPNM = (float*)(ws + WS_EXPNM);
    LAS bf16* Qs = (LAS bf16*)F.lds;
    LAS bf16* Ks = (LAS bf16*)(F.lds + 67584);
    LAS float* vec = (LAS float*)(F.lds + 135168);
    const int lane = F.lane, w = F.wave, fr = lane & 15, fq = lane >> 4;
    v4u pk_[8], pq_[8]; float pv_[3];
#define P4_DECODE(U, dir, b, h, k, lat) const bool lat = (U) < 1024; int dir, b, h, k; \
        if (lat) { dir = (U) & 1; k = 2 + (((U) >> 1) & 63); h = ((U) >> 7) & 3; b = (U) >> 9; } else { const int r_ = (U) - 1024; dir = r_ & 1; k = (r_ >> 1) & 1; h = (r_ >> 2) & 3; b = r_ >> 4; }
#define P4_FETCH(U) do { P4_DECODE(U, dir_, b_, h_, k_, lat_) const int seq_ = dir_ * 8 + b_ * 4 + h_; \
        const size_t row0_ = k_ < 2 ? (size_t)M + b_ * CTXL + k_ * CHK : (size_t)b_ * SEQ + (k_ - 2) * CHK; \
        _Pragma("unroll") for (int it = 0; it < 8; ++it) { const int item = F.tid + NTHR * it, row = item >> 5, ch = item & 31; \
            pk_[it] = *(const v4u*)(KC + (row0_ + row) * 1024 + h_ * 256 + ch * 8); \
            if (lat_) pq_[it] = *(const v4u*)(QC + (row0_ + row) * 1024 + h_ * 256 + ch * 8); } \
        if (F.tid < 128) { const int s = F.tid; \
            pv_[2] = ((const float*)(ws + WS_WST))[(size_t)seq_ * (NCHT * CHK) + k_ * CHK + s]; \
            if (lat_) { pv_[0] = ((const float*)(ws + WS_BCUM))[(size_t)seq_ * SEQ + (k_ - 2) * CHK + s]; pv_[1] = GATES[(row0_ + s) * 16 + 2 * dir_ * 4 + h_]; } } } while (0)
    if (F.bid < 1024 + 32) P4_FETCH(F.bid);
    for (int u = F.bid; u < 1024 + 32; u += F.G) {
        P4_DECODE(u, dir, b, h, k, lat)
        const int seq = dir * 8 + b * 4 + h;
#pragma unroll
        for (int it = 0; it < 8; ++it) { const int item = F.tid + NTHR * it, row = item >> 5, ch = item & 31;
            *(LAS v4u*)(Ks + row * 264 + ch * 8) = pk_[it];
            if (lat) *(LAS v4u*)(Qs + row * 264 + ch * 8) = pq_[it]; }
        if (F.tid < 128) { const int s = F.tid;
            vec[256 + s] = pv_[2];
            if (lat) { vec[s] = pv_[0]; vec[128 + s] = pv_[1] - pv_[0]; } }
        __syncthreads();
        if (u + F.G < 1024 + 32) P4_FETCH(u + F.G);
        if (lat) {
            if (w == 0) {
                const int j0 = 2 * lane, j1 = j0 + 1, s0 = dir ? 127 - j0 : j0, s1 = dir ? 127 - j1 : j1;
                float p0 = vec[128 + s0], p1 = vec[128 + s1]; wscan_max2(p0, p1, lane);
                const float mprev = ((const float*)(ws + WS_MPREV))[seq * NCHT + k];
                const float m0 = fmaxf(mprev, p0), m1 = fmaxf(mprev, p1);
                vec[384 + s0] = -m0; vec[384 + s1] = -m1;
                AINT[(size_t)u * CHK + s0] = expf(mprev - m0); AINT[(size_t)u * CHK + s1] = expf(mprev - m1);
                EXPNM[(size_t)u * CHK + s0] = expf(-(vec[s0] + m0)); EXPNM[(size_t)u * CHK + s1] = expf(-(vec[s1] + m1));
            }
            f32x4 acc[8];
#pragma unroll
            for (int st = 0; st < 8; ++st) acc[st] = (f32x4){0.f, 0.f, 0.f, 0.f};
#pragma unroll
#define P4_LIVE(ST) (dir ? ((ST) >= w) : ((ST) <= w))
            for (int ks = 0; ks < 8; ++ks) {
                const bf16x8 qf = *(const LAS bf16x8*)(Qs + (16 * w + fr) * 264 + ks * 32 + 8 * fq);
#pragma unroll
                for (int st = 0; st < 8; ++st) if (P4_LIVE(st)) { const bf16x8 kf = *(const LAS bf16x8*)(Ks + (16 * st + fr) * 264 + ks * 32 + 8 * fq); acc[st] = mfma16(kf, qf, acc[st]); }
            }
            __syncthreads();
            const int t = 16 * w + fr; const float al = vec[384 + t];
#pragma unroll
            for (int st = 0; st < 8; ++st) { const int sb = 16 * st + 4 * fq;
                if (P4_LIVE(st)) { float p[4];
#pragma unroll
                    for (int r = 0; r < 4; ++r) { const int s = sb + r; const bool ok = dir ? (s >= t) : (s <= t);
                        p[r] = ok ? expf(fminf(al + vec[128 + s], 0.f)) * acc[st][r] : 0.f; }
                    v2u o; o.x = pk2c(p[0], p[1]); o.y = pk2c(p[2], p[3]);
                    *(v2u*)(PM + ((size_t)u * CHK + t) * CHK + sb) = o; }
                else if ((st >> 1) == (w >> 1)) *(v2u*)(PM + ((size_t)u * CHK + t) * CHK + sb) = (v2u){0u, 0u};
            }
#undef P4_LIVE
        }
        {
            unsigned char* dstc = ws + WS_WKT + ((size_t)seq * NCHT + k) * (256 * 128);
#pragma unroll
            for (int it = 0; it < 4; ++it) { const int item = F.tid + NTHR * it, d = item >> 3, sg = item & 7; float q[16];
#pragma unroll
                for (int i = 0; i < 16; ++i) { const int s = sg * 16 + i; q[i] = bf2f(Ks[s * 264 + d]) * vec[256 + s] * 64.0f; }
                v4u o; o.x = pk4_fp8(q[0], q[1], q[2], q[3]); o.y = pk4_fp8(q[4], q[5], q[6], q[7]); o.z = pk4_fp8(q[8], q[9], q[10], q[11]); o.w = pk4_fp8(q[12], q[13], q[14], q[15]);
                *(v4u*)(dstc + (size_t)item * 16) = o; }
        }
        __syncthreads();
    }
}

#undef P4_FETCH
#undef P4_DECODE
__device__ __forceinline__ void p5_scan(const Frame& F) {
    unsigned char* ws = F.ws;
    const bf16* PM = (const bf16*)(ws + WS_PM); const unsigned char* WKT = ws + WS_WKT; const bf16* VTR = (const bf16*)(ws + WS_VTR);
    const float* AINT = (const float*)(ws + WS_AINT); const float* EXPNM = (const float*)(ws + WS_EXPNM); const float* ASTATE = (const float*)(ws + WS_ASTATE);
    LAS bf16* VTs = (LAS bf16*)F.lds;
    LAS unsigned char* V8 = F.lds + 17408;
    LAS unsigned char* C8 = F.lds + 26624;
    const int lane = F.lane, w = F.wave, fr = lane & 15, fq = lane >> 4, tid = F.tid;
    const int vb = (F.G == 256) ? ((F.bid & 7) * 32 + (F.bid >> 3)) : F.bid;
    typedef int i32x4 __attribute__((ext_vector_type(4))); typedef int i32x8 __attribute__((ext_vector_type(8)));
    bf16x8 ones; { const short o1 = (short)0x3F80;
#pragma unroll
        for (int i = 0; i < 8; ++i) ones[i] = o1; }
    i32x8 ones8; { const int o1 = 0x38383838;
#pragma unroll
        for (int i = 0; i < 8; ++i) ones8[i] = o1; }
#define MFMA8(A, B, C) __builtin_amdgcn_mfma_scale_f32_16x16x128_f8f6f4((A), (B), (C), 0, 0, 0, 0, 0, 0)
#define LD8(PTR) __builtin_shufflevector(*(const LAS i32x4*)(PTR), *(const LAS i32x4*)((PTR) + 64), 0, 1, 2, 3, 4, 5, 6, 7)
#define CAT8(X, Y) __builtin_shufflevector(__builtin_bit_cast(i32x4, (X)), __builtin_bit_cast(i32x4, (Y)), 0, 1, 2, 3, 4, 5, 6, 7)
    for (int unit = vb; unit < 256; unit += F.G) {
        const int seq = unit >> 4, j = unit & 15, dir = seq >> 3, b = (seq >> 2) & 1, h = seq & 3;
        bf16* HOUT = (bf16*)(ws + (dir ? WS_V : WS_QKRAW));
        f32x4 CT[2][3];
#pragma unroll
        for (int a = 0; a < 2; ++a)
#pragma unroll
            for (int e = 0; e < 3; ++e) CT[a][e] = (f32x4){0.f, 0.f, 0.f, 0.f};
        for (int i = tid; i < 2 * 48 * 272 / 4; i += NTHR) ((LAS unsigned*)C8)[i] = 0u;
        v4u qa[4], pa[4], wa[4], va, qb[4], pb[4], wb[4], vb_; float ga[3], gb[3];
        const unsigned voV = (unsigned)(((tid >> 4) * CHK + (tid & 15) * 8) * 2);
        const unsigned voQ = (unsigned)((16 * w + fr) * 1024 + 16 * fq), voP = (unsigned)(((16 * w + fr) * CHK + 8 * fq) * 2), voW = (unsigned)((32 * w + fr) * 128 + 16 * fq);
#define P5_KOF(I) (dir ? ((I) < 2 ? 1 - (I) : 67 - (I)) : (I))
#define P5_NEED(IT) (dir ? ((IT) >= (w >> 1)) : ((IT) <= (w >> 1)))
#define P5_FETCH(KK, preQ, preV, preP, preW, preG) do { const int kq_ = (KK), kk_ = kq_ < 0 ? 2 : kq_; \
            preG[2] = ASTATE[seq * NCHT + kk_]; \
            const unsigned char* bV_ = (const unsigned char*)(VTR + (((size_t)b * NCHT + kk_) * D + h * 512 + j * 32) * CHK); \
            preV = *(const v4u*)(bV_ + voV); \
            const unsigned char* bW_ = WKT + ((size_t)seq * NCHT + kk_) * (256 * 128); \
            _Pragma("unroll") for (int it = 0; it < 4; ++it) preW[it] = *(const v4u*)(bW_ + (it >> 1) * 2048 + (it & 1) * 64 + voW);     \
            { const int c_ = kk_ >= 2 ? kk_ - 2 : 0; const int u4_ = dir | (c_ << 1) | (h << 7) | (b << 9); const size_t rown_ = (size_t)b * SEQ + c_ * CHK; \
                const unsigned char* bQ_ = ws + WS_QC8 + rown_ * 1024 + h * 256; const unsigned char* bP_ = (const unsigned char*)(PM + (size_t)u4_ * CHK * CHK); \
                preG[0] = AINT[(size_t)u4_ * CHK + 16 * w + fr]; preG[1] = EXPNM[(size_t)u4_ * CHK + 16 * w + fr]; \
                _Pragma("unroll") for (int it = 0; it < 4; ++it) preQ[it] = *(const v4u*)(bQ_ + it * 64 + voQ);        \
                _Pragma("unroll") for (int it = 0; it < 4; ++it) preP[it] = *(const v4u*)(bP_ + (P5_NEED(it) ? it : (w >> 1)) * 64 + voP); } } while (0)
        P5_FETCH(P5_KOF(0), qa, va, pa, wa, ga); asm volatile("" ::: "memory");
        int tpa = 0, tpb = 0, sink = 0;
        __syncthreads();
        auto step = [&](const int idx, v4u (&preQ)[4], v4u& preV, v4u (&preP)[4], v4u (&preW)[4], float (&preG)[3], v4u (&nxtQ)[4], v4u& nxtV, v4u (&nxtP)[4], v4u (&nxtW)[4], float (&nxtG)[3], int& tp) __attribute__((always_inline)) {
            const int k = P5_KOF(idx), par = idx & 1;
            const bool lat = k >= 2;
            const int kn = (idx + 1 < NCHT) ? P5_KOF(idx + 1) : -1;
            const float a_state = preG[2], aint = preG[0] * (1.0f / 64.0f), expnm = preG[1];
            LAS bf16* VTc = VTs + par * (32 * 136); LAS unsigned char* V8c = V8 + par * (32 * 144); LAS unsigned char* C8c = C8 + par * (48 * 272); LAS unsigned char* C8n = C8 + (par ^ 1) * (48 * 272);
            { *(LAS v4u*)(VTc + (tid >> 4) * 136 + (tid & 15) * 8) = preV;
              v2u v8; v8.x = pk4_fp8(bflo(preV.x), bfhi(preV.x), bflo(preV.y), bfhi(preV.y)); v8.y = pk4_fp8(bflo(preV.z), bfhi(preV.z), bflo(preV.w), bfhi(preV.w));
              *(LAS v2u*)(V8c + (tid >> 4) * 144 + (tid & 15) * 8) = v8; }
            __syncthreads();
            P5_FETCH(kn, nxtQ, nxtV, nxtP, nxtW, nxtG);
            { const int kt0 = (idx + 3 < NCHT) ? P5_KOF(idx + 3) : 2, ct_ = kt0 >= 2 ? kt0 - 2 : 0; const int u4t = dir | (ct_ << 1) | (h << 7) | (b << 9);
              const int L = w * 64 + lane; const unsigned char* ta;
              if (L < 96) { const int sl = (j * 48 + L) % 768, ln = sl & 255;
                  ta = sl < 256 ? ws + WS_QC8 + ((size_t)b * SEQ + ct_ * CHK + (ln >> 1)) * 1024 + h * 256 + (ln & 1) * 128
                     : sl < 512 ? (const unsigned char*)(PM + (size_t)u4t * CHK * CHK) + ln * 128 : WKT + ((size_t)seq * NCHT + kt0) * (256 * 128) + ln * 128; }
              else ta = (const unsigned char*)(VTR + (((size_t)b * NCHT + kt0) * D + h * 512 + j * 32) * CHK) + (L & 63) * 128;
              sink += tp; tp = *(const int*)ta; }
            if (lat) {
                const int c = k - 2; const int u4 = dir | (c << 1) | (h << 7) | (b << 9);
                const size_t row0 = (size_t)b * SEQ + c * CHK;
                const int t = 16 * w + fr;
                f32x4 H[3];
#pragma unroll
                for (int e = 0; e < 3; ++e) H[e] = (f32x4){0.f, 0.f, 0.f, 0.f};
#pragma unroll
                for (int ks = 0; ks < 2; ++ks) { const i32x8 qf = CAT8(preQ[2 * ks], preQ[2 * ks + 1]);
#pragma unroll
                    for (int et = 0; et < 3; ++et) { const i32x8 cf = LD8(C8c + (16 * et + fr) * 272 + 128 * ks + 16 * fq); H[et] = MFMA8(cf, qf, H[et]); } }
#pragma unroll
                for (int et = 0; et < 3; ++et) H[et] = H[et] * aint;
#pragma unroll
                for (int ks = 0; ks < 4; ++ks) if (P5_NEED(ks)) { const bf16x8 pf = __builtin_bit_cast(bf16x8, preP[ks]);
                    const bf16x8 v0 = *(const LAS bf16x8*)(VTc + fr * 136 + ks * 32 + 8 * fq), v1 = *(const LAS bf16x8*)(VTc + (16 + fr) * 136 + ks * 32 + 8 * fq);
                    H[0] = mfma16(v0, pf, H[0]); H[1] = mfma16(v1, pf, H[1]); H[2] = mfma16(ones, pf, H[2]); }
                {
                    const float den = H[2][0];
                    const float inv = 1.0f / fmaxf(fabsf(den), expnm);
                    bf16* orow = HOUT + (row0 + t) * D + h * 512 + j * 32 + 4 * fq;
#pragma unroll
                    for (int et = 0; et < 2; ++et) { v2u o; o.x = pk2c(H[et][0] * inv, H[et][1] * inv); o.y = pk2c(H[et][2] * inv, H[et][3] * inv); *(v2u*)(orow + 16 * et) = o; }
                }
            }
            { const i32x8 vf0 = LD8(V8c + fr * 144 + 16 * fq), vf1 = LD8(V8c + (16 + fr) * 144 + 16 * fq);
#pragma unroll
              for (int dt = 0; dt < 2; ++dt) { const i32x8 wf = CAT8(preW[2 * dt], preW[2 * dt + 1]);
#pragma unroll
                  for (int et = 0; et < 3; ++et) CT[dt][et] = CT[dt][et] * a_state;
                  CT[dt][0] = MFMA8(wf, vf0, CT[dt][0]); CT[dt][1] = MFMA8(wf, vf1, CT[dt][1]); CT[dt][2] = MFMA8(wf, ones8, CT[dt][2]); } }
#pragma unroll
            for (int dt = 0; dt < 2; ++dt)
#pragma unroll
                for (int et = 0; et < 3; ++et) *(LAS unsigned*)(C8n + (16 * et + fr) * 272 + 32 * w + 16 * dt + 4 * fq) = pk4_fp8(CT[dt][et][0], CT[dt][et][1], CT[dt][et][2], CT[dt][et][3]);
        };
#pragma unroll 1
        for (int idx = 0; idx < NCHT; idx += 2) {
            step(idx, qa, va, pa, wa, ga, qb, vb_, pb, wb, gb, tpa);
            step(idx + 1, qb, vb_, pb, wb, gb, qa, va, pa, wa, ga, tpb);
        }
        sink += tpa + tpb; asm volatile("" :: "v"(sink));
        __syncthreads();
    }
#undef P5_FETCH
#undef P5_KOF
#undef P5_NEED
#undef CAT8
#undef MFMA8
#undef LD8
}

__device__ __forceinline__ void p6_combine(const Frame& F, const float* head_g) {
    unsigned char* ws = F.ws;
    const bf16* HF = (const bf16*)(ws + WS_QKRAW); const bf16* HB = (const bf16*)(ws + WS_V); const bf16* OG = (const bf16*)(ws + WS_OG); bf16* HN = (bf16*)(ws + WS_HN);
    const int gw = F.bid * NWAVES + F.wave, NGW = F.G * NWAVES, lane = F.lane;
    v4u na[4], nbb[4], no[4];
    if (gw < M) {
#pragma unroll
        for (int hh = 0; hh < 4; ++hh) { const size_t off = (size_t)gw * D + hh * 512 + lane * 8; na[hh] = *(const v4u*)(HF + off); nbb[hh] = *(const v4u*)(HB + off); no[hh] = *(const v4u*)(OG + off); } }
    for (int row = gw; row < M; row += NGW) {
        v4u ca[4], cb[4], co[4];
#pragma unroll
        for (int hh = 0; hh < 4; ++hh) { ca[hh] = na[hh]; cb[hh] = nbb[hh]; co[hh] = no[hh]; }
        { const int rn = (row + NGW < M) ? row + NGW : row;
#pragma unroll
          for (int hh = 0; hh < 4; ++hh) { const size_t off = (size_t)rn * D + hh * 512 + lane * 8; na[hh] = *(const v4u*)(HF + off); nbb[hh] = *(const v4u*)(HB + off); no[hh] = *(const v4u*)(OG + off); } }
#pragma unroll
        for (int hh = 0; hh < 4; ++hh) { const size_t off = (size_t)row * D + hh * 512 + lane * 8;
            const v4u a = ca[hh], b = cb[hh], o = co[hh];
            float x[8] = { bflo(a.x) + bflo(b.x), bfhi(a.x) + bfhi(b.x), bflo(a.y) + bflo(b.y), bfhi(a.y) + bfhi(b.y), bflo(a.z) + bflo(b.z), bfhi(a.z) + bfhi(b.z), bflo(a.w) + bflo(b.w), bfhi(a.w) + bfhi(b.w) };
            float ss = 0.f;
#pragma unroll
            for (int i = 0; i < 8; ++i) ss += x[i] * x[i];
            const float rstd = 1.0f / sqrtf(wsum(ss) * (1.0f / 512.0f) + EPS);
            const f32x4 g0 = *(const f32x4*)(head_g + hh * 512 + lane * 8), g1 = *(const f32x4*)(head_g + hh * 512 + lane * 8 + 4);
            const float og[8] = { bflo(o.x), bfhi(o.x), bflo(o.y), bfhi(o.y), bflo(o.z), bfhi(o.z), bflo(o.w), bfhi(o.w) };
            float y[8];
#pragma unroll
            for (int i = 0; i < 8; ++i) { const float hn = x[i] * rstd * (i < 4 ? g0[i] : g1[i - 4]); y[i] = hn * og[i]; }
            v2u w; w.x = pk4_fp8(y[0], y[1], y[2], y[3]); w.y = pk4_fp8(y[4], y[5], y[6], y[7]);
            *(v2u*)((unsigned char*)HN + off) = w; }
    }
}

#define DPP_ROR(x, n) __builtin_amdgcn_update_dpp(0, (x), 0x120 + (n), 0xf, 0xf, false)
#define DPP_SHR0(x, n) __builtin_amdgcn_update_dpp(0, (x), 0x110 + (n), 0xf, 0xf, true)
__device__ __forceinline__ float row_min(float v) {
    v = fminf(v, __int_as_float(DPP_ROR(__float_as_int(v), 8))); v = fminf(v, __int_as_float(DPP_ROR(__float_as_int(v), 4)));
    v = fminf(v, __int_as_float(DPP_ROR(__float_as_int(v), 2))); v = fminf(v, __int_as_float(DPP_ROR(__float_as_int(v), 1))); return v; }
__device__ __forceinline__ float row_max(float v) {
    v = fmaxf(v, __int_as_float(DPP_ROR(__float_as_int(v), 8))); v = fmaxf(v, __int_as_float(DPP_ROR(__float_as_int(v), 4)));
    v = fmaxf(v, __int_as_float(DPP_ROR(__float_as_int(v), 2))); v = fmaxf(v, __int_as_float(DPP_ROR(__float_as_int(v), 1))); return v; }
__device__ __forceinline__ float row_sumf(float v) {
    v += __int_as_float(DPP_ROR(__float_as_int(v), 8)); v += __int_as_float(DPP_ROR(__float_as_int(v), 4));
    v += __int_as_float(DPP_ROR(__float_as_int(v), 2)); v += __int_as_float(DPP_ROR(__float_as_int(v), 1)); return v; }
__device__ __forceinline__ int row_sumi(int v) { return row16_sum_i32(v); }
__device__ __forceinline__ int row_incl_scan(int v, int) {
    v += DPP_SHR0(v, 1); v += DPP_SHR0(v, 2); v += DPP_SHR0(v, 4); v += DPP_SHR0(v, 8); return v; }
template <int NV> __device__ __forceinline__ float row_bisect16(const float (&v)[NV]) {
    float mn = v[0], mx = v[0];
#pragma unroll
    for (int j = 1; j < NV; ++j) { mn = fminf(mn, v[j]); mx = fmaxf(mx, v[j]); }
    float lo = row_min(mn), hi = row_max(mx); int cl = NV * 16;
    for (int it = 0; it < 64; ++it) {
        const float mid = 0.5f * (lo + hi);
        const bool active = (cl != 16) && (mid > lo) && (mid < hi);
        if (!__any(active)) break;
        int c = 0;
#pragma unroll
        for (int j = 0; j < NV; ++j) c += (v[j] >= mid) ? 1 : 0;
        c = row_sumi(c);
        if (active) { if (c >= 16) { lo = mid; cl = c; } else hi = mid; }
    }
    return lo;
}

template <int NV> __device__ __forceinline__ unsigned row_select16(const float (&v)[NV]) {
    typedef short s16x2 __attribute__((ext_vector_type(2))); typedef unsigned short u16x2 __attribute__((ext_vector_type(2)));
    float mn = v[0], mx = v[0];
#pragma unroll
    for (int j = 1; j < NV; ++j) { mn = fminf(mn, v[j]); mx = fmaxf(mx, v[j]); }
    mn = row_min(mn); mx = row_max(mx);
    const float sc = 32767.0f / fmaxf(mx - mn, 1e-30f);
    unsigned kp[NV / 2];
#pragma unroll
    for (int j = 0; j < NV / 2; ++j) { const unsigned k0 = min(32767u, (unsigned)((v[2 * j] - mn) * sc)), k1 = min(32767u, (unsigned)((v[2 * j + 1] - mn) * sc)); kp[j] = k0 | (k1 << 16); }
    unsigned T = 0u;
#pragma unroll 1
    for (int b = 14; b >= 0; --b) {
        const unsigned cand = T | (1u << b); const s16x2 c2 = __builtin_bit_cast(s16x2, cand * 0x00010001u);
        u16x2 acc = (u16x2){0, 0};
#pragma unroll
        for (int j = 0; j < NV / 2; ++j) { const s16x2 d = __builtin_bit_cast(s16x2, kp[j]) - c2; acc += __builtin_bit_cast(u16x2, d) >> (unsigned short)15; }
        const unsigned a = __builtin_bit_cast(unsigned, acc);
        const int lt = row_sumi((int)((a & 0xffffu) + (a >> 16)));
        if (NV * 16 - lt >= 16) T = cand;
    }
    unsigned selm = 0u;
#pragma unroll
    for (int j = 0; j < NV; ++j) { const unsigned k = (j & 1) ? (kp[j >> 1] >> 16) : (kp[j >> 1] & 0xffffu); selm |= (k >= T ? 1u : 0u) << j; }
    return selm;
}

template <int NV, int BITS = 13> __device__ __forceinline__ void row_select16_x2(const float (&va)[NV], const float (&vb)[NV], unsigned& selma, unsigned& selmb) {
    typedef short s16x2 __attribute__((ext_vector_type(2))); typedef unsigned short u16x2 __attribute__((ext_vector_type(2)));
    float mna = va[0], mxa = va[0], mnb = vb[0], mxb = vb[0];
#pragma unroll
    for (int j = 1; j < NV; ++j) { mna = fminf(mna, va[j]); mxa = fmaxf(mxa, va[j]); mnb = fminf(mnb, vb[j]); mxb = fmaxf(mxb, vb[j]); }
    mna = row_min(mna); mxa = row_max(mxa); mnb = row_min(mnb); mxb = row_max(mxb);
    const float sca = 1.0f / fmaxf(mxa - mna, 1e-30f), scb = 1.0f / fmaxf(mxb - mnb, 1e-30f);
    unsigned kpa[NV / 2], kpb[NV / 2];
#pragma unroll
    for (int j = 0; j < NV / 2; ++j) { kpa[j] = __builtin_bit_cast(unsigned, __builtin_amdgcn_cvt_pknorm_u16((va[2 * j] - mna) * sca, (va[2 * j + 1] - mna) * sca) >> (unsigned short)(16 - BITS));
        kpb[j] = __builtin_bit_cast(unsigned, __builtin_amdgcn_cvt_pknorm_u16((vb[2 * j] - mnb) * scb, (vb[2 * j + 1] - mnb) * scb) >> (unsigned short)(16 - BITS)); }
    unsigned Ta = 0u, Tb = 0u;
#pragma unroll 1
    for (int b = BITS - 1; b >= 0; --b) {
        const unsigned bit2 = 0x00010001u << b;
        const unsigned ca = Ta | bit2, cb = Tb | bit2;
        const s16x2 c2a = __builtin_bit_cast(s16x2, ca), c2b = __builtin_bit_cast(s16x2, cb);
        u16x2 acca = (u16x2){0, 0}, accb = (u16x2){0, 0};
#pragma unroll
        for (int j = 0; j < NV / 2; ++j) { const s16x2 da = __builtin_bit_cast(s16x2, kpa[j]) - c2a, db = __builtin_bit_cast(s16x2, kpb[j]) - c2b;
            acca += __builtin_bit_cast(u16x2, da) >> (unsigned short)15; accb += __builtin_bit_cast(u16x2, db) >> (unsigned short)15; }
        const unsigned a = __builtin_bit_cast(unsigned, acca), bq = __builtin_bit_cast(unsigned, accb);
        const int lt = row_sumi((int)(__builtin_amdgcn_perm(bq, a, 0x05040100u) + __builtin_amdgcn_perm(bq, a, 0x07060302u)));
        if (NV * 16 - (lt & 0xffff) >= 16) Ta = ca;
        if (NV * 16 - (lt >> 16) >= 16) Tb = cb;
    }
    selma = 0u; selmb = 0u;
    Ta &= 0xffffu; Tb &= 0xffffu;
#pragma unroll
    for (int j = 0; j < NV; ++j) { const unsigned ka = (j & 1) ? (kpa[j >> 1] >> 16) : (kpa[j >> 1] & 0xffffu), kb = (j & 1) ? (kpb[j >> 1] >> 16) : (kpb[j >> 1] & 0xffffu);
        selma |= (ka >= Ta ? 1u : 0u) << j; selmb |= (kb >= Tb ? 1u : 0u) << j; }
}

__device__ __forceinline__ void p10_topk(const Frame& F, int layer, const Params& P) {
    const float* pu = P.in[I_PU]; const float* pv = P.in[I_PV];
    unsigned char* ws = F.ws;
    const bf16* QP = (const bf16*)(ws + WS_OG); const bf16* KEYS = (const bf16*)(ws + WS_KEYS) + (size_t)layer * (8 * 2 * 128 * 128);
    int* EIDX = (int*)(ws + WS_EIDX); float* EGATE = (float*)(ws + WS_EGATE);
    LAS bf16* keysL = (LAS bf16*)F.lds;
    LAS bf16* At = (LAS bf16*)(F.lds + 69632);
    LAS float* sc = (LAS float*)(F.lds + 86528);
    LAS float* sel_s = (LAS float*)(F.lds + 120320);
    LAS int* sel_i = (LAS int*)(F.lds + 128512);
    LAS float* fin_s = (LAS float*)(F.lds + 136704);
    LAS int* fin_i = (LAS int*)(F.lds + 140800);
    const int lane = F.lane, w = F.wave, fr = lane & 15, fq = lane >> 4, tid = F.tid;
    unsigned stw = 0x03020100u;
    { constexpr unsigned STW[16] = { 0x03020100u, 0x07060504u, 0x0b0a0908u, 0x0f0e0d0cu, 0x13121110u, 0x17161514u, 0x23222120u, 0x32313024u, 0x42414033u, 0x61605150u, 0x90807170u, 0xd0c0b0a0u, 0xfffff0e0u, 0xffffffffu, 0xffffffffu, 0xffffffffu };
#pragma unroll
      for (int k = 1; k < 16; ++k) stw = (fr == k) ? STW[k] : stw; }
    const unsigned stvalid = fr < 12 ? 15u : (fr == 12 ? 3u : 0u);
    for (int blk = F.bid; blk < M / 64; blk += F.G) {
        v4u kreg[8], areg[2];
#pragma unroll
        for (int it = 0; it < 8; ++it) { const int item = tid + NTHR * it, row = item >> 4, ch = item & 15; kreg[it] = *(const v4u*)(KEYS + (size_t)row * 128 + ch * 8); }
#pragma unroll
        for (int it = 0; it < 2; ++it) { const int item = tid + NTHR * it, row = item >> 5, ch = item & 31; areg[it] = *(const v4u*)(QP + (size_t)(blk * 64 + row) * D + ch * 8); }
#pragma unroll 1
        for (int h = 0; h < 8; ++h) {
#pragma unroll 1
            for (int tile = 0; tile < 2; ++tile) {
                const int t0 = blk * 64 + tile * 32;
                const int tqr = (blk * 16 + h * 2 + tile) * 8 + w, tqt = tqr >> 14, tqe = tqr & (NEXP - 1);
                f32x4 tqv[4][2];
                { const float* src = (tqt ? pv : pu) + ((size_t)layer * NEXP + tqe) * D;
#pragma unroll
                  for (int j = 0; j < 4; ++j)
#pragma unroll
                      for (int q = 0; q < 2; ++q) tqv[j][q] = __builtin_nontemporal_load((const f32x4*)src + 2 * lane + 128 * j + q); }
                if (tile == 0) {
#pragma unroll
                    for (int it = 0; it < 8; ++it) { const int item = tid + NTHR * it, row = item >> 4, ch = item & 15; *(LAS v4u*)(keysL + row * 136 + ch * 8) = kreg[it]; } }
#pragma unroll
                for (int it = 0; it < 2; ++it) { const int item = tid + NTHR * it, row = item >> 5, ch = item & 31; *(LAS v4u*)(At + row * 264 + ch * 8) = areg[it]; }
                __syncthreads();
                { const int hn = tile ? h + 1 : h, tn = tile ? 0 : 1;
                  if (hn < 8) {
#pragma unroll
                      for (int it = 0; it < 2; ++it) { const int item = tid + NTHR * it, row = item >> 5, ch = item & 31; areg[it] = *(const v4u*)(QP + (size_t)(blk * 64 + tn * 32 + row) * D + hn * 256 + ch * 8); }
                      if (tile) {
#pragma unroll
                          for (int it = 0; it < 8; ++it) { const int item = tid + NTHR * it, row = item >> 4, ch = item & 15; kreg[it] = *(const v4u*)(KEYS + ((size_t)hn * 256 + row) * 128 + ch * 8); } } } }
#pragma unroll
                for (int p = 0; p < 2; ++p)
#pragma unroll
                    for (int tt = 0; tt < 2; ++tt) { f32x4 acc = (f32x4){0.f, 0.f, 0.f, 0.f};
#pragma unroll
                        for (int ks = 0; ks < 4; ++ks) { const bf16x8 af = *(const LAS bf16x8*)(At + (16 * tt + fr) * 264 + p * 128 + ks * 32 + 8 * fq);
                            const bf16x8 kf = *(const LAS bf16x8*)(keysL + (p * 128 + 16 * w + fr) * 136 + ks * 32 + 8 * fq); acc = mfma16(kf, af, acc); }
                        *(LAS f32x4*)(sc + ((16 * tt + fr) * 2 + p) * 132 + 16 * w + 4 * fq) = acc; }
                __syncthreads();
                {
                    const int tla = 4 * w + (fq >> 1), tlb = tla + 2, p = fq & 1;
                    float va[8], vb[8];
                    { const f32x4 a = *(const LAS f32x4*)(sc + (tla * 2 + p) * 132 + fr * 8), b = *(const LAS f32x4*)(sc + (tla * 2 + p) * 132 + fr * 8 + 4);
                      va[0] = a[0]; va[1] = a[1]; va[2] = a[2]; va[3] = a[3]; va[4] = b[0]; va[5] = b[1]; va[6] = b[2]; va[7] = b[3]; }
                    { const f32x4 a = *(const LAS f32x4*)(sc + (tlb * 2 + p) * 132 + fr * 8), b = *(const LAS f32x4*)(sc + (tlb * 2 + p) * 132 + fr * 8 + 4);
                      vb[0] = a[0]; vb[1] = a[1]; vb[2] = a[2]; vb[3] = a[3]; vb[4] = b[0]; vb[5] = b[1]; vb[6] = b[2]; vb[7] = b[3]; }
                    unsigned selma, selmb; row_select16_x2<8>(va, vb, selma, selmb);
                    { const int ns = __popc(selma); int pos = row_incl_scan(ns, fr) - ns; const int o = ((tile * 32 + tla) * 2 + p) * 16;
#pragma unroll
                      for (int j = 0; j < 8; ++j) if ((selma >> j) & 1u) { if (pos < 16) { sel_s[o + pos] = va[j]; sel_i[o + pos] = fr * 8 + j; } ++pos; } }
                    { const int ns = __popc(selmb); int pos = row_incl_scan(ns, fr) - ns; const int o = ((tile * 32 + tlb) * 2 + p) * 16;
#pragma unroll
                      for (int j = 0; j < 8; ++j) if ((selmb >> j) & 1u) { if (pos < 16) { sel_s[o + pos] = vb[j]; sel_i[o + pos] = fr * 8 + j; } ++pos; } }
                }
                LDS_WAIT(); asm volatile("" ::: "memory");
                { unsigned* dst = (unsigned*)(ws + (layer ? (tqt ? WS_VT1 : WS_UT1) : (tqt ? WS_VT0 : WS_UT0)) + (size_t)tqe * 1024);
                  float ss = 0.f;
#pragma unroll
                  for (int j = 0; j < 4; ++j)
#pragma unroll
                      for (int q = 0; q < 2; ++q) ss += (tqv[j][q][0] * tqv[j][q][0] + tqv[j][q][1] * tqv[j][q][1]) + (tqv[j][q][2] * tqv[j][q][2] + tqv[j][q][3] * tqv[j][q][3]);
                  ss = wsum(ss);
                  const float rms = sqrtf(ss * (1.0f / D));
                  const float step = ss > 0.f ? (tqt ? 0.47f * rms : 0.3352f * rms) : 1.0f, inv = 1.0f / step;
#pragma unroll
                  for (int j = 0; j < 4; ++j) { unsigned wq = 0u;
                      if (tqt) wq = fp4x4(tqv[j][0][0] * inv, tqv[j][0][1] * inv, tqv[j][0][2] * inv, tqv[j][0][3] * inv) | (fp4x4(tqv[j][1][0] * inv, tqv[j][1][1] * inv, tqv[j][1][2] * inv, tqv[j][1][3] * inv) << 16);
                      else {
#pragma unroll
                          for (int i = 0; i < 4; ++i) {
                              const unsigned lo = (unsigned)__builtin_amdgcn_fmed3f(fmaf(tqv[j][0][i], inv, 8.0f), 0.0f, 15.5f), hi = (unsigned)__builtin_amdgcn_fmed3f(fmaf(tqv[j][1][i], inv, 8.0f), 0.0f, 15.5f);
                              wq |= ((lo ^ 8u) << (4 * i)) | ((hi ^ 8u) << (16 + 4 * i)); } }
                      dst[lane + 64 * j] = wq; }
                  if (lane == 0) ((float*)(ws + WS_TSC))[((size_t)layer * NEXP + tqe) * 2 + tqt] = step; }
                if (tile == 1) {
                    const int tl = 4 * w + fq, oa = (tl * 2) * 16, ob = ((32 + tl) * 2) * 16;
                    const float a1 = sel_s[oa + fr], a2 = sel_s[oa + 16 + fr], b1 = sel_s[ob + fr], b2 = sel_s[ob + 16 + fr];
                    const int ia1 = sel_i[oa + fr], ia2 = sel_i[oa + 16 + fr], ib1 = sel_i[ob + fr], ib2 = sel_i[ob + 16 + fr];
#define ST_UKEY(x) ((((__float_as_uint(x) & 0x80000000u) ? ~__float_as_uint(x) : (__float_as_uint(x) | 0x80000000u)) & ~15u) | (15u - (unsigned)fr))
                    const unsigned ua1 = ST_UKEY(a1), ua2 = ST_UKEY(a2), ub1 = ST_UKEY(b1), ub2 = ST_UKEY(b2);
                    int ra1 = 0, ra2 = 0, rb1 = 0, rb2 = 0;
#define ST_RK(n) ra1 += ((unsigned)DPP_ROR((int)ua1, n) > ua1) ? 1 : 0; ra2 += ((unsigned)DPP_ROR((int)ua2, n) > ua2) ? 1 : 0; rb1 += ((unsigned)DPP_ROR((int)ub1, n) > ub1) ? 1 : 0; rb2 += ((unsigned)DPP_ROR((int)ub2, n) > ub2) ? 1 : 0;
                    ST_RK(1) ST_RK(2) ST_RK(3) ST_RK(4) ST_RK(5) ST_RK(6) ST_RK(7) ST_RK(8) ST_RK(9) ST_RK(10) ST_RK(11) ST_RK(12) ST_RK(13) ST_RK(14) ST_RK(15)
#undef ST_RK
#undef ST_UKEY
                    sel_s[oa + ra1] = a1; sel_i[oa + ra1] = ia1; sel_s[oa + 16 + ra2] = a2; sel_i[oa + 16 + ra2] = ia2;
                    sel_s[ob + rb1] = b1; sel_i[ob + rb1] = ib1; sel_s[ob + 16 + rb2] = b2; sel_i[ob + 16 + rb2] = ib2;
                    LDS_WAIT(); asm volatile("" ::: "memory");
                    float ca[4], cb[4]; float mva = 3.0e38f, mvb = 3.0e38f;
#pragma unroll
                    for (int q = 0; q < 4; ++q) { const int si = (stw >> (8 * q + 4)) & 15, sj = (stw >> (8 * q)) & 15; const bool ok = (stvalid >> q) & 1u;
                        ca[q] = sel_s[oa + si] + sel_s[oa + 16 + sj]; cb[q] = sel_s[ob + si] + sel_s[ob + 16 + sj];
                        mva = ok ? fminf(mva, ca[q]) : mva; mvb = ok ? fminf(mvb, cb[q]) : mvb; }
                    mva = row_min(mva); mvb = row_min(mvb);
#pragma unroll
                    for (int q = 0; q < 4; ++q) { const bool ok = (stvalid >> q) & 1u; ca[q] = ok ? ca[q] : mva; cb[q] = ok ? cb[q] : mvb; }
                    unsigned selma, selmb; row_select16_x2<4, 15>(ca, cb, selma, selmb);
                    { const int ns = __popc(selma); int pos = row_incl_scan(ns, fr) - ns;
#pragma unroll
                      for (int q = 0; q < 4; ++q) if ((selma >> q) & 1u) { if (pos < 16) { const int si = (stw >> (8 * q + 4)) & 15, sj = (stw >> (8 * q)) & 15; fin_s[tl * 16 + pos] = ca[q]; fin_i[tl * 16 + pos] = sel_i[oa + si] * 128 + sel_i[oa + 16 + sj]; } ++pos; } }
                    { const int ns = __popc(selmb); int pos = row_incl_scan(ns, fr) - ns;
#pragma unroll
                      for (int q = 0; q < 4; ++q) if ((selmb >> q) & 1u) { if (pos < 16) { const int si = (stw >> (8 * q + 4)) & 15, sj = (stw >> (8 * q)) & 15; fin_s[(32 + tl) * 16 + pos] = cb[q]; fin_i[(32 + tl) * 16 + pos] = sel_i[ob + si] * 128 + sel_i[ob + 16 + sj]; } ++pos; } }
                    LDS_WAIT(); asm volatile("" ::: "memory");
#pragma unroll
                    for (int tt = 0; tt < 2; ++tt) {
                        const float ts = fin_s[(32 * tt + tl) * 16 + fr]; const int ei = fin_i[(32 * tt + tl) * 16 + fr];
                        const float mx = row_max(ts); const float ex = expf(ts - mx); const float sm = row_sumf(ex);
                        const size_t o = (size_t)(blk * 64 + 32 * tt + tl) * 128 + h * 16 + fr;
                        EIDX[o] = ei; EGATE[o] = ex / sm;
                    }
                    LDS_WAIT(); asm volatile("" ::: "memory");
                }
            }
        }
    }
}

__device__ __forceinline__ void p11u_pass(const Frame& F, int layer) {
    unsigned char* ws = F.ws;
    const unsigned char* UT = ws + (layer ? WS_UT1 : WS_UT0);
    typedef float f32x2v __attribute__((ext_vector_type(2)));
    const f32x2v* TSC = (const f32x2v*)(ws + WS_TSC) + (size_t)layer * NEXP;
    const unsigned char* XQ = ws + WS_XQ; const f32x2v* SX = (const f32x2v*)(ws + WS_SX);
    const int* EIDX = (const int*)(ws + WS_EIDX); const float* EGATE = (const float*)(ws + WS_EGATE); float* ACT = (float*)(ws + WS_ACT);
    const int lane = F.lane, g16 = lane >> 4, l16 = lane & 15;
    LAS unsigned char* xs = F.lds + F.wave * 16384;
    LAS int* listb = (LAS int*)(F.lds + F.wave * 16384 + 8192);
    const unsigned long long lt = (1ull << lane) - 1ull;
    for (int vb = F.bid; vb < 256; vb += F.G) {
        const int bk = vb & 7, tg = (vb >> 3) * 8 + F.wave;
        int pe0[4], pe1[4]; float pg0[4], pg1[4]; v4u pxa[4], pxb[4];
#define UA_FETCH(SB) do { const int t0_ = tg * 64 + (SB) * 4; _Pragma("unroll") for (int tl = 0; tl < 4; ++tl) { \
            pe0[tl] = EIDX[(size_t)(t0_ + tl) * 128 + lane]; pe1[tl] = EIDX[(size_t)(t0_ + tl) * 128 + 64 + lane]; pg0[tl] = EGATE[(size_t)(t0_ + tl) * 128 + lane]; pg1[tl] = EGATE[(size_t)(t0_ + tl) * 128 + 64 + lane]; \
            pxa[tl] = *(const v4u*)(XQ + (size_t)(t0_ + tl) * D + 16 * lane); pxb[tl] = *(const v4u*)(XQ + (size_t)(t0_ + tl) * D + 1024 + 16 * lane); } } while (0)
#define UA_BUILD(LST, GLST, NOUT) do { int n_ = 0; _Pragma("unroll") for (int tl = 0; tl < 4; ++tl) { const int e0 = pe0[tl], e1 = pe1[tl]; \
            const bool s0 = (e0 >> 11) == bk, s1 = (e1 >> 11) == bk; const unsigned long long m0 = __ballot(s0), m1 = __ballot(s1); const int c0 = __popcll(m0); \
            if (s0) { const int p = n_ + __popcll(m0 & lt); (LST)[p] = (e0 << 10) | (tl << 7) | lane; (GLST)[p] = pg0[tl]; } \
            if (s1) { const int p = n_ + c0 + __popcll(m1 & lt); (LST)[p] = (e1 << 10) | (tl << 7) | (64 + lane); (GLST)[p] = pg1[tl]; } \
            n_ += c0 + __popcll(m1); } NOUT = n_; } while (0)
#define UA_XS() do { _Pragma("unroll") for (int tl = 0; tl < 4; ++tl) { *(LAS v4u*)(xs + tl * 2048 + 16 * lane) = pxa[tl]; *(LAS v4u*)(xs + tl * 2048 + 1024 + 16 * lane) = pxb[tl]; } } while (0)
        v4u u[2][4]; f32x2v sc2[2], sx2[2]; float gk[2]; int tokk[2], kidx[2], tls[2]; bool valid[2];
        v4u un[2][4]; f32x2v sc2n[2], sx2n[2]; float gkn[2]; int tokkn[2], kidxn[2], tlsn[2]; bool validn[2];
#define U_FETCH(LST, GLST, NN, TOK0, P0, U, SC2, SX2, GK, TOKK, KIDX, TLS, VALID) do { _Pragma("unroll") for (int h = 0; h < 2; ++h) { const int p = (P0) + 4 * h + g16; VALID[h] = p < (NN); const int pp = VALID[h] ? p : 0; const int ent = VALID[h] ? (LST)[pp] : 0; GK[h] = (GLST)[pp]; \
                    const int e = ent >> 10; TLS[h] = (ent >> 7) & 3; const int tok = (TOK0) + TLS[h]; KIDX[h] = ent & 127; TOKK[h] = tok; \
                    const unsigned char* rowp = UT + (size_t)e * 1024 + l16 * 16; \
                    _Pragma("unroll") for (int i = 0; i < 4; ++i) U[h][i] = *(const v4u*)(rowp + 256 * i); \
                    SC2[h] = TSC[e]; SX2[h] = SX[tok]; } } while (0)
#define U_COMP(U, SC2, SX2, GK, TOKK, KIDX, TLS, VALID) do { _Pragma("unroll") for (int h = 0; h < 2; ++h) { int acch = 0, accl = 0; const LAS unsigned char* xp = xs + TLS[h] * 2048 + l16 * 16;     \
                    _Pragma("unroll") for (int i = 0; i < 4; ++i) { const v4u xa = *(const LAS v4u*)(xp + 256 * i), xb = *(const LAS v4u*)(xp + 1024 + 256 * i); \
                        acch = __builtin_amdgcn_sdot8((int)U[h][i].x, (int)xa.x, acch, false); accl = __builtin_amdgcn_sdot8((int)U[h][i].x, (int)xb.x, accl, false); \
                        acch = __builtin_amdgcn_sdot8((int)U[h][i].y, (int)xa.y, acch, false); accl = __builtin_amdgcn_sdot8((int)U[h][i].y, (int)xb.y, accl, false); \
                        acch = __builtin_amdgcn_sdot8((int)U[h][i].z, (int)xa.z, acch, false); accl = __builtin_amdgcn_sdot8((int)U[h][i].z, (int)xb.z, accl, false); \
                        acch = __builtin_amdgcn_sdot8((int)U[h][i].w, (int)xa.w, acch, false); accl = __builtin_amdgcn_sdot8((int)U[h][i].w, (int)xb.w, accl, false); } \
                    const int acc = row16_sum_i32(16 * acch + accl); \
                    const float d = ((float)(2 * acc) + SX2[h].y) * (0.5f * SC2[h].x * SX2[h].x);       \
                    const float act = gelu_tanh(d) * GK[h] * SC2[h].y; \
                    if (VALID[h] && l16 == 0) ACT[(size_t)TOKK[h] * 128 + KIDX[h]] = act; } } while (0)
        int n;
        UA_FETCH(0);
        { LAS int* l0 = listb; LAS float* g0 = (LAS float*)(listb + 512); UA_BUILD(l0, g0, n); }
        UA_XS();
        { LAS int* l0 = listb; LAS float* g0 = (LAS float*)(listb + 512); U_FETCH(l0, g0, n, tg * 64, 0, u, sc2, sx2, gk, tokk, kidx, tls, valid); }
        UA_FETCH(1);
#pragma unroll 1
        for (int sb = 0; sb < 16; ++sb) {
            const int tok0 = tg * 64 + sb * 4;
            LAS int* list = listb + (sb & 1) * 1024; LAS float* glist = (LAS float*)(list + 512);
            LAS int* listn = listb + ((sb & 1) ^ 1) * 1024; LAS float* glistn = (LAS float*)(listn + 512);
            int nn = 0; bool built = false;
#pragma unroll 1
            for (int p0 = 0; p0 < n; p0 += 16) {
                U_FETCH(list, glist, n, tok0, p0 + 8, un, sc2n, sx2n, gkn, tokkn, kidxn, tlsn, validn);
                U_COMP(u, sc2, sx2, gk, tokk, kidx, tls, valid);
                if (p0 + 16 >= n) {
                    if (sb < 15) UA_BUILD(listn, glistn, nn);
                    built = true;
                    U_FETCH(listn, glistn, nn, tok0 + 4, 0, u, sc2, sx2, gk, tokk, kidx, tls, valid);
                } else U_FETCH(list, glist, n, tok0, p0 + 16, u, sc2, sx2, gk, tokk, kidx, tls, valid);
                if (p0 + 8 < n) U_COMP(un, sc2n, sx2n, gkn, tokkn, kidxn, tlsn, validn);
            }
            if (!built) { if (sb < 15) UA_BUILD(listn, glistn, nn); U_FETCH(listn, glistn, nn, tok0 + 4, 0, u, sc2, sx2, gk, tokk, kidx, tls, valid); }
            if (sb < 15) { UA_XS(); UA_FETCH(sb < 14 ? sb + 2 : 15); }
            n = nn;
        }
#undef U_COMP
#undef U_FETCH
#undef UA_XS
#undef UA_BUILD
#undef UA_FETCH
        asm volatile("" ::: "memory");
    }
}
template <int TAIL> __device__ __forceinline__ void p11v_pass(const Frame& F, int layer, const float* tgv, const float* tmod, unsigned char* thn, float* tout) {
    unsigned char* ws = F.ws;
    const unsigned char* VT = ws + (layer ? WS_VT1 : WS_VT0);
    bf16* HLAT = (bf16*)(ws + WS_HLAT);
    const int* EIDX = (const int*)(ws + WS_EIDX); const float* ACT = (const float*)(ws + WS_ACT);
    const float* MODV = (const float*)(ws + WS_MODV) + (size_t)layer * 3 * NMOD;
    const int lane = F.lane, l8 = lane & 7, g8 = lane >> 3, fr = lane & 15, fq = lane >> 4;
    typedef int i32x2 __attribute__((ext_vector_type(2))); typedef int i32x4 __attribute__((ext_vector_type(4))); typedef int i32x8 __attribute__((ext_vector_type(8)));
    typedef float f32x2v __attribute__((ext_vector_type(2)));
    LAS unsigned char* T = F.lds + F.wave * 17536;
    LAS unsigned char* apl = T + 16384;
    LAS float* outs = (LAS float*)(T + 16512);
    LAS unsigned char* twr = T + (16 * g8) * 128;
    const LAS unsigned char* trd = T + (32 * fq + fr) * 128;
    for (int vb = F.bid; vb < 256; vb += F.G) {
        const int s = vb & 7, tg = (vb >> 3) * 8 + F.wave;
        const unsigned char* vbase = VT + s * 128 + 16 * l8;
        i32x4 evn[4]; f32x2v a2; v4u w[16]; float part_mine = 0.f;
        { const int tok = tg * 64;
          i32x4 ev0[4];
#pragma unroll
          for (int j = 0; j < 4; ++j) ev0[j] = *(const i32x4*)(EIDX + (size_t)tok * 128 + 16 * g8 + 4 * j);
#pragma unroll
          for (int q = 0; q < 16; ++q) w[q] = *(const v4u*)(vbase + (size_t)ev0[q >> 2][q & 3] * 1024);
          a2 = *(const f32x2v*)(ACT + (size_t)tok * 128 + 2 * lane);
#pragma unroll
          for (int j = 0; j < 4; ++j) evn[j] = *(const i32x4*)(EIDX + (size_t)(tok + 1) * 128 + 16 * g8 + 4 * j); }
#pragma unroll 1
        for (int ti = 0; ti < 64; ++ti) {
            const int tok = tg * 64 + ti, tokn = tg * 64 + (ti < 63 ? ti + 1 : 63), tokn2 = tg * 64 + (ti < 62 ? ti + 2 : 63);
#pragma unroll
            for (int q = 0; q < 16; ++q) { const v4u x = (q & 1) ? (v4u){w[q].z, w[q].w, w[q].x, w[q].y} : w[q]; *(LAS v4u*)(twr + q * 128 + ((l8 ^ (q >> 1)) * 16)) = x; }
            float amax = fmaxf(fabsf(a2.x), fabsf(a2.y)); amax = wmaxf_all(amax);
            const float uh = amax > 0.f ? amax * (1.0f / 6.0f) : 1.0f, iuh = 1.0f / uh;
            { const unsigned ch = __builtin_amdgcn_cvt_scalef32_pk_fp4_f32(0u, a2.x * iuh, a2.y * iuh, 1.0f, 0) & 0xffu;
              const f32x2v dq = __builtin_amdgcn_cvt_scalef32_pk_f32_fp4(ch, 1.0f, 0);
              const unsigned cl = __builtin_amdgcn_cvt_scalef32_pk_fp4_f32(0u, (a2.x * iuh - dq[0]) * 6.0f, (a2.y * iuh - dq[1]) * 6.0f, 1.0f, 0) & 0xffu;
              apl[lane] = (unsigned char)ch; apl[64 + lane] = (unsigned char)cl; }
#pragma unroll
            for (int q = 0; q < 16; ++q) w[q] = *(const v4u*)(vbase + (size_t)evn[q >> 2][q & 3] * 1024);
            a2 = *(const f32x2v*)(ACT + (size_t)tokn * 128 + 2 * lane);
#pragma unroll
            for (int j = 0; j < 4; ++j) evn[j] = *(const i32x4*)(EIDX + (size_t)tokn2 * 128 + 16 * g8 + 4 * j);
            const int col = s * 256 + 4 * lane; const size_t off = (size_t)tok * D + col;
            const f32x4 gq = *(const f32x4*)(MODV + (size_t)(tok >> 13) * NMOD + 10240 + col); const v2u hx = *(const v2u*)(HLAT + off);
            LDS_WAIT(); asm volatile("" ::: "memory");
            i32x4 bq = (i32x4){0, 0, 0, 0};
            if (fr < 2) bq = *(const LAS i32x4*)(apl + fr * 64 + 16 * fq);
            const i32x8 b8 = (i32x8){bq[0], bq[1], bq[2], bq[3], 0, 0, 0, 0};
#pragma unroll
            for (int ct = 0; ct < 16; ++ct) {
                const LAS unsigned char* p = trd + ((ct ^ fr) * 8);
                const i32x2 r0 = __builtin_amdgcn_ds_read_tr4_b64_v2i32((LAS i32x2*)p), r1 = __builtin_amdgcn_ds_read_tr4_b64_v2i32((LAS i32x2*)(p + 2048));
                const i32x8 a8 = (i32x8){r0[0], r0[1], r1[0], r1[1], 0, 0, 0, 0};
                const f32x4 d = __builtin_amdgcn_mfma_scale_f32_16x16x128_f8f6f4(a8, b8, (f32x4){0.f, 0.f, 0.f, 0.f}, 4, 4, 0, 0, 0, 0);
                f32x4 dl;
#pragma unroll
                for (int r = 0; r < 4; ++r) dl[r] = __int_as_float(__builtin_amdgcn_update_dpp(0, __float_as_int(d[r]), 0x101, 0xf, 0xf, true));
                if (fr == 0) *(LAS f32x4*)(outs + ct * 16 + 4 * fq) = uh * (d + dl * (1.0f / 6.0f));
            }
            LDS_WAIT(); asm volatile("" ::: "memory");
            const f32x4 o = *(const LAS f32x4*)(outs + 4 * lane);
            f32x4 h0 = (f32x4){bflo(hx.x), bfhi(hx.x), bflo(hx.y), bfhi(hx.y)};
#pragma unroll
            for (int i = 0; i < 4; ++i) h0[i] += gq[i] * o[i];
            { v2u ho; ho.x = pk2c(h0[0], h0[1]); ho.y = pk2c(h0[2], h0[3]); *(v2u*)(HLAT + off) = ho;
              if (TAIL) { const float b0 = bflo(ho.x), b1 = bfhi(ho.x), b2 = bflo(ho.y), b3 = bfhi(ho.y); const float ss = wsum((b0 * b0 + b1 * b1) + (b2 * b2 + b3 * b3)); if (lane == ti) part_mine = ss; } }
            LDS_WAIT(); asm volatile("" ::: "memory");
        }
        if (TAIL) {
            float* xsl = (float*)(ws + WS_XCH) + ((size_t)(layer * 256 + tg) * 8) * 64;
            unsigned* xcnt = (unsigned*)(ws + WS_CTL) + CW_XCH + layer * 256 + tg;
            __hip_atomic_store(xsl + s * 64 + lane, part_mine, __ATOMIC_RELAXED, __HIP_MEMORY_SCOPE_AGENT);
            asm volatile("s_waitcnt vmcnt(0)" ::: "memory");
            if (lane == 0) (void)xb_add(xcnt, 1u);
            { unsigned sp = 0u; while (xb_ld(xcnt) < 8u) { __builtin_amdgcn_s_sleep(2); if (++sp > XB_SPIN_CAP) break; } }
            float tot = 0.f;
#pragma unroll
            for (int q = 0; q < 8; ++q) tot += __hip_atomic_load(xsl + q * 64 + lane, __ATOMIC_RELAXED, __HIP_MEMORY_SCOPE_AGENT);
            const float rstd_l = 1.0f / sqrtf(tot * (1.0f / D) + EPS);
            const int col = s * 256 + 4 * lane, bt = (tg * 64) >> 13;
            const f32x4 g4 = *(const f32x4*)(tgv + col);
            f32x4 am = g4, bm = (f32x4){0.f, 0.f, 0.f, 0.f};
            if (TAIL == 1) { const float* mv = tmod + (size_t)bt * NMOD; const f32x4 sc = *(const f32x4*)(mv + 2048 + col), sh = *(const f32x4*)(mv + col); am = g4 * (sc + 1.0f); bm = sh; }
#pragma unroll 1
            for (int t0 = 0; t0 < 64; t0 += 32) {
                v2u hx[32];
#pragma unroll
                for (int i = 0; i < 32; ++i) hx[i] = *(const v2u*)(HLAT + (size_t)(tg * 64 + t0 + i) * D + col);
#pragma unroll
                for (int i = 0; i < 32; ++i) { const size_t off = (size_t)(tg * 64 + t0 + i) * D + col;
                    const float rstd = __int_as_float(__builtin_amdgcn_readlane(__float_as_int(rstd_l), t0 + i));
                    const f32x4 y = (f32x4){bflo(hx[i].x), bfhi(hx[i].x), bflo(hx[i].y), bfhi(hx[i].y)} * rstd * am + bm;
                    if (TAIL == 1) *(unsigned*)(thn + off) = pk4_fp8(y[0], y[1], y[2], y[3]);
                    else __builtin_nontemporal_store(y, (f32x4*)(tout + off)); }
            }
        }
    }
}

__device__ __forceinline__ void p14_spatial(const Frame& F, const Params& P) {
    unsigned char* ws = F.ws;
    const bf16* U = (const bf16*)(ws + WS_QKRAW); const bf16* VV = (const bf16*)(ws + WS_V); bf16* HN = (bf16*)(ws + WS_HN);
    const float* VSSP = (const float*)(ws + WS_VSSP);
    const float* w_s = P.in[I_CMWS]; const float* b_s = P.in[I_CMBS]; const float* g_v = P.in[I_CMGV];
    LAS bf16* Wp = (LAS bf16*)F.lds;
    LAS bf16* Vr = (LAS bf16*)(F.lds + 34816);
    LAS float* rs = (LAS float*)(F.lds + 103424);
    const int lane = F.lane, w = F.wave, fr = lane & 15, fq = lane >> 4, tid = F.tid;
    for (int u = F.bid; u < 1024; u += F.G) {
        const int g = u & 7, c = (u >> 3) & 63, b = u >> 9; const size_t row0 = (size_t)b * SEQ + c * CHK;
        __syncthreads();
        if (tid < 128) { float s = 0.f; for (int i = 0; i < 32; ++i) s += VSSP[(row0 + tid) * 32 + i]; rs[tid] = 1.0f / sqrtf(s * (1.0f / D) + EPS); }
#pragma unroll
        for (int it = 0; it < 8; ++it) { const int item = tid + NTHR * it, s = item >> 5, ch = item & 31;
            const v4u x = *(const v4u*)(VV + (row0 + s) * D + g * 256 + ch * 8);
            LAS v2u* d2 = (LAS v2u*)(Vr + s * 268 + ch * 8); d2[0] = (v2u){x.x, x.y}; d2[1] = (v2u){x.z, x.w}; }
        __syncthreads();
#pragma unroll
        for (int it = 0; it < 4; ++it) { const int item = tid + NTHR * it, t = item >> 4, s0 = (item & 15) * 8;
            const f32x4 a = *(const f32x4*)(w_s + ((size_t)g * 128 + t) * 128 + s0), bq = *(const f32x4*)(w_s + ((size_t)g * 128 + t) * 128 + s0 + 4);
            v4u o; o.x = pk2(a[0] * rs[s0], a[1] * rs[s0 + 1]); o.y = pk2(a[2] * rs[s0 + 2], a[3] * rs[s0 + 3]); o.z = pk2(bq[0] * rs[s0 + 4], bq[1] * rs[s0 + 5]); o.w = pk2(bq[2] * rs[s0 + 6], bq[3] * rs[s0 + 7]);
            *(LAS v4u*)(Wp + t * 136 + s0) = o; }
        __syncthreads();
        bf16x8 wf[4];
#pragma unroll
        for (int ks = 0; ks < 4; ++ks) wf[ks] = *(const LAS bf16x8*)(Wp + (16 * w + fr) * 136 + ks * 32 + 8 * fq);
        const int t = 16 * w + fr; const float bs = b_s[g * 128 + t];
#pragma unroll 2
        for (int dt = 0; dt < 16; ++dt) {
            f32x4 acc = (f32x4){0.f, 0.f, 0.f, 0.f};
#pragma unroll
            for (int ks = 0; ks < 4; ++ks) { bf16x8 vf;
#pragma unroll
                for (int i = 0; i < 8; ++i) vf[i] = (short)Vr[(ks * 32 + 8 * fq + i) * 268 + 16 * dt + fr];
                acc = mfma16(vf, wf[ks], acc); }
            const int dcol = g * 256 + 16 * dt + 4 * fq;
            const v2u uu = *(const v2u*)(U + (row0 + t) * D + dcol); const f32x4 gv = *(const f32x4*)(g_v + dcol);
            *(unsigned*)((unsigned char*)HN + (row0 + t) * D + dcol) = pk4_fp8(bflo(uu.x) * (acc[0] * gv[0] + bs), bfhi(uu.x) * (acc[1] * gv[1] + bs), bflo(uu.y) * (acc[2] * gv[2] + bs), bfhi(uu.y) * (acc[3] * gv[3] + bs));
        }
    }
}


#ifndef PROBE_HASH_N
#define PROBE_HASH_N ((size_t)M * D)
#endif
__device__ __forceinline__ void p_hash_bf16(const Frame& F, size_t wsoff, float* dout) {
    const bf16* src = (const bf16*)(F.ws + wsoff);
    for (size_t i = (size_t)F.bid * NTHR + F.tid; i < (size_t)M * D; i += (size_t)F.G * NTHR) { const unsigned h = ((unsigned)src[i < (size_t)PROBE_HASH_N ? i : 0] + 1u) * 2654435761u; dout[i] = (float)(h >> 8) * (1.0f / 16777216.0f); }
}
__device__ __forceinline__ void p_hash_f32(const Frame& F, size_t wsoff, float* dout) {
    const unsigned* src = (const unsigned*)(F.ws + wsoff);
    for (size_t i = (size_t)F.bid * NTHR + F.tid; i < (size_t)M * D; i += (size_t)F.G * NTHR) { const unsigned h = (src[i] + 1u) * 2654435761u; dout[i] = (float)(h >> 8) * (1.0f / 16777216.0f); }
}

__device__ __forceinline__ void p_final_only(const Frame& F, const float* g_final, float* dout) {
    const bf16* HLAT = (const bf16*)(F.ws + WS_HLAT);
    const int gw = F.bid * NWAVES + F.wave, NGW = F.G * NWAVES, lane = F.lane;
    v2u nx[8];
    f32x4 g4r[8];
#pragma unroll
    for (int j = 0; j < 8; ++j) g4r[j] = ((const f32x4*)g_final)[lane + 64 * j];
    if (gw < M) {
#pragma unroll
        for (int j = 0; j < 8; ++j) nx[j] = ((const v2u*)(HLAT + (size_t)gw * D))[lane + 64 * j]; }
    for (int row = gw; row < M; row += NGW) {
        f32x4 v[8]; float s = 0.f;
#pragma unroll
        for (int j = 0; j < 8; ++j) { const v2u x = nx[j]; v[j] = (f32x4){bflo(x.x), bfhi(x.x), bflo(x.y), bfhi(x.y)}; s += (v[j][0] * v[j][0] + v[j][1] * v[j][1]) + (v[j][2] * v[j][2] + v[j][3] * v[j][3]); }
        { const int rn = (row + NGW < M) ? row + NGW : row;
#pragma unroll
          for (int j = 0; j < 8; ++j) nx[j] = ((const v2u*)(HLAT + (size_t)rn * D))[lane + 64 * j]; }
        const float rstd = 1.0f / sqrtf(wsum(s) * (1.0f / D) + EPS);
#pragma unroll
        for (int j = 0; j < 8; ++j) __builtin_nontemporal_store(v[j] * rstd * g4r[j], (f32x4*)(dout + (size_t)row * D) + lane + 64 * j);
    }
}

constexpr int NPHASE = 20;
__global__ void __launch_bounds__(NTHR, 2) fwd(Params P) {
    extern __shared__ __attribute__((aligned(16))) unsigned char lds_[];
    Frame F; F.lds = (LAS unsigned char*)lds_; F.ws = P.ws; F.tid = threadIdx.x; F.lane = F.tid & 63; F.wave = __builtin_amdgcn_readfirstlane(F.tid >> 6); F.G = gridDim.x; F.bid = blockIdx.x;
    unsigned char* ws = P.ws;
    volatile LAS unsigned* MISC = (volatile LAS unsigned*)(F.lds + LDS_MISC);
    if (F.tid < 16) MISC[F.tid] = 0u;
    __syncthreads();
    const int lo = P.ph_lo, hi = P.ph_hi;
    XcdBarrier bar; bar.bar = (unsigned*)(ws + WS_CTL) + CW_BAR; bar.x = 0; bar.st = MISC + 8;
    if (hi - lo > 1) bar = xcd_barrier_post((unsigned*)(ws + WS_CTL) + CW_BAR, MISC + 8);
#define IN(k) (lo <= (k) && (k) < hi)
#define SEAM(k) do { if (IN(k) && IN((k) + 1)) xcd_barrier(bar); } while (0)
#ifndef PROBE_DUP_MASK
#define PROBE_DUP_MASK 0u
#endif
#define NREP(k) (((PROBE_DUP_MASK >> (k)) & 1u) ? 2 : 1)
    float* MODV = (float*)(ws + WS_MODV);
    bf16* HN = (bf16*)(ws + WS_HN); bf16* HLAT = (bf16*)(ws + WS_HLAT);

    if (IN(0)) for (int rep_ = 0; rep_ < NREP(0); ++rep_) { if (rep_) xcd_barrier(bar); p0_prologue(F, P); } SEAM(0);
    if (IN(1)) for (int rep_ = 0; rep_ < NREP(1); ++rep_) { if (rep_) xcd_barrier(bar); p1_adaln_gates(F, P.in[I_X], P.in[I_CTX], MC, P.in[I_GMIX], MODV, 0, 2048, (unsigned char*)HN, (const float*)(ws + WS_WG), P.in[I_MLGB], (float*)(ws + WS_GATES)); } SEAM(1);
    if (IN(2)) for (int rep_ = 0; rep_ < NREP(2); ++rep_) { if (rep_) xcd_barrier(bar);
        { pg8::Gemm g{(const pg8::bf16_t*)HN, (const pg8::bf16_t*)(ws + WS_WIN0), M, 6144, D / 2}; pg8::StaticOrder S; S.init(M, 6144, F.G, F.bid);
          EpiML E{(bf16*)(ws + WS_QKRAW), (bf16*)(ws + WS_VTR), (bf16*)(ws + WS_OG), 0, W8_INV};
          pg8::gemm_phase<EpiML, pg8::StaticOrder, true, true, true>(F.lds, g, S, E); }
        __syncthreads();
        { pg8::Gemm g{(const pg8::bf16_t*)((const unsigned char*)HN + (size_t)M * D), (const pg8::bf16_t*)(ws + WS_WIN0 + (size_t)1024 * D), MC, 3072, D / 2}; pg8::StaticOrder S; S.init(MC, 3072, F.G, F.bid);
          EpiML E{(bf16*)(ws + WS_QKRAW) + (size_t)M * D, (bf16*)(ws + WS_VTR), nullptr, 1, W8_INV};
          pg8::gemm_phase<EpiML, pg8::StaticOrder, true, true, true>(F.lds, g, S, E); }
    } SEAM(2);
    if (IN(3)) for (int rep_ = 0; rep_ < NREP(3); ++rep_) { if (rep_) xcd_barrier(bar); p3_conv(F, P); } SEAM(3);
    if (IN(4)) for (int rep_ = 0; rep_ < NREP(4); ++rep_) { if (rep_) xcd_barrier(bar); p4_intra(F); } SEAM(4);
    if (IN(5)) for (int rep_ = 0; rep_ < NREP(5); ++rep_) { if (rep_) xcd_barrier(bar); p5_scan(F); } SEAM(5);
    if (IN(6)) for (int rep_ = 0; rep_ < NREP(6); ++rep_) { if (rep_) xcd_barrier(bar); p6_combine(F, P.in[I_MLHG]); } SEAM(6);
    if (IN(7)) for (int rep_ = 0; rep_ < NREP(7); ++rep_) { if (rep_) xcd_barrier(bar); pg8::Gemm g{(const pg8::bf16_t*)HN, (const pg8::bf16_t*)(ws + WS_WOUT0), M, D, D / 2}; pg8::StaticOrder S; S.init(M, D, F.G, F.bid);
        EpiResid<false> E{P.in[I_X], HLAT, MODV + 4096, W8_INV};
        pg8::gemm_phase<EpiResid<false>, pg8::StaticOrder, true, true, true>(F.lds, g, S, E); } SEAM(7);
    if (IN(8)) for (int rep_ = 0; rep_ < NREP(8); ++rep_) { if (rep_) xcd_barrier(bar); adaln_phase<false, true, true>(F, HLAT, nullptr, 0, P.in[I_GCHAN], MODV, 6144, 8192, HN, nullptr, nullptr, nullptr); } SEAM(8);
    if (IN(9)) for (int rep_ = 0; rep_ < NREP(9); ++rep_) { if (rep_) xcd_barrier(bar); pg8::Gemm g{(const pg8::bf16_t*)HN, (const pg8::bf16_t*)(ws + WS_WQ0), M, D, D}; pg8::StaticOrder S; S.init(M, D, F.G, F.bid);
        EpiPlain E{(bf16*)(ws + WS_OG), 1.0f};
        pg8::gemm_phase<EpiPlain, pg8::StaticOrder, true, true>(F.lds, g, S, E); } SEAM(9);
    if (IN(10)) for (int rep_ = 0; rep_ < NREP(10); ++rep_) { if (rep_) xcd_barrier(bar); p10_topk(F, 0, P); } SEAM(10);
    if (IN(11)) { for (int rep_ = 0; rep_ < NREP(24); ++rep_) { p11u_pass(F, 0); xcd_barrier(bar); } if (F.G == 256) p11v_pass<1>(F, 0, P.in[I_GMIX] + D, MODV + 3 * NMOD, (unsigned char*)HN, nullptr); else p11v_pass<0>(F, 0, nullptr, nullptr, nullptr, nullptr); } SEAM(11);
    if (IN(12)) for (int rep_ = 0; rep_ < NREP(12); ++rep_) { if (rep_) xcd_barrier(bar); if (F.G != 256) adaln_phase<false, false, true, true>(F, HLAT, nullptr, 0, P.in[I_GMIX] + D, MODV + 3 * NMOD, 0, 2048, HN, nullptr, nullptr, nullptr); } if (F.G != 256) SEAM(12);
    if (IN(13)) for (int rep_ = 0; rep_ < NREP(13); ++rep_) { if (rep_) xcd_barrier(bar); pg8::Gemm g{(const pg8::bf16_t*)HN, (const pg8::bf16_t*)(ws + WS_WIN1), M, 4096, D / 2}; pg8::StaticOrder S; S.init(M, 4096, F.G, F.bid);
        EpiCM E{(bf16*)(ws + WS_QKRAW), (bf16*)(ws + WS_V), (float*)(ws + WS_VSSP), W8_INV};
        pg8::gemm_phase<EpiCM, pg8::StaticOrder, true, true, true>(F.lds, g, S, E); } SEAM(13);
    if (IN(14)) for (int rep_ = 0; rep_ < NREP(14); ++rep_) { if (rep_) xcd_barrier(bar); p14_spatial(F, P); } SEAM(14);
    if (IN(15)) { pg8::Gemm g{(const pg8::bf16_t*)HN, (const pg8::bf16_t*)(ws + WS_WOUT1), M, D, D / 2}; pg8::StaticOrder S; S.init(M, D, F.G, F.bid);
        EpiResid<true> E{HLAT, HLAT, MODV + 3 * NMOD + 4096, W8_INV};
        pg8::gemm_phase<EpiResid<true>, pg8::StaticOrder, true, true, true>(F.lds, g, S, E); } SEAM(15);
    if (IN(16)) for (int rep_ = 0; rep_ < NREP(16); ++rep_) { if (rep_) xcd_barrier(bar); adaln_phase<false, true, true, true>(F, HLAT, nullptr, 0, P.in[I_GCHAN] + D, MODV + 3 * NMOD, 6144, 8192, HN, nullptr, nullptr, nullptr); } SEAM(16);
    if (IN(17)) for (int rep_ = 0; rep_ < NREP(17); ++rep_) { if (rep_) xcd_barrier(bar); pg8::Gemm g{(const pg8::bf16_t*)HN, (const pg8::bf16_t*)(ws + WS_WQ1), M, D, D / 2}; pg8::StaticOrder S; S.init(M, D, F.G, F.bid);
        EpiPlain E{(bf16*)(ws + WS_OG), W8_INV};
        pg8::gemm_phase<EpiPlain, pg8::StaticOrder, true, true, true>(F.lds, g, S, E); } SEAM(17);
    if (IN(18)) for (int rep_ = 0; rep_ < NREP(18); ++rep_) { if (rep_) xcd_barrier(bar); p10_topk(F, 1, P); } SEAM(18);
    if (IN(19)) { for (int rep_ = 0; rep_ < NREP(24); ++rep_) { p11u_pass(F, 1); xcd_barrier(bar); } { p11v_pass<0>(F, 1, nullptr, nullptr, nullptr, nullptr); xcd_barrier(bar); p_final_only(F, P.in[I_GFINAL], P.out); } }
    if (IN(20)) { p_final_only(F, P.in[I_GFINAL], P.out); }
#ifndef PROBE_HASH_N
#define PROBE_HASH_N ((size_t)M * D)
#endif
#ifdef PROBE_HASH_OFF
    if (IN(21)) { if (PROBE_HASH_F32) p_hash_f32(F, PROBE_HASH_OFF, P.out); else p_hash_bf16(F, PROBE_HASH_OFF, P.out); }
#endif
#undef IN
#undef SEAM
}

#ifndef MK_ONE_LAUNCH
#define MK_ONE_LAUNCH 1
#endif
extern "C" void kernel_launch(void* const* d_in, const int* in_sizes, int n_in, void* d_out, int out_size, void* d_ws, size_t ws_size, hipStream_t stream) {
    static int grid = 0;
    if (grid == 0) {
        if (n_in != 24 || in_sizes[0] != M * D || out_size != M * D || ws_size < WS_END) { fprintf(stderr, "kernel_launch: unexpected shapes (n_in %d, in0 %d, out %d, ws %zu)\n", n_in, n_in > 0 ? in_sizes[0] : -1, out_size, ws_size); grid = -1; return; }
        int dev = 0, cus = 0, per_cu = 0;
        if (hipGetDevice(&dev) != hipSuccess || hipDeviceGetAttribute(&cus, hipDeviceAttributeMultiprocessorCount, dev) != hipSuccess) { grid = -1; return; }
        if (hipFuncSetAttribute((const void*)fwd, hipFuncAttributeMaxDynamicSharedMemorySize, LDS_BYTES) != hipSuccess) { fprintf(stderr, "kernel_launch: hipFuncSetAttribute failed\n"); grid = -1; return; }
        if (hipOccupancyMaxActiveBlocksPerMultiprocessor(&per_cu, (const void*)fwd, NTHR, LDS_BYTES) != hipSuccess || per_cu < 1) fprintf(stderr, "kernel_launch: occupancy query reports %d\n", per_cu);
        (void)hipGetLastError();
        grid = cus;
    }
    if (grid < 0) return;
    (void)hipMemsetAsync((char*)d_ws + WS_CTL, 0, CTL_ZERO_BYTES, stream);
    Params p{};
    for (int i = 0; i < 24; ++i) p.in[i] = (const float*)d_in[i];
    p.out = (float*)d_out; p.ws = (unsigned char*)d_ws;
#if MK_ONE_LAUNCH
    p.ph_lo = 0; p.ph_hi = NPHASE;
    hipLaunchKernelGGL(fwd, dim3(grid), dim3(NTHR), LDS_BYTES, stream, p);
#else
#ifdef MK_TRUNC
    for (int ph = 0; ph <= MK_TRUNC; ++ph) { p.ph_lo = ph; p.ph_hi = ph + 1; hipLaunchKernelGGL(fwd, dim3(grid), dim3(NTHR), LDS_BYTES, stream, p); }
#ifdef PROBE_HASH_OFF
    p.ph_lo = 21; p.ph_hi = 22; hipLaunchKernelGGL(fwd, dim3(grid), dim3(NTHR), LDS_BYTES, stream, p);
#else
    p.ph_lo = 20; p.ph_hi = 21; hipLaunchKernelGGL(fwd, dim3(grid), dim3(NTHR), LDS_BYTES, stream, p);
#endif
#else
    for (int ph = 0; ph < NPHASE; ++ph) { p.ph_lo = ph; p.ph_hi = ph + 1; hipLaunchKernelGGL(fwd, dim3(grid), dim3(NTHR), LDS_BYTES, stream, p); }
#endif
#endif
}
```
